# Optimizing an MI355X kernel written in HIP

```python
import jax, jax.numpy as jnp
from jax import lax
import numpy as np

D_MODEL = 1024
BATCH = 4
SEQ = 8192
DEPTH = 4

CHUNK = 64
D_MIX = D_MODEL
EPS = 1e-6

LRU_WIDTH = 3 * D_MIX // 8
LRU_HEAD_DIM = 64
LRU_HEADS = LRU_WIDTH // LRU_HEAD_DIM
CONV_WIDTH = 4
LRU_C = 8.0

MLA_HEADS = 6
MLA_NOPE = 64
MLA_ROPE = 32
MLA_V = 64
MLA_WIDTH = MLA_HEADS * MLA_V
Q_RANK = 192
KV_RANK = 128
ROPE_THETA = 10000.0
Q_BLOCK = 128

SGU_WIDTH = D_MIX - LRU_WIDTH - MLA_WIDTH
SGU_GROUPS = 4
SGU_GROUP_DIM = SGU_WIDTH // SGU_GROUPS
SGU_BLOCK = 128

IN_SPLITS = (LRU_WIDTH, LRU_WIDTH,
             Q_RANK, KV_RANK, MLA_ROPE, MLA_WIDTH,
             SGU_WIDTH, SGU_WIDTH, SGU_WIDTH)
D_IN = sum(IN_SPLITS)

kernel_name = "hybrid_rglru_mla_sgu_sandwich"


def rms_norm(x, g):
    xf = x.astype(jnp.float32)
    y = xf * lax.rsqrt(jnp.mean(xf * xf, axis=-1, keepdims=True) + EPS)
    return (y * g.astype(jnp.float32)).astype(x.dtype)


def layer_norm(x, g, b):
    xf = x.astype(jnp.float32)
    mu = jnp.mean(xf, axis=-1, keepdims=True)
    xc = xf - mu
    y = xc * lax.rsqrt(jnp.mean(xc * xc, axis=-1, keepdims=True) + EPS)
    return (y * g.astype(jnp.float32) + b.astype(jnp.float32)).astype(x.dtype)


def causal_depthwise_conv(x, w, b):
    y = lax.conv_general_dilated(
        x, w[:, None, :].astype(x.dtype), window_strides=(1,),
        padding=[(CONV_WIDTH - 1, 0)],
        dimension_numbers=('NWC', 'WIO', 'NWC'),
        feature_group_count=x.shape[-1])
    return y + b


def rg_lru(x, wa, ba, wx, bx, lam):
    B_, S_, _ = x.shape
    xh = x.reshape(B_, S_, LRU_HEADS, LRU_HEAD_DIM)
    gate_a = jax.nn.sigmoid(jnp.einsum('bshi,hij->bshj', xh, wa).reshape(B_, S_, LRU_WIDTH) + ba)
    gate_x = jax.nn.sigmoid(jnp.einsum('bshi,hij->bshj', xh, wx).reshape(B_, S_, LRU_WIDTH) + bx)
    log_a = -LRU_C * gate_a.astype(jnp.float32) * jax.nn.softplus(-lam.astype(jnp.float32))
    a = jnp.exp(log_a)
    mult = jnp.sqrt(-jnp.expm1(2.0 * log_a))
    b_in = mult * (gate_x * x).astype(jnp.float32)

    def combine(left, right):
        a_l, b_l = left
        a_r, b_r = right
        return a_l * a_r, a_r * b_l + b_r

    _, h = lax.associative_scan(combine, (a, b_in), axis=1)
    return h.astype(x.dtype)


def rope_cos_sin(positions):
    half = MLA_ROPE // 2
    inv_freq = ROPE_THETA ** (-jnp.arange(half, dtype=jnp.float32) / half)
    ang = positions.astype(jnp.float32)[..., None] * inv_freq
    return jnp.cos(ang), jnp.sin(ang)


def apply_rope(x, cos, sin):
    x1, x2 = jnp.split(x.astype(jnp.float32), 2, axis=-1)
    return jnp.concatenate([x1 * cos - x2 * sin, x2 * cos + x1 * sin], axis=-1).astype(x.dtype)


def mla(q_lat, kv_lat, k_rope, positions, q_norm_g, w_uq, kv_norm_g, w_ukv):
    B_, S_, _ = q_lat.shape
    d_qk = MLA_NOPE + MLA_ROPE
    q = (rms_norm(q_lat, q_norm_g) @ w_uq).reshape(B_, S_, MLA_HEADS, d_qk)
    kv = (rms_norm(kv_lat, kv_norm_g) @ w_ukv).reshape(B_, S_, MLA_HEADS, MLA_NOPE + MLA_V)
    q_nope, q_pe = q[..., :MLA_NOPE], q[..., MLA_NOPE:]
    k_nope, v = kv[..., :MLA_NOPE], kv[..., MLA_NOPE:]
    cos, sin = rope_cos_sin(positions)
    q_pe = apply_rope(q_pe, cos[:, :, None, :], sin[:, :, None, :])
    k_pe = apply_rope(k_rope, cos, sin)
    q = jnp.concatenate([q_nope, q_pe], axis=-1)
    k = jnp.concatenate([k_nope, jnp.broadcast_to(k_pe[:, :, None, :], (B_, S_, MLA_HEADS, MLA_ROPE))], axis=-1)
    scale = d_qk ** -0.5
    n_blk = S_ // Q_BLOCK
    q_blocks = q.reshape(B_, n_blk, Q_BLOCK, MLA_HEADS, d_qk).transpose(1, 0, 2, 3, 4)
    k_chunk = jnp.arange(S_) // CHUNK

    def attend(args):
        qb, blk = args
        q_chunk = (blk * Q_BLOCK + jnp.arange(Q_BLOCK)) // CHUNK
        s = jnp.einsum('bqhd,bkhd->bhqk', qb, k).astype(jnp.float32) * scale
        mask = k_chunk[None, :] <= q_chunk[:, None]
        s = jnp.where(mask[None, None], s, -jnp.inf)
        p = jax.nn.softmax(s, axis=-1).astype(v.dtype)
        return jnp.einsum('bhqk,bkhd->bqhd', p, v)

    o = lax.map(attend, (q_blocks, jnp.arange(n_blk)))
    return o.transpose(1, 0, 2, 3, 4).reshape(B_, S_, MLA_WIDTH)


def spatial_gating(u, v, norm_g, norm_b, w_s, b_s):
    B_, S_, _ = u.shape
    u = jax.nn.gelu(u)
    v = layer_norm(jax.nn.gelu(v), norm_g, norm_b)
    n_blk = S_ // SGU_BLOCK
    vb = v.reshape(B_, n_blk, SGU_BLOCK, SGU_GROUPS, SGU_GROUP_DIM)
    pos_chunk = jnp.arange(SGU_BLOCK) // CHUNK
    mask = pos_chunk[:, None] >= pos_chunk[None, :]
    w = jnp.where(mask[None], w_s, jnp.zeros_like(w_s))
    mixed = jnp.einsum('gij,bnjgc->bnigc', w, vb) + b_s.T[None, None, :, :, None]
    return u * mixed.reshape(B_, S_, SGU_WIDTH)


def hybrid_layer(x, positions, pre_g, w_in, conv_w, conv_b, wa, ba, wx, bx, lam,
                 q_norm_g, w_uq, kv_norm_g, w_ukv, sgu_g, sgu_bn, sgu_w, sgu_b,
                 branch_g, w_out, post_g):
    h = rms_norm(x, pre_g)
    proj = h @ w_in
    offsets = [int(o) for o in np.cumsum(IN_SPLITS)[:-1]]
    xa, ga, q_lat, kv_lat, k_rope, gb, u, v, gc = jnp.split(proj, offsets, axis=-1)
    ya = rg_lru(causal_depthwise_conv(xa, conv_w, conv_b), wa, ba, wx, bx, lam) * jax.nn.silu(ga)
    yb = mla(q_lat, kv_lat, k_rope, positions, q_norm_g, w_uq, kv_norm_g, w_ukv) * jax.nn.silu(gb)
    yc = spatial_gating(u, v, sgu_g, sgu_bn, sgu_w, sgu_b) * jax.nn.silu(gc)
    y = jnp.concatenate([
        rms_norm(ya, branch_g[:LRU_WIDTH]),
        rms_norm(yb, branch_g[LRU_WIDTH:LRU_WIDTH + MLA_WIDTH]),
        rms_norm(yc, branch_g[LRU_WIDTH + MLA_WIDTH:]),
    ], axis=-1)
    return x + rms_norm(y @ w_out, post_g)


def setup_inputs(seed: int = 0) -> dict:
    key = jax.random.key(seed)
    ks = jax.random.split(key, 24)
    f32 = jnp.float32

    def nrm(k, shape, scale):
        return jax.random.normal(k, shape, f32) * scale

    def gain(k, shape):
        return 1.0 + 0.05 * jax.random.normal(k, shape, f32)

    x = jax.random.normal(ks[0], (BATCH, SEQ, D_MODEL), f32)
    offset = jax.random.randint(ks[1], (BATCH, 1), 0, 4096, dtype=jnp.int32)
    positions = (offset + jnp.arange(SEQ, dtype=jnp.int32)[None, :]).astype(jnp.int32)
    a0 = jax.random.uniform(ks[2], (DEPTH, LRU_WIDTH), f32, minval=0.9, maxval=0.999)
    s0 = a0 ** (1.0 / LRU_C)
    lru_lambda = jnp.log(s0) - jnp.log1p(-s0)
    return {
        "x": x,
        "positions": positions,
        "pre_norm_g": gain(ks[3], (DEPTH, D_MODEL)),
        "w_in": nrm(ks[4], (DEPTH, D_MODEL, D_IN), D_MODEL ** -0.5),
        "conv_w": nrm(ks[5], (DEPTH, CONV_WIDTH, LRU_WIDTH), CONV_WIDTH ** -0.5),
        "conv_b": nrm(ks[6], (DEPTH, LRU_WIDTH), 0.02),
        "lru_wa": nrm(ks[7], (DEPTH, LRU_HEADS, LRU_HEAD_DIM, LRU_HEAD_DIM), LRU_HEAD_DIM ** -0.5),
        "lru_ba": nrm(ks[8], (DEPTH, LRU_WIDTH), 0.1),
        "lru_wx": nrm(ks[9], (DEPTH, LRU_HEADS, LRU_HEAD_DIM, LRU_HEAD_DIM), LRU_HEAD_DIM ** -0.5),
        "lru_bx": nrm(ks[10], (DEPTH, LRU_WIDTH), 0.1),
        "lru_lambda": lru_lambda,
        "q_norm_g": gain(ks[11], (DEPTH, Q_RANK)),
        "w_uq": nrm(ks[12], (DEPTH, Q_RANK, MLA_HEADS * (MLA_NOPE + MLA_ROPE)), Q_RANK ** -0.5),
        "kv_norm_g": gain(ks[13], (DEPTH, KV_RANK)),
        "w_ukv": nrm(ks[14], (DEPTH, KV_RANK, MLA_HEADS * (MLA_NOPE + MLA_V)), KV_RANK ** -0.5),
        "sgu_norm_g": gain(ks[15], (DEPTH, SGU_WIDTH)),
        "sgu_norm_b": nrm(ks[16], (DEPTH, SGU_WIDTH), 0.02),
        "sgu_w": nrm(ks[17], (DEPTH, SGU_GROUPS, SGU_BLOCK, SGU_BLOCK), SGU_BLOCK ** -0.5),
        "sgu_b": gain(ks[18], (DEPTH, SGU_GROUPS, SGU_BLOCK)),
        "branch_norm_g": gain(ks[19], (DEPTH, D_MIX)),
        "w_out": nrm(ks[20], (DEPTH, D_MIX, D_MODEL), D_MIX ** -0.5),
        "post_norm_g": gain(ks[21], (DEPTH, D_MODEL)),
    }


def reference(x, positions, pre_norm_g, w_in, conv_w, conv_b, lru_wa, lru_ba, lru_wx, lru_bx,
              lru_lambda, q_norm_g, w_uq, kv_norm_g, w_ukv, sgu_norm_g, sgu_norm_b, sgu_w, sgu_b,
              branch_norm_g, w_out, post_norm_g):
    h = x
    for l in range(DEPTH):
        h = hybrid_layer(h, positions, pre_norm_g[l], w_in[l], conv_w[l], conv_b[l],
                         lru_wa[l], lru_ba[l], lru_wx[l], lru_bx[l], lru_lambda[l],
                         q_norm_g[l], w_uq[l], kv_norm_g[l], w_ukv[l],
                         sgu_norm_g[l], sgu_norm_b[l], sgu_w[l], sgu_b[l],
                         branch_norm_g[l], w_out[l], post_norm_g[l])
    return h
```

```cpp
#include <hip/hip_runtime.h>
#include <hip/hip_cooperative_groups.h>
#include <stdint.h>
#include <stdio.h>
namespace cg = cooperative_groups;

typedef unsigned short u16;
typedef __attribute__((ext_vector_type(8))) short bf16x8;
typedef __attribute__((ext_vector_type(16))) float f32x16;
typedef __attribute__((ext_vector_type(4))) unsigned u32x4;
typedef __attribute__((ext_vector_type(2))) unsigned u32x2;

#ifndef COOP
#define COOP 1
#endif

#define T_TOK 32768
#define SEQ 8192
#define DM 1024
#define DIN 2272
#define DINP 2304
#define NLAYER 4
#define EPSF 1e-6f
#define C_XA 0
#define C_GA 384
#define C_QL 768
#define C_KVL 960
#define C_KR 1088
#define C_GB 1120
#define C_U 1504
#define C_V 1760
#define C_GC 2016

#define LDT 72
#define TILE_U16 (128 * LDT)
#define LDS_BYTES 73728

struct Params {
  const float* x; const int* pos; const float* pre_g; const float* w_in; const float* conv_w; const float* conv_b;
  const float* lru_wa; const float* lru_ba; const float* lru_wx; const float* lru_bx; const float* lru_lam;
  const float* q_g; const float* w_uq; const float* kv_g; const float* w_ukv; const float* sgu_g; const float* sgu_bn;
  const float* sgu_w; const float* sgu_b; const float* br_g; const float* w_out; const float* post_g;
  float* out;
  u16* wInT; u16* wOutT; u16* wUqT; u16* wUkvT; u16* waT; u16* wxT; u16* sguW;
  float2* tab; int* counters; unsigned* bar;
  u16* hbuf;
  u16* proj;
  u16* y2;
  u16* Q; u16* K; u16* VT;
  u16* hloc; u16* cum; float* Ptile; float* Htile; float* carry;
  u16* obuf; u16* ycpre;
};

__device__ const double c_invfreq_rev[16] = {1.59154943091895345608e-01, 8.94994016088910132600e-02, 5.03292121044870352509e-02, 2.83021958306233986646e-02, 1.59154943091895338669e-02, 8.94994016088910236684e-03, 5.03292121044870369856e-03, 2.83021958306233986646e-03, 1.59154943091895356017e-03, 8.94994016088910236684e-04, 5.03292121044870326488e-04, 2.83021958306233954120e-04, 1.59154943091895350596e-04, 8.94994016088910182474e-05, 5.03292121044870353593e-05, 2.83021958306233960897e-05};
typedef const __attribute__((address_space(4))) Params* PP;
__device__ __forceinline__ PP launder(PP q) { asm volatile("" : "+s"(q)); return q; }
__device__ __forceinline__ float bf2f(u16 b) { return __uint_as_float(((unsigned)b) << 16); }
typedef __attribute__((ext_vector_type(2))) __bf16 bf16x2_t;
__device__ __forceinline__ u16 f2bf(float f) { return __builtin_bit_cast(u16, (__bf16)f); }
__device__ __forceinline__ unsigned pack2(float a, float b) { bf16x2_t v = {(__bf16)a, (__bf16)b}; return __builtin_bit_cast(unsigned, v); }
__device__ __forceinline__ float lo16(unsigned u) { return __uint_as_float(u << 16); }
__device__ __forceinline__ float hi16(unsigned u) { return __uint_as_float(u & 0xffff0000u); }
__device__ __forceinline__ void unpack8(uint4 a, float* v) {
  v[0] = lo16(a.x); v[1] = hi16(a.x); v[2] = lo16(a.y); v[3] = hi16(a.y);
  v[4] = lo16(a.z); v[5] = hi16(a.z); v[6] = lo16(a.w); v[7] = hi16(a.w);
}
__device__ __forceinline__ uint4 pack8(const float* v) {
  uint4 a; a.x = pack2(v[0], v[1]); a.y = pack2(v[2], v[3]); a.z = pack2(v[4], v[5]); a.w = pack2(v[6], v[7]); return a;
}
__device__ __forceinline__ float sigmoidf_(float x) { return __builtin_amdgcn_rcpf(1.f + __expf(-x)); }
__device__ __forceinline__ float siluf_(float x) { return x * __builtin_amdgcn_rcpf(1.f + __expf(-x)); }
__device__ __forceinline__ float geluf_(float x) {
  float u = 1.5957691216057308f * (x + 0.044715f * x * x * x);
  return x * __builtin_amdgcn_rcpf(1.f + __expf(-u));
}
__device__ __forceinline__ float wave_sum(float v) {
#pragma unroll
  for (int o = 32; o >= 1; o >>= 1) v += __shfl_xor(v, o);
  return v;
}
__device__ __forceinline__ int opaque_tid() { int t = threadIdx.x; asm volatile("" : "+v"(t)); return t; }
__device__ __forceinline__ f32x16 mfma32(bf16x8 a, bf16x8 b, f32x16 c) {
  return __builtin_amdgcn_mfma_f32_32x32x16_bf16(a, b, c, 0, 0, 0);
}

struct GStage { u32x4 w0, w1, w2, w3, x0, x1, x2, x3; };
__device__ __forceinline__ void gs_load(GStage& g, const u16* gw, int ldw, const u16* gx, int ldx, int k0) {
  g.w0 = *(const u32x4*)(gw + k0);
  g.w1 = *(const u32x4*)(gw + (size_t)32 * ldw + k0);
  g.w2 = *(const u32x4*)(gw + (size_t)64 * ldw + k0);
  g.w3 = *(const u32x4*)(gw + (size_t)96 * ldw + k0);
  g.x0 = *(const u32x4*)(gx + k0);
  g.x1 = *(const u32x4*)(gx + (size_t)32 * ldx + k0);
  g.x2 = *(const u32x4*)(gx + (size_t)64 * ldx + k0);
  g.x3 = *(const u32x4*)(gx + (size_t)96 * ldx + k0);
}
__device__ __forceinline__ void gs_store(const GStage& g, u16* db, int lo) {
  *(u32x4*)(db + lo) = g.w0;
  *(u32x4*)(db + lo + 32 * LDT) = g.w1;
  *(u32x4*)(db + lo + 64 * LDT) = g.w2;
  *(u32x4*)(db + lo + 96 * LDT) = g.w3;
  *(u32x4*)(db + TILE_U16 + lo) = g.x0;
  *(u32x4*)(db + TILE_U16 + lo + 32 * LDT) = g.x1;
  *(u32x4*)(db + TILE_U16 + lo + 64 * LDT) = g.x2;
  *(u32x4*)(db + TILE_U16 + lo + 96 * LDT) = g.x3;
}
__device__ __forceinline__ void gemm_kstep(const u16* sb, int wn, int wt, int r, int h, f32x16 (&acc)[2][2]) {
  const u16* bw = sb + (wn * 64 + r) * LDT + h * 8;
  const u16* bx = sb + TILE_U16 + (wt * 64 + r) * LDT + h * 8;
  __builtin_amdgcn_s_setprio(1);
#pragma unroll
  for (int ks = 0; ks < 4; ++ks) {
    bf16x8 a0 = *(const bf16x8*)(bw + ks * 16);
    bf16x8 a1 = *(const bf16x8*)(bw + 32 * LDT + ks * 16);
    bf16x8 b0 = *(const bf16x8*)(bx + ks * 16);
    bf16x8 b1 = *(const bf16x8*)(bx + 32 * LDT + ks * 16);
    acc[0][0] = mfma32(a0, b0, acc[0][0]);
    acc[0][1] = mfma32(a0, b1, acc[0][1]);
    acc[1][0] = mfma32(a1, b0, acc[1][0]);
    acc[1][1] = mfma32(a1, b1, acc[1][1]);
  }
  __builtin_amdgcn_s_setprio(0);
}
__device__ __forceinline__ void gemm_tile(const u16* __restrict__ W, int ldw, const u16* __restrict__ X, int ldx,
                                          int K, u16* lds, f32x16 (&acc)[2][2]) {
  const int tid = opaque_tid(), lane = tid & 63, w = tid >> 6, r = lane & 31, h = lane >> 5;
  const int wn = w >> 1, wt = w & 1;
#pragma unroll
  for (int a = 0; a < 2; ++a)
#pragma unroll
    for (int b = 0; b < 2; ++b)
#pragma unroll
      for (int i = 0; i < 16; ++i) acc[a][b][i] = 0.f;
  const int lrow = tid >> 3, lc = tid & 7;
  const u16* gw = W + (size_t)lrow * ldw + lc * 8;
  const u16* gx = X + (size_t)lrow * ldx + lc * 8;
  const int lo = lrow * LDT + lc * 8;
  const int nk = K >> 6;
  GStage A, B;
  gs_load(B, gw, ldw, gx, ldx, 0);
  if (nk > 1) gs_load(A, gw, ldw, gx, ldx, 64);
  gs_store(B, lds, lo);
  __syncthreads();
  for (int kt = 0; kt < nk; kt += 2) {
    if (kt + 2 < nk) gs_load(B, gw, ldw, gx, ldx, (kt + 2) * 64);
    gemm_kstep(lds, wn, wt, r, h, acc);
    if (kt + 1 < nk) gs_store(A, lds + 2 * TILE_U16, lo);
    __syncthreads();
    if (kt + 1 < nk) {
      if (kt + 3 < nk) gs_load(A, gw, ldw, gx, ldx, (kt + 3) * 64);
      gemm_kstep(lds + 2 * TILE_U16, wn, wt, r, h, acc);
      if (kt + 2 < nk) gs_store(B, lds, lo);
      __syncthreads();
    }
  }
}

__device__ __forceinline__ void stage_f32(float* st, f32x16 (&acc)[2][2]) {
  const int tid = opaque_tid(), lane = tid & 63, w = tid >> 6, r = lane & 31, h = lane >> 5;
  const int wn = w >> 1, wt = w & 1;
#pragma unroll
  for (int nb = 0; nb < 2; ++nb)
#pragma unroll
    for (int tb = 0; tb < 2; ++tb) {
      const int token = wt * 64 + tb * 32 + r;
#pragma unroll
      for (int g = 0; g < 4; ++g) {
        const int n0 = wn * 64 + nb * 32 + 8 * g + 4 * h;
        float4 v = make_float4(acc[nb][tb][4 * g], acc[nb][tb][4 * g + 1], acc[nb][tb][4 * g + 2], acc[nb][tb][4 * g + 3]);
        *(float4*)(st + token * 132 + n0) = v;
      }
    }
}
__device__ __forceinline__ void stage_bf16(u16* st, f32x16 (&acc)[2][2]) {
  const int tid = opaque_tid(), lane = tid & 63, w = tid >> 6, r = lane & 31, h = lane >> 5;
  const int wn = w >> 1, wt = w & 1;
#pragma unroll
  for (int nb = 0; nb < 2; ++nb)
#pragma unroll
    for (int tb = 0; tb < 2; ++tb) {
      const int token = wt * 64 + tb * 32 + r;
#pragma unroll
      for (int g = 0; g < 4; ++g) {
        const int n0 = wn * 64 + nb * 32 + 8 * g + 4 * h;
        uint2 v;
        v.x = pack2(acc[nb][tb][4 * g], acc[nb][tb][4 * g + 1]);
        v.y = pack2(acc[nb][tb][4 * g + 2], acc[nb][tb][4 * g + 3]);
        *(uint2*)(st + token * 136 + n0) = v;
      }
    }
}

__device__ void gemm_store_tile(const u16* W, int ldw, const u16* X, int ldx, int K, u16* out, int ldo, u16* lds) {
  f32x16 acc[2][2];
  gemm_tile(W, ldw, X, ldx, K, lds, acc);
  stage_bf16(lds, acc);
  __syncthreads();
  const int tid = opaque_tid();
#pragma unroll
  for (int i = 0; i < 8; ++i) {
    const int id = tid + 256 * i;
    const int row = id >> 4, c = id & 15;
    uint4 v = *(const uint4*)(lds + row * 136 + c * 8);
    *(uint4*)(out + (size_t)row * ldo + c * 8) = v;
  }
  __syncthreads();
}

__device__ void gemm_phase(const u16* __restrict__ Wb, int ldw, const u16* __restrict__ Xb, int ldx, int K,
                           u16* __restrict__ outb, int ldo, int ntn, int ntiles, u16* lds) {
  const int tid = opaque_tid(), lane = tid & 63, w = tid >> 6, r = lane & 31, h = lane >> 5;
  const int wn = w >> 1, wt = w & 1;
  const int lrow = tid >> 3, lc = tid & 7;
  const int lo = lrow * LDT + lc * 8;
  const int nk = K >> 6;
  const int nbl = gridDim.x >> 3;
  const int xl = blockIdx.x & 7, jl = blockIdx.x >> 3;
  const int mt_per = (ntiles / ntn) >> 3;
  const int L = mt_per * ntn;
  int q = jl;
  if (q >= L) return;
#define GP_MT(qq) (xl * mt_per + ((qq) / (8 * ntn)) * 8 + ((qq) % (8 * ntn)) % 8)
#define GP_NT(qq) (((qq) % (8 * ntn)) / 8)
  const u16* gw = Wb + (size_t)(GP_NT(q) * 128 + lrow) * ldw + lc * 8;
  const u16* gx = Xb + (size_t)(GP_MT(q) * 128 + lrow) * ldx + lc * 8;
  GStage A, B;
  gs_load(B, gw, ldw, gx, ldx, 0);
  gs_load(A, gw, ldw, gx, ldx, 64);
  for (; q < L; q += nbl) {
    const int qn = q + nbl;
    const bool has_next = qn < L;
    const int qq = has_next ? qn : q;
    const u16* gwn = Wb + (size_t)(GP_NT(qq) * 128 + lrow) * ldw + lc * 8;
    const u16* gxn = Xb + (size_t)(GP_MT(qq) * 128 + lrow) * ldx + lc * 8;
    f32x16 acc[2][2];
#pragma unroll
    for (int a = 0; a < 2; ++a)
#pragma unroll
      for (int b = 0; b < 2; ++b)
#pragma unroll
        for (int i = 0; i < 16; ++i) acc[a][b][i] = 0.f;
    gs_store(B, lds, lo);
    __syncthreads();
    for (int kt = 0; kt < nk; kt += 2) {
      if (kt + 2 < nk) gs_load(B, gw, ldw, gx, ldx, (kt + 2) * 64);
      else if (has_next) gs_load(B, gwn, ldw, gxn, ldx, 0);
      gemm_kstep(lds, wn, wt, r, h, acc);
      gs_store(A, lds + 2 * TILE_U16, lo);
      __syncthreads();
      if (kt + 3 < nk) gs_load(A, gw, ldw, gx, ldx, (kt + 3) * 64);
      else if (has_next) gs_load(A, gwn, ldw, gxn, ldx, 64);
      gemm_kstep(lds + 2 * TILE_U16, wn, wt, r, h, acc);
      if (kt + 2 < nk) gs_store(B, lds, lo);
      __syncthreads();
    }
    stage_bf16(lds, acc);
    __syncthreads();
    u16* out = outb + (size_t)GP_MT(q) * 128 * ldo + GP_NT(q) * 128;
#pragma unroll
    for (int i = 0; i < 8; ++i) {
      const int id = tid + 256 * i;
      const int row = id >> 4, c = id & 15;
      uint4 v = *(const uint4*)(lds + row * 136 + c * 8);
      *(uint4*)(out + (size_t)row * ldo + c * 8) = v;
    }
    __syncthreads();
    gw = gwn; gx = gxn;
  }
#undef GP_MT
#undef GP_NT
}

__device__ void prep_transpose(const float* __restrict__ src, size_t sstride, int nmat, int R, int C, u16* __restrict__ dst,
                               size_t dstride, int dld, const float* __restrict__ gk, int mode, float* tile, int bid, int nb) {
  const int tid = opaque_tid();
  const int tr = R >> 6, tc = (C + 63) >> 6;
  const int per = tr * tc;
  for (int t = bid; t < per * nmat; t += nb) {
    const int m = t / per, tt = t % per;
    const int r0 = (tt / tc) * 64, c0 = (tt % tc) * 64;
    const float* sm = src + (size_t)m * sstride;
    u16* dm = dst + (size_t)m * dstride;
    __syncthreads();
#pragma unroll
    for (int i = 0; i < 16; ++i) {
      const int rr = i * 4 + (tid >> 6), cc = tid & 63;
      float v = 0.f;
      if (c0 + cc < C) {
        v = sm[(size_t)(r0 + rr) * C + c0 + cc];
        if (gk) v *= gk[m * R + r0 + rr];
      }
      tile[rr * 65 + cc] = v;
    }
    __syncthreads();
#pragma unroll
    for (int i = 0; i < 16; ++i) {
      const int cc = i * 4 + (tid >> 6), rr = tid & 63;
      const int c = c0 + cc;
      if (c < C) {
        const int n = (mode == 1) ? (c / 96) * 128 + (c % 96) : c;
        dm[(size_t)n * dld + r0 + rr] = f2bf(tile[rr * 65 + cc]);
      }
    }
  }
}
__device__ void phase_prep(PP p, float* ldsf) {
  p = launder(p);
  const int bid = blockIdx.x, nb = gridDim.x, tid = opaque_tid();
  const int gtid = bid * 256 + tid, gn = nb * 256;
  if (bid == 0) p->counters[tid] = 0;
  prep_transpose(p->w_in, (size_t)DM * DIN, NLAYER, DM, DIN, p->wInT, (size_t)DINP * DM, DM, nullptr, 0, ldsf, bid, nb);
  prep_transpose(p->w_out, (size_t)DM * DM, NLAYER, DM, DM, p->wOutT, (size_t)DM * DM, DM, nullptr, 0, ldsf, (bid + 256) % nb, nb);
  prep_transpose(p->w_uq, (size_t)192 * 576, NLAYER, 192, 576, p->wUqT, (size_t)768 * 192, 192, p->q_g, 1, ldsf, (bid + 128) % nb, nb);
  prep_transpose(p->w_ukv, (size_t)128 * 768, NLAYER, 128, 768, p->wUkvT, (size_t)768 * 128, 128, p->kv_g, 0, ldsf, (bid + 384) % nb, nb);
  prep_transpose(p->lru_wa, 4096, NLAYER * 6, 64, 64, p->waT, 4096, 64, nullptr, 0, ldsf, (bid + 64) % nb, nb);
  prep_transpose(p->lru_wx, 4096, NLAYER * 6, 64, 64, p->wxT, 4096, 64, nullptr, 0, ldsf, (bid + 192) % nb, nb);
  for (int i = gtid; i < NLAYER * 32 * DM; i += gn) {
    const int l = i / (32 * DM), rem = i % (32 * DM);
    p->wInT[(size_t)l * DINP * DM + (size_t)DIN * DM + rem] = 0;
  }
  for (int i = gtid; i < NLAYER * 6 * 32 * 192; i += gn) {
    const int l = i / (6 * 32 * 192), rem = i % (6 * 32 * 192);
    const int hd = rem / (32 * 192), rem2 = rem % (32 * 192);
    p->wUqT[(size_t)l * 768 * 192 + (size_t)(hd * 128 + 96) * 192 + rem2] = 0;
  }
  for (int i = gtid; i < NLAYER * 4 * 128 * 128; i += gn) {
    const int ii = (i >> 7) & 127, jj = i & 127;
    const float v = (ii >= 64 || jj < 64) ? p->sgu_w[i] : 0.f;
    p->sguW[i] = f2bf(v);
  }
  for (int i = gtid; i < T_TOK * 16; i += gn) {
    const int t = i >> 4, k = i & 15;
    const double rev = (double)p->pos[t] * c_invfreq_rev[k];
    const double fr = rev - __builtin_rint(rev);
    const float f = (float)fr;
    p->tab[i] = make_float2(__builtin_amdgcn_cosf(f), __builtin_amdgcn_sinf(f));
  }
}

typedef __attribute__((ext_vector_type(4))) float f32x4;
__device__ void phase_norm(PP p, int l) {
  p = launder(p);
  const int tid_ = opaque_tid();
  const int lane = tid_ & 63;
  const int gw = blockIdx.x * 4 + (tid_ >> 6), nw = gridDim.x * 4;
  const float* xin = (l == 0) ? p->x : p->out;
  const float* gpost = p->post_g + (l > 0 ? l - 1 : 0) * DM;
  const float* gpre = p->pre_g + (l < NLAYER ? l : 0) * DM;
  constexpr int NTK = 4;
  for (int tok0 = gw; tok0 < T_TOK; tok0 += NTK * nw) {
    f32x4 xv[NTK][4];
    u32x2 yu[NTK][4];
#pragma unroll
    for (int t = 0; t < NTK; ++t) {
      const int tok = (tok0 + t * nw < T_TOK) ? tok0 + t * nw : tok0;
#pragma unroll
      for (int i = 0; i < 4; ++i) xv[t][i] = __builtin_nontemporal_load((const f32x4*)(xin + (size_t)tok * DM + i * 256 + lane * 4));
    }
    if (l > 0) {
#pragma unroll
      for (int t = 0; t < NTK; ++t) {
        const int tok = (tok0 + t * nw < T_TOK) ? tok0 + t * nw : tok0;
#pragma unroll
        for (int i = 0; i < 4; ++i) yu[t][i] = __builtin_nontemporal_load((const u32x2*)(p->y2 + (size_t)tok * DM + i * 256 + lane * 4));
      }
    }
#pragma unroll
    for (int t = 0; t < NTK; ++t) {
      const int tok = (tok0 + t * nw < T_TOK) ? tok0 + t * nw : tok0;
      if (l > 0) {
        float yv[16];
        float ss = 0.f;
#pragma unroll
        for (int i = 0; i < 4; ++i) {
          yv[4 * i] = lo16(yu[t][i].x); yv[4 * i + 1] = hi16(yu[t][i].x); yv[4 * i + 2] = lo16(yu[t][i].y); yv[4 * i + 3] = hi16(yu[t][i].y);
          ss += yv[4 * i] * yv[4 * i] + yv[4 * i + 1] * yv[4 * i + 1] + yv[4 * i + 2] * yv[4 * i + 2] + yv[4 * i + 3] * yv[4 * i + 3];
        }
        ss = wave_sum(ss);
        const float rs = rsqrtf(ss * (1.f / 1024.f) + EPSF);
#pragma unroll
        for (int i = 0; i < 4; ++i) {
          float4 gv = *(const float4*)(gpost + i * 256 + lane * 4);
          xv[t][i].x += yv[4 * i] * rs * gv.x; xv[t][i].y += yv[4 * i + 1] * rs * gv.y;
          xv[t][i].z += yv[4 * i + 2] * rs * gv.z; xv[t][i].w += yv[4 * i + 3] * rs * gv.w;
        }
      }
#pragma unroll
      for (int i = 0; i < 4; ++i) __builtin_nontemporal_store(xv[t][i], (f32x4*)(p->out + (size_t)tok * DM + i * 256 + lane * 4));
      if (l < NLAYER) {
        float ss = 0.f;
#pragma unroll
        for (int i = 0; i < 4; ++i) ss += xv[t][i].x * xv[t][i].x + xv[t][i].y * xv[t][i].y + xv[t][i].z * xv[t][i].z + xv[t][i].w * xv[t][i].w;
        ss = wave_sum(ss);
        const float rs = rsqrtf(ss * (1.f / 1024.f) + EPSF);
#pragma unroll
        for (int i = 0; i < 4; ++i) {
          float4 gv = *(const float4*)(gpre + i * 256 + lane * 4);
          uint2 u;
          u.x = pack2(xv[t][i].x * rs * gv.x, xv[t][i].y * rs * gv.y);
          u.y = pack2(xv[t][i].z * rs * gv.z, xv[t][i].w * rs * gv.w);
          *(uint2*)(p->hbuf + (size_t)tok * DM + i * 256 + lane * 4) = u;
        }
      }
    }
  }
}

__device__ void item_q(PP p, int l, int rt, int hd, u16* lds, float* ssm) {
  p = launder(p);
  const int tid = opaque_tid();
  const int m0 = rt * 128;
  {
    const int row = tid >> 1, half = tid & 1;
    const u16* src = p->proj + (size_t)(m0 + row) * DINP + C_QL + half * 96;
    float ss = 0.f;
#pragma unroll
    for (int i = 0; i < 12; ++i) {
      float v[8]; unpack8(*(const uint4*)(src + i * 8), v);
#pragma unroll
      for (int j = 0; j < 8; ++j) ss += v[j] * v[j];
    }
    ss += __shfl_xor(ss, 1);
    if (half == 0) ssm[row] = rsqrtf(ss * (1.f / 192.f) + EPSF);
  }
  f32x16 acc[2][2];
  gemm_tile(p->wUqT + (size_t)l * 768 * 192 + (size_t)hd * 128 * 192, 192, p->proj + (size_t)m0 * DINP + C_QL, DINP, 192, lds, acc);
  float* st = (float*)lds;
  stage_f32(st, acc);
  __syncthreads();
  const float qscale = 0.10206207261596577f * 1.4426950408889634f;
#pragma unroll
  for (int i = 0; i < 6; ++i) {
    const int u = tid + 256 * i;
    const int row = u / 12, dg = u % 12;
    const float sc = ssm[row] * qscale;
    const float* sr = st + row * 132;
    float o[8];
    if (dg < 8) {
      const float4 a = *(const float4*)(sr + dg * 8), bq = *(const float4*)(sr + dg * 8 + 4);
      o[0] = a.x * sc; o[1] = a.y * sc; o[2] = a.z * sc; o[3] = a.w * sc;
      o[4] = bq.x * sc; o[5] = bq.y * sc; o[6] = bq.z * sc; o[7] = bq.w * sc;
    } else {
      const int i0 = (dg & 1) * 8;
      const float2* tb = p->tab + (size_t)(m0 + row) * 16 + i0;
      const float4 a0 = *(const float4*)(sr + 64 + i0), a1 = *(const float4*)(sr + 68 + i0);
      const float4 b0 = *(const float4*)(sr + 80 + i0), b1 = *(const float4*)(sr + 84 + i0);
      const float x1[8] = {a0.x, a0.y, a0.z, a0.w, a1.x, a1.y, a1.z, a1.w};
      const float x2[8] = {b0.x, b0.y, b0.z, b0.w, b1.x, b1.y, b1.z, b1.w};
      const float4 t0 = *(const float4*)(tb), t1 = *(const float4*)(tb + 2), t2 = *(const float4*)(tb + 4), t3 = *(const float4*)(tb + 6);
      const float cc[8] = {t0.x, t0.z, t1.x, t1.z, t2.x, t2.z, t3.x, t3.z};
      const float sn[8] = {t0.y, t0.w, t1.y, t1.w, t2.y, t2.w, t3.y, t3.w};
      if (dg < 10) {
#pragma unroll
        for (int j = 0; j < 8; ++j) o[j] = (x1[j] * cc[j] - x2[j] * sn[j]) * sc;
      } else {
#pragma unroll
        for (int j = 0; j < 8; ++j) o[j] = (x2[j] * cc[j] + x1[j] * sn[j]) * sc;
      }
    }
    *(uint4*)(p->Q + ((size_t)(m0 + row) * 6 + hd) * 96 + dg * 8) = pack8(o);
  }
  __syncthreads();
}

__device__ void item_kv(PP p, int l, int rt, int hd, u16* lds, float* ssm) {
  p = launder(p);
  const int tid = opaque_tid();
  const int m0 = rt * 128;
  {
    const int row = tid >> 1, half = tid & 1;
    const u16* src = p->proj + (size_t)(m0 + row) * DINP + C_KVL + half * 64;
    float ss = 0.f;
#pragma unroll
    for (int i = 0; i < 8; ++i) {
      float v[8]; unpack8(*(const uint4*)(src + i * 8), v);
#pragma unroll
      for (int j = 0; j < 8; ++j) ss += v[j] * v[j];
    }
    ss += __shfl_xor(ss, 1);
    if (half == 0) ssm[row] = rsqrtf(ss * (1.f / 128.f) + EPSF);
  }
  f32x16 acc[2][2];
  gemm_tile(p->wUkvT + (size_t)l * 768 * 128 + (size_t)hd * 128 * 128, 128, p->proj + (size_t)m0 * DINP + C_KVL, DINP, 128, lds, acc);
  float* st = (float*)lds;
  stage_f32(st, acc);
  __syncthreads();
  const int kb_ = m0 / SEQ, ks0_ = m0 % SEQ;
#pragma unroll
  for (int i = 0; i < 4; ++i) {
    const int u = tid + 256 * i;
    const int row = u >> 3, dg = u & 7;
    const float sc = ssm[row];
    const float* sr = st + row * 132 + dg * 8;
    float o[8];
    {
      const float4 a = *(const float4*)(sr), bq = *(const float4*)(sr + 4);
      o[0] = a.x * sc; o[1] = a.y * sc; o[2] = a.z * sc; o[3] = a.w * sc;
      o[4] = bq.x * sc; o[5] = bq.y * sc; o[6] = bq.z * sc; o[7] = bq.w * sc;
    }
    *(uint4*)(p->K + ((size_t)(kb_ * 6 + hd) * SEQ + ks0_ + row) * 96 + dg * 8) = pack8(o);
  }
  if (hd == 0) {
#pragma unroll
    for (int i = 0; i < 2; ++i) {
      const int u = tid + 256 * i;
      const int row = u >> 2, dq = u & 3;
      const int i0 = (dq & 1) * 8;
      const u16* kr = p->proj + (size_t)(m0 + row) * DINP + C_KR;
      float x1[8], x2[8], o[8];
      unpack8(*(const uint4*)(kr + i0), x1);
      unpack8(*(const uint4*)(kr + 16 + i0), x2);
      const float2* tb = p->tab + (size_t)(m0 + row) * 16 + i0;
      if (dq < 2) {
#pragma unroll
        for (int j = 0; j < 8; ++j) { float2 cs = tb[j]; o[j] = x1[j] * cs.x - x2[j] * cs.y; }
      } else {
#pragma unroll
        for (int j = 0; j < 8; ++j) { float2 cs = tb[j]; o[j] = x2[j] * cs.x + x1[j] * cs.y; }
      }
      const uint4 ov = pack8(o);
#pragma unroll
      for (int hh2 = 0; hh2 < 6; ++hh2)
        *(uint4*)(p->K + ((size_t)(kb_ * 6 + hh2) * SEQ + ks0_ + row) * 96 + 64 + dq * 8) = ov;
    }
  }
  const int b = m0 / SEQ, s0 = m0 % SEQ;
#pragma unroll
  for (int i = 0; i < 4; ++i) {
    const int u = tid + 256 * i;
    const int dv = u & 63, tg = u >> 6;
    float o[8];
#pragma unroll
    for (int j = 0; j < 8; ++j) o[j] = st[(tg * 8 + j) * 132 + 64 + dv] * ssm[tg * 8 + j];
    u16* vdst = p->VT + (((size_t)(b * 6 + hd) * 128 + (s0 >> 6) + (tg >> 3)) * 64 + dv) * 64 + ((tg & 7) >> 1) * 16 + (tg & 1) * 4;
    uint2 lo2, hi2;
    lo2.x = pack2(o[0], o[1]); lo2.y = pack2(o[2], o[3]);
    hi2.x = pack2(o[4], o[5]); hi2.y = pack2(o[6], o[7]);
    *(uint2*)(vdst) = lo2;
    *(uint2*)(vdst + 8) = hi2;
  }
  __syncthreads();
}

__device__ void item_lru(PP p, int l, int tt, int hd, u16* lds, float* ssm) {
  p = launder(p);
  const int tid = opaque_tid(), lane = tid & 63, w = tid >> 6, r = lane & 31, h = lane >> 5;
  const int t0 = tt * 64;
  const int s0 = t0 % SEQ;
  float* xaf = (float*)lds;
  u16* xcb = lds + 8576;
  float* aarr = (float*)(lds + 8576 + 4608);
  float* barr = aarr + 4096;
  const int c = tid & 63;
  const int cg = hd * 64 + c;
  bf16x8 wfa[4], wfx[4];
  {
    const int cbk_ = w & 1;
    const u16* wa_ = p->waT + (size_t)(l * 6 + hd) * 4096 + (cbk_ * 32 + r) * 64 + h * 8;
    const u16* wx_ = p->wxT + (size_t)(l * 6 + hd) * 4096 + (cbk_ * 32 + r) * 64 + h * 8;
#pragma unroll
    for (int ks = 0; ks < 4; ++ks) { wfa[ks] = *(const bf16x8*)(wa_ + ks * 16); wfx[ks] = *(const bf16x8*)(wx_ + ks * 16); }
  }
  for (int u = tid; u < 67 * 8; u += 256) {
    const int row = u >> 3, c8 = u & 7;
    float v[8];
    if (s0 + row - 3 >= 0) {
      unpack8(*(const uint4*)(p->proj + (size_t)(t0 + row - 3) * DINP + C_XA + hd * 64 + c8 * 8), v);
    } else {
#pragma unroll
      for (int j = 0; j < 8; ++j) v[j] = 0.f;
    }
    *(float4*)(xaf + row * 64 + c8 * 8) = make_float4(v[0], v[1], v[2], v[3]);
    *(float4*)(xaf + row * 64 + c8 * 8 + 4) = make_float4(v[4], v[5], v[6], v[7]);
  }
  __syncthreads();
  const float cw0 = p->conv_w[(l * 4 + 0) * 384 + cg], cw1 = p->conv_w[(l * 4 + 1) * 384 + cg];
  const float cw2 = p->conv_w[(l * 4 + 2) * 384 + cg], cw3 = p->conv_w[(l * 4 + 3) * 384 + cg];
  const float cbias = p->conv_b[l * 384 + cg];
  {
    const int tq = tid >> 6;
    for (int t = tq * 16; t < tq * 16 + 16; ++t) {
      const float xc = cbias + cw0 * xaf[t * 64 + c] + cw1 * xaf[(t + 1) * 64 + c] + cw2 * xaf[(t + 2) * 64 + c] + cw3 * xaf[(t + 3) * 64 + c];
      xcb[t * LDT + c] = f2bf(xc);
    }
  }
  __syncthreads();
  {
    const int tb = w >> 1, cbk = w & 1;
    f32x16 aa, ax;
#pragma unroll
    for (int i = 0; i < 16; ++i) { aa[i] = 0.f; ax[i] = 0.f; }
    const u16* xr = xcb + (tb * 32 + r) * LDT + h * 8;
#pragma unroll
    for (int ks = 0; ks < 4; ++ks) {
      bf16x8 af = *(const bf16x8*)(xr + ks * 16);
      aa = mfma32(af, wfa[ks], aa);
      ax = mfma32(af, wfx[ks], ax);
    }
    const int cc = cbk * 32 + r;
    const int cgl = hd * 64 + cc;
    const float ba = p->lru_ba[l * 384 + cgl], bx = p->lru_bx[l * 384 + cgl];
    const float lam = p->lru_lam[l * 384 + cgl];
    const float nl = -lam;
    const float sp = fmaxf(nl, 0.f) + log1pf(expf(-fabsf(nl)));
#pragma unroll
    for (int reg = 0; reg < 16; ++reg) {
      const int t = tb * 32 + (reg & 3) + 8 * (reg >> 2) + 4 * h;
      const float xc = bf2f(xcb[t * LDT + cc]);
      const float ga = sigmoidf_(aa[reg] + ba);
      const float gx = sigmoidf_(ax[reg] + bx);
      const float la = -8.f * ga * sp;
      const float a = __expf(la);
      const float om = (la > -5e-4f) ? (-2.f * la) * (1.f + la) : (1.f - a * a);
      const float mult = sqrtf(fmaxf(om, 0.f));
      aarr[t * 64 + cc] = a;
      barr[t * 64 + cc] = mult * gx * xc;
    }
  }
  __syncthreads();
  const int seg = tid >> 6;
  u16* h16 = (u16*)aarr;
  u16* c16 = (u16*)barr;
  float pr[16], hr[16];
#pragma unroll
  for (int j = 0; j < 16; ++j) { pr[j] = aarr[(seg * 16 + j) * 64 + c]; hr[j] = barr[(seg * 16 + j) * 64 + c]; }
  {
    float hh = 0.f, P = 1.f;
#pragma unroll
    for (int j = 0; j < 16; ++j) { hh = pr[j] * hh + hr[j]; P *= pr[j]; hr[j] = hh; pr[j] = P; }
    ssm[seg * 64 + c] = P;
    ssm[256 + seg * 64 + c] = hh;
  }
  __syncthreads();
  {
    float Hc = 0.f, Pc = 1.f;
    for (int s2 = 0; s2 < seg; ++s2) {
      const float Ps = ssm[s2 * 64 + c], Hs = ssm[256 + s2 * 64 + c];
      Hc = Ps * Hc + Hs; Pc *= Ps;
    }
    float hl = 0.f, cm = 1.f;
#pragma unroll
    for (int j = 0; j < 16; ++j) {
      hl = hr[j] + pr[j] * Hc;
      cm = pr[j] * Pc;
      h16[(seg * 16 + j) * 64 + c] = f2bf(hl);
      c16[(seg * 16 + j) * 64 + c] = f2bf(cm);
    }
    if (seg == 3) {
      p->Htile[(size_t)tt * 384 + cg] = hl;
      p->Ptile[(size_t)tt * 384 + cg] = cm;
    }
  }
  __syncthreads();
#pragma unroll
  for (int i = 0; i < 2; ++i) {
    const int id = tid + 256 * i;
    const int row = id >> 3, c8 = id & 7;
    const uint4 hv = *(const uint4*)(h16 + row * 64 + c8 * 8);
    const uint4 cv = *(const uint4*)(c16 + row * 64 + c8 * 8);
    *(uint4*)(p->hloc + (size_t)(t0 + row) * 384 + hd * 64 + c8 * 8) = hv;
    *(uint4*)(p->cum + (size_t)(t0 + row) * 384 + hd * 64 + c8 * 8) = cv;
  }
  __syncthreads();
}

__device__ void item_sgu(PP p, int l, int nbk, u16* lds, float* ssm) {
  p = launder(p);
  const int tid = opaque_tid(), lane = tid & 63, w = tid >> 6, r = lane & 31, h = lane >> 5;
  const int m0 = nbk * 128;
  {
    const int row = tid >> 1, half = tid & 1;
    const u16* src = p->proj + (size_t)(m0 + row) * DINP + C_V + half * 128;
    float s1 = 0.f, s2 = 0.f;
#pragma unroll
    for (int i = 0; i < 16; ++i) {
      float v[8]; unpack8(*(const uint4*)(src + i * 8), v);
#pragma unroll
      for (int j = 0; j < 8; ++j) { const float gq = geluf_(v[j]); s1 += gq; s2 += gq * gq; }
    }
    s1 += __shfl_xor(s1, 1); s2 += __shfl_xor(s2, 1);
    if (half == 0) {
      const float mu = s1 * (1.f / 256.f);
      const float var = fmaxf(s2 * (1.f / 256.f) - mu * mu, 0.f);
      ssm[row] = mu; ssm[128 + row] = rsqrtf(var + EPSF);
    }
  }
  u16* vbT = lds;
  for (int g = 0; g < 4; ++g) {
    __syncthreads();
    const u16* wr = p->sguW + ((size_t)(l * 4 + g) * 128 + w * 32 + r) * 128 + h * 8;
    bf16x8 wf[8];
#pragma unroll
    for (int ks = 0; ks < 8; ++ks) wf[ks] = *(const bf16x8*)(wr + ks * 16);
    {
      const int j = tid & 127, chalf = tid >> 7;
      const float mu = ssm[j], rs = ssm[128 + j];
      const u16* src = p->proj + (size_t)(m0 + j) * DINP + C_V + g * 64 + chalf * 32;
      const float* lg = p->sgu_g + l * 256 + g * 64 + chalf * 32;
      const float* lb = p->sgu_bn + l * 256 + g * 64 + chalf * 32;
#pragma unroll
      for (int i = 0; i < 4; ++i) {
        float v[8]; unpack8(*(const uint4*)(src + i * 8), v);
#pragma unroll
        for (int q = 0; q < 8; ++q) {
          const int cc = chalf * 32 + i * 8 + q;
          const float val = (geluf_(v[q]) - mu) * rs * lg[i * 8 + q] + lb[i * 8 + q];
          vbT[cc * 136 + j] = f2bf(val);
        }
      }
    }
    __syncthreads();
    f32x16 a0, a1;
#pragma unroll
    for (int i = 0; i < 16; ++i) { a0[i] = 0.f; a1[i] = 0.f; }
    const u16* vv0 = vbT + r * 136 + h * 8;
    const u16* vv1 = vbT + (32 + r) * 136 + h * 8;
    const int nks = (w < 2) ? 4 : 8;
#pragma unroll
    for (int ks = 0; ks < 8; ++ks) {
      if (ks < nks) {
        bf16x8 b0 = *(const bf16x8*)(vv0 + ks * 16);
        bf16x8 b1 = *(const bf16x8*)(vv1 + ks * 16);
        a0 = mfma32(wf[ks], b0, a0);
        a1 = mfma32(wf[ks], b1, a1);
      }
    }
    float* stg = (float*)(lds + 8704);
#pragma unroll
    for (int reg = 0; reg < 16; ++reg) {
      const int i = w * 32 + (reg & 3) + 8 * (reg >> 2) + 4 * h;
      const float bsv = p->sgu_b[(l * 4 + g) * 128 + i];
      stg[i * 68 + r] = a0[reg] + bsv;
      stg[i * 68 + 32 + r] = a1[reg] + bsv;
    }
    __syncthreads();
#pragma unroll
    for (int k = 0; k < 4; ++k) {
      const int u = tid + 256 * k;
      const int i = u >> 3, c8 = u & 7;
      const size_t tok = (size_t)(m0 + i);
      const int ch = g * 64 + c8 * 8;
      const float4 m0v = *(const float4*)(stg + i * 68 + c8 * 8), m1v = *(const float4*)(stg + i * 68 + c8 * 8 + 4);
      const float mx[8] = {m0v.x, m0v.y, m0v.z, m0v.w, m1v.x, m1v.y, m1v.z, m1v.w};
      float uu[8], gcv[8], o[8];
      unpack8(*(const uint4*)(p->proj + tok * DINP + C_U + ch), uu);
      unpack8(*(const uint4*)(p->proj + tok * DINP + C_GC + ch), gcv);
#pragma unroll
      for (int q = 0; q < 8; ++q) o[q] = geluf_(uu[q]) * mx[q] * siluf_(gcv[q]);
      *(uint4*)(p->ycpre + tok * 256 + ch) = pack8(o);
    }
  }
  __syncthreads();
}

__device__ void item_carry(PP p, int ci) {
  p = launder(p);
  const int idx = ci * 256 + opaque_tid();
  const int b = idx / 384, c = idx % 384;
  float carry = 0.f;
  for (int tt = 0; tt < 128; ++tt) {
    const size_t o = (size_t)(b * 128 + tt) * 384 + c;
    p->carry[o] = carry;
    carry = p->Ptile[o] * carry + p->Htile[o];
  }
}

#define KLD 104
#define VLD 72
#define ATT_STAGE (64 * KLD + 64 * VLD)
struct AStage { u32x4 k0, k1, k2, v0, v1; };
__device__ __forceinline__ void as_load(AStage& g, const u16* kg, const u16* vg, int kt) {
  const u16* kp = kg + (size_t)kt * 6144;
  g.k0 = *(const u32x4*)(kp); g.k1 = *(const u32x4*)(kp + 2048); g.k2 = *(const u32x4*)(kp + 4096);
  const u16* vp = vg + (size_t)kt * 4096;
  g.v0 = *(const u32x4*)(vp); g.v1 = *(const u32x4*)(vp + 2048);
#ifdef DUP_LOADS
  {
    u32x4 t0 = *(const volatile u32x4*)(kp), t1 = *(const volatile u32x4*)(kp + 2048), t2 = *(const volatile u32x4*)(kp + 4096);
    u32x4 t3 = *(const volatile u32x4*)(vp), t4 = *(const volatile u32x4*)(vp + 2048);
    asm volatile("" :: "v"(t0), "v"(t1), "v"(t2), "v"(t3), "v"(t4));
  }
#endif
}
__device__ __forceinline__ void as_store(const AStage& g, u16* db, int kl0, int kl1, int kl2, int vl) {
  *(u32x4*)(db + kl0) = g.k0; *(u32x4*)(db + kl1) = g.k1; *(u32x4*)(db + kl2) = g.k2;
  *(u32x4*)(db + vl) = g.v0; *(u32x4*)(db + vl + 32 * VLD) = g.v1;
}
__device__ __forceinline__ float max3f(float a, float b, float c) {
  float d; asm("v_max3_f32 %0, %1, %2, %3" : "=v"(d) : "v"(a), "v"(b), "v"(c)); return d;
}
__device__ __forceinline__ bf16x8 pack_p(const f32x16& s, int o) {
  u32x4 pu;
  pu.x = pack2(s[o + 0], s[o + 1]); pu.y = pack2(s[o + 2], s[o + 3]);
  pu.z = pack2(s[o + 4], s[o + 5]); pu.w = pack2(s[o + 6], s[o + 7]);
  return __builtin_bit_cast(bf16x8, pu);
}
__device__ __forceinline__ void attn_qk(const u16* kp, const bf16x8 (&qa)[6], f32x16& s0, f32x16& s1) {
#pragma unroll
  for (int ks = 0; ks < 6; ++ks) {
    bf16x8 k0 = *(const bf16x8*)(kp + ks * 16);
    bf16x8 k1 = *(const bf16x8*)(kp + 32 * KLD + ks * 16);
    s0 = mfma32(k0, qa[ks], s0);
    s1 = mfma32(k1, qa[ks], s1);
  }
}
__device__ __forceinline__ void attn_tile(const u16* sb, const bf16x8 (&qa)[6], f32x16& o0, f32x16& o1, f32x16& lacc,
                                          float& m, bool& mz, int r, int h, bool first) {
  const u16* kp = sb + r * KLD + h * 8;
  f32x16 s0, s1;
  __builtin_amdgcn_s_setprio(1);
  if (mz) {
#pragma unroll
    for (int i = 0; i < 16; ++i) { s0[i] = 0.f; s1[i] = 0.f; }
    attn_qk(kp, qa, s0, s1);
  } else {
#pragma unroll
    for (int i = 0; i < 16; ++i) { s0[i] = -m; s1[i] = -m; }
    attn_qk(kp, qa, s0, s1);
  }
  __builtin_amdgcn_s_setprio(0);
  float mxa = max3f(s0[0], s0[1], s0[2]), mxb = max3f(s0[3], s0[4], s0[5]);
  float mxc = max3f(s0[6], s0[7], s0[8]), mxd = max3f(s0[9], s0[10], s0[11]);
  mxa = max3f(mxa, s0[12], s0[13]); mxb = max3f(mxb, s0[14], s0[15]);
  mxc = max3f(mxc, s1[0], s1[1]); mxd = max3f(mxd, s1[2], s1[3]);
  mxa = max3f(mxa, s1[4], s1[5]); mxb = max3f(mxb, s1[6], s1[7]);
  mxc = max3f(mxc, s1[8], s1[9]); mxd = max3f(mxd, s1[10], s1[11]);
  mxa = max3f(mxa, s1[12], s1[13]); mxb = max3f(mxb, s1[14], s1[15]);
  const float lm = max3f(mxa, mxb, fmaxf(mxc, mxd));
  bool slow;
  if (first) {
    const float mx = fmaxf(lm, __shfl_xor(lm, 32));
    slow = __any(mx > 30.f || mx < -30.f);
  } else {
    slow = __any(lm > 30.f);
  }
  if (slow) {
    const float mx = fmaxf(lm, __shfl_xor(lm, 32));
    const float d = first ? mx : fmaxf(mx, 0.f);
    const float alpha = first ? 1.f : __builtin_amdgcn_exp2f(-d);
    m += d;
    mz = false;
#pragma unroll
    for (int i = 0; i < 16; ++i) { s0[i] -= d; s1[i] -= d; o0[i] *= alpha; o1[i] *= alpha; }
    lacc[0] *= alpha;
  }
  float pa = 0.f, pb = 0.f, pc = 0.f, pd = 0.f;
#pragma unroll
  for (int i = 0; i < 16; ++i) {
    s0[i] = __builtin_amdgcn_exp2f(s0[i]); s1[i] = __builtin_amdgcn_exp2f(s1[i]);
    if ((i & 3) == 0) pa += s0[i] + s1[i];
    else if ((i & 3) == 1) pb += s0[i] + s1[i];
    else if ((i & 3) == 2) pc += s0[i] + s1[i];
    else pd += s0[i] + s1[i];
  }
  lacc[0] += (pa + pb) + (pc + pd);
  const u16* vp = sb + 64 * KLD + r * VLD + 8 * h;
  __builtin_amdgcn_s_setprio(1);
#pragma unroll
  for (int kb = 0; kb < 2; ++kb) {
#pragma unroll
    for (int s = 0; s < 2; ++s) {
      const bf16x8 pf = pack_p(kb == 0 ? s0 : s1, 8 * s);
      const int koff = kb * 32 + 16 * s;
      const bf16x8 v0 = *(const bf16x8*)(vp + koff);
      const bf16x8 v1 = *(const bf16x8*)(vp + 32 * VLD + koff);
      o0 = mfma32(v0, pf, o0);
      o1 = mfma32(v1, pf, o1);
    }
  }
  __builtin_amdgcn_s_setprio(0);
}
__device__ __forceinline__ void attn_write_o(u16* op, const f32x16& o0, const f32x16& o1, float inv) {
#pragma unroll
  for (int g = 0; g < 4; ++g) {
    uint2 v;
    v.x = pack2(o0[4 * g] * inv, o0[4 * g + 1] * inv); v.y = pack2(o0[4 * g + 2] * inv, o0[4 * g + 3] * inv);
    *(uint2*)(op + 8 * g) = v;
    v.x = pack2(o1[4 * g] * inv, o1[4 * g + 1] * inv); v.y = pack2(o1[4 * g + 2] * inv, o1[4 * g + 3] * inv);
    *(uint2*)(op + 32 + 8 * g) = v;
  }
}

__device__ void item_attn(PP p, int qb, int b, int hh, u16* lds) {
  p = launder(p);
  const int tid = opaque_tid(), lane = tid & 63, w = tid >> 6, r = lane & 31, h = lane >> 5;
  const size_t tokbase = (size_t)b * SEQ;
  const int q0 = qb * 128 + w * 32;
  bf16x8 qa[6];
  {
    const u16* qp = p->Q + ((tokbase + q0 + r) * 6 + hh) * 96 + h * 8;
#pragma unroll
    for (int ks = 0; ks < 6; ++ks) qa[ks] = *(const bf16x8*)(qp + ks * 16);
  }
  f32x16 oa0, oa1, lacc;
#pragma unroll
  for (int i = 0; i < 16; ++i) { oa0[i] = 0.f; oa1[i] = 0.f; lacc[i] = 0.f; }
  float ma = 0.f;
  bool mz = true;
  const int ntiles = 2 * qb + 2;
  const int my_ntiles = 2 * qb + 1 + (w >> 1);
  const u16* kg = p->K + (size_t)(b * 6 + hh) * SEQ * 96 + tid * 8;
  const u16* vg = p->VT + (size_t)(b * 6 + hh) * SEQ * 64 + tid * 8;
  const int id1 = tid + 256, id2 = tid + 512;
  const int kl0 = (tid / 12) * KLD + (tid % 12) * 8;
  const int kl1 = (id1 / 12) * KLD + (id1 % 12) * 8;
  const int kl2 = (id2 / 12) * KLD + (id2 % 12) * 8;
  const int vl = 64 * KLD + (tid >> 3) * VLD + (tid & 7) * 8;
  AStage A, B;
  as_load(B, kg, vg, 0);
  as_load(A, kg, vg, 1);
  as_store(B, lds, kl0, kl1, kl2, vl);
  __syncthreads();
  for (int kt = 0; kt < ntiles; kt += 2) {
    if (kt + 2 < ntiles) as_load(B, kg, vg, kt + 2);
    attn_tile(lds, qa, oa0, oa1, lacc, ma, mz, r, h, kt == 0);
    as_store(A, lds + ATT_STAGE, kl0, kl1, kl2, vl);
    __syncthreads();
    if (kt + 3 < ntiles) as_load(A, kg, vg, kt + 3);
    if (kt + 1 < my_ntiles) attn_tile(lds + ATT_STAGE, qa, oa0, oa1, lacc, ma, mz, r, h, false);
    if (kt + 2 < ntiles) as_store(B, lds, kl0, kl1, kl2, vl);
    __syncthreads();
  }
  const float lta = lacc[0] + __shfl_xor(lacc[0], 32);
  u16* op = p->obuf + (tokbase + q0 + r) * 384 + hh * 64 + 4 * h;
  attn_write_o(op, oa0, oa1, 1.f / lta);
}

__device__ void phase_y(PP p, int l) {
  p = launder(p);
  const int tid_ = opaque_tid();
  const int lane = tid_ & 63;
  const int gw = blockIdx.x * 4 + (tid_ >> 6), nw = gridDim.x * 4;
  const float* bg = p->br_g + l * DM + lane * 16;
  const int seg = (lane < 24) ? 0 : (lane < 48) ? 1 : 2;
  const u16* xbase; const u16* gbase; size_t xs, gs;
  if (seg == 0) { xbase = p->hloc + lane * 16; xs = 384; gbase = p->proj + C_GA + lane * 16; gs = DINP; }
  else if (seg == 1) { xbase = p->obuf + (lane - 24) * 16; xs = 384; gbase = p->proj + C_GB + (lane - 24) * 16; gs = DINP; }
  else { xbase = p->ycpre + (lane - 48) * 16; xs = 256; gbase = xbase; gs = 256; }
  for (int tok0 = gw; tok0 < T_TOK; tok0 += 2 * nw) {
    const int tok1 = (tok0 + nw < T_TOK) ? tok0 + nw : tok0;
    uint4 xr[2][2], gr[2][2], cr_[2][2];
    float4 cy[2][4];
#pragma unroll
    for (int t = 0; t < 2; ++t) {
      const size_t tok = (size_t)(t ? tok1 : tok0);
      xr[t][0] = *(const uint4*)(xbase + tok * xs); xr[t][1] = *(const uint4*)(xbase + tok * xs + 8);
      gr[t][0] = *(const uint4*)(gbase + tok * gs); gr[t][1] = *(const uint4*)(gbase + tok * gs + 8);
    }
    if (seg == 0) {
#pragma unroll
      for (int t = 0; t < 2; ++t) {
        const size_t tok = (size_t)(t ? tok1 : tok0);
        cr_[t][0] = *(const uint4*)(p->cum + tok * 384 + lane * 16); cr_[t][1] = *(const uint4*)(p->cum + tok * 384 + lane * 16 + 8);
        const float* cp = p->carry + (tok >> 6) * 384 + lane * 16;
#pragma unroll
        for (int i = 0; i < 4; ++i) cy[t][i] = *(const float4*)(cp + 4 * i);
      }
    }
#pragma unroll
    for (int t = 0; t < 2; ++t) {
      const size_t tok = (size_t)(t ? tok1 : tok0);
      float v[16], g[16];
      unpack8(xr[t][0], v); unpack8(xr[t][1], v + 8);
      unpack8(gr[t][0], g); unpack8(gr[t][1], g + 8);
      if (seg == 0) {
        float cm[16];
        unpack8(cr_[t][0], cm); unpack8(cr_[t][1], cm + 8);
#pragma unroll
        for (int i = 0; i < 4; ++i) {
          v[4 * i] += cm[4 * i] * cy[t][i].x; v[4 * i + 1] += cm[4 * i + 1] * cy[t][i].y;
          v[4 * i + 2] += cm[4 * i + 2] * cy[t][i].z; v[4 * i + 3] += cm[4 * i + 3] * cy[t][i].w;
        }
      }
      if (seg < 2) {
#pragma unroll
        for (int j = 0; j < 16; ++j) v[j] *= siluf_(g[j]);
      }
      float ss = 0.f;
#pragma unroll
      for (int j = 0; j < 16; ++j) ss += v[j] * v[j];
      const float sa = wave_sum(seg == 0 ? ss : 0.f);
      const float sb = wave_sum(seg == 1 ? ss : 0.f);
      const float sc = wave_sum(seg == 2 ? ss : 0.f);
      const float rs = (seg == 0) ? rsqrtf(sa * (1.f / 384.f) + EPSF)
                     : (seg == 1) ? rsqrtf(sb * (1.f / 384.f) + EPSF) : rsqrtf(sc * (1.f / 256.f) + EPSF);
      float o[16];
#pragma unroll
      for (int j = 0; j < 16; ++j) o[j] = v[j] * rs * bg[j];
      *(uint4*)(p->hbuf + tok * DM + lane * 16) = pack8(o);
      *(uint4*)(p->hbuf + tok * DM + lane * 16 + 8) = pack8(o + 8);
    }
  }
}

__device__ __forceinline__ int next_item(int* counter, int* slot) {
  __syncthreads();
  if (threadIdx.x == 0) *slot = atomicAdd(counter, 1);
  __syncthreads();
  return *slot;
}


#define XB_TMO      128
#define XB_XCNT(j)  (256  + 64 * (j))
#define XB_XSUB(j)  (1280 + 64 * (j))
#define XB_XGEN(j)  (2304 + 64 * (j))
#define XB_TOP      3328
#define XB_TOPGEN   3392
#define XCD_BAR_WORDS 3456
#define XB_SPIN_CAP (1u << 18)
#define LAS __attribute__((address_space(3)))
__device__ __forceinline__ unsigned xb_ld(unsigned* p)              { return __hip_atomic_load(p, __ATOMIC_RELAXED, __HIP_MEMORY_SCOPE_AGENT); }
__device__ __forceinline__ unsigned xb_add(unsigned* p, unsigned v) { return __hip_atomic_fetch_add(p, v, __ATOMIC_RELAXED, __HIP_MEMORY_SCOPE_AGENT); }
__device__ __forceinline__ unsigned xb_xcc_id() { return (unsigned)__builtin_amdgcn_s_getreg((3 << 11) | 20) & 0xFu; }
#define XB_SPIN(cond, bar) do { unsigned _sp = 0; while (cond) { __builtin_amdgcn_s_sleep(1); \
    if ((++_sp & 255u) == 0u) { if (xb_ld(&(bar)[XB_TMO])) break; if (_sp > XB_SPIN_CAP) { atomicAdd(&(bar)[XB_TMO], 1u); break; } } } } while (0)
struct XcdBarrier { unsigned* bar; unsigned x; volatile LAS unsigned* st; };
__device__ __forceinline__ XcdBarrier xcd_barrier_post(unsigned* bar, volatile LAS unsigned* st) {
    XcdBarrier b; b.bar = bar; b.x = xb_xcc_id(); b.st = st;
    if (threadIdx.x == 0) (void)xb_add(&bar[XB_XCNT(b.x)], 1u);
    return b;
}
__device__ __forceinline__ void xcd_barrier_complete(unsigned* bar, unsigned x, unsigned& nloc, unsigned& nx) {
    const unsigned G = gridDim.x * gridDim.y * gridDim.z;
    unsigned sum, cnt, mine, sp = 0u;
    for (;;) {
        sum = 0u; cnt = 0u; mine = 0u;
#pragma unroll
        for (unsigned j = 0; j < 16; ++j) { const unsigned c = xb_ld(&bar[XB_XCNT(j)]); sum += c; cnt += (c > 0u) ? 1u : 0u; mine = (j == x) ? c : mine; }
        if (sum == G) break;
        __builtin_amdgcn_s_sleep(1);
        if ((++sp & 255u) == 0u) { if (xb_ld(&bar[XB_TMO])) break; if (sp > XB_SPIN_CAP) { atomicAdd(&bar[XB_TMO], 1u); break; } }
    }
    nloc = mine > 0u ? mine : 1u; nx = cnt > 0u ? cnt : 1u;
}
__device__ __forceinline__ void xcd_barrier(const XcdBarrier& b) {
    asm volatile("s_waitcnt vmcnt(0)" ::: "memory");
    __syncthreads();
    if (threadIdx.x == 0) {
        unsigned* bar = b.bar;
        __builtin_amdgcn_s_waitcnt(0);
        unsigned nloc = b.st[0], nx = b.st[1];
        if (nloc == 0u) { xcd_barrier_complete(bar, b.x, nloc, nx); b.st[0] = nloc; b.st[1] = nx; }
        const unsigned old = xb_add(&bar[XB_XSUB(b.x)], 1u);
        const unsigned gen = old / nloc;
        if (old + 1u == (gen + 1u) * nloc) {
            __builtin_amdgcn_fence(__ATOMIC_RELEASE, "agent");
            asm volatile("s_waitcnt vmcnt(0)" ::: "memory");
            const unsigned og = xb_add(&bar[XB_TOP], 1u);
            const unsigned tg = og / nx;
            if (og + 1u == (tg + 1u) * nx) xb_add(&bar[XB_TOPGEN], 1u);
            else XB_SPIN(xb_ld(&bar[XB_TOPGEN]) == tg, bar);
            __builtin_amdgcn_fence(__ATOMIC_ACQUIRE, "agent");
            xb_add(&bar[XB_XGEN(b.x)], 1u);
            asm volatile("s_waitcnt vmcnt(0)" ::: "memory");
        } else {
            XB_SPIN(xb_ld(&bar[XB_XGEN(b.x)]) == gen, bar);
            __builtin_amdgcn_fence(__ATOMIC_ACQUIRE, "agent");
            asm volatile("s_waitcnt vmcnt(0)" ::: "memory");
        }
    }
    __syncthreads();
}

#define N_PHASES (1 + 6 * NLAYER + 1)

__device__ void run_phase(PP p, int ph, u16* lds, float* ssm, int* slot, int rep) {
  int l = (ph - 1) / 6, sub = (ph - 1) % 6 + 1;
  if (ph == 0) { sub = 0; l = 0; }
  if (ph == N_PHASES - 1) { sub = 1; l = NLAYER; }
#ifdef ONLYSUB
  sub = ONLYSUB;
#endif
  const int bid = blockIdx.x, nb = gridDim.x;
  if (sub == 0) { phase_prep(p, (float*)lds); return; }
  if (sub == 1) { phase_norm(p, l); return; }
  if (sub == 2) {
    gemm_phase(p->wInT + (size_t)l * DINP * DM, DM, p->hbuf, DM, DM, p->proj, DINP, 18, 256 * 18, lds);
    return;
  }
  if (sub == 3) {
    int* ctr = p->counters + l * 16 + rep * 64;
    for (;;) {
      int it = next_item(ctr, slot);
      if (it >= 256 + 1536 + 1536 + 3072) break;
#ifdef ONLYITEM
      it = (ONLYITEM == 0) ? (it & 255) : (ONLYITEM == 1) ? 256 + (it & 1023) : (ONLYITEM == 2) ? 256 + 1536 + (it & 1023) : 256 + 3072 + (it & 2047);
#endif
#ifdef REPEAT_ITEM
      if (rep == 1) { const int ty = (it < 256) ? 0 : (it < 256 + 1536) ? 1 : (it < 256 + 3072) ? 2 : 3; if (ty != REPEAT_ITEM) continue; }
#endif
      if (it < 256) item_sgu(p, l, it, lds, ssm);
      else if (it < 256 + 1536) { const int k = it - 256; item_q(p, l, k / 6, k % 6, lds, ssm); }
      else if (it < 256 + 3072) { const int k = it - 256 - 1536; item_kv(p, l, k / 6, k % 6, lds, ssm); }
      else { const int k = it - 256 - 3072; item_lru(p, l, k / 6, k % 6, lds, ssm); }
    }
    return;
  }
  if (sub == 4) {
    if (bid < 6) item_carry(p, bid);
    const int xq = (int)(xb_xcc_id() & 7u);
    int* cbase = p->counters + l * 16 + 8 + rep * 64;
    for (;;) {
      __syncthreads();
      if (threadIdx.x == 0) {
        int got = -1;
        for (int dq = 0; dq < 8 && got < 0; ++dq) {
          const int q = (xq + dq) & 7;
          if (__hip_atomic_load(cbase + q, __ATOMIC_RELAXED, __HIP_MEMORY_SCOPE_AGENT) < 192) {
            const int it = atomicAdd(cbase + q, 1);
            if (it < 192) got = q * 256 + it;
          }
        }
        *slot = got;
      }
      __syncthreads();
      const int got = *slot;
      if (got < 0) break;
      const int q = got >> 8, it = got & 255;
      int qb, bh;
      if (it < 64) { qb = 63 - it; bh = q * 3; }
      else { const int j = it - 64; qb = 63 - (j >> 1); bh = q * 3 + 1 + (j & 1); }
      item_attn(p, qb, bh / 6, bh % 6, lds);
    }
    return;
  }
  if (sub == 5) { phase_y(p, l); return; }
  gemm_phase(p->wOutT + (size_t)l * DM * DM, DM, p->hbuf, DM, DM, p->y2, DM, 8, 256 * 8, lds);
}

__global__ void __launch_bounds__(256, 2) mega_kernel(Params p, int ph_begin, int ph_end) {
  __shared__ __attribute__((aligned(16))) unsigned char lds_raw[LDS_BYTES];
  __shared__ float ssm[512];
  __shared__ int slot;
  u16* lds = (u16*)lds_raw;
  PP pp = (PP)__builtin_amdgcn_kernarg_segment_ptr();
#if COOP
  cg::grid_group grid = cg::this_grid();
  __shared__ uint4 xb_words;
  if (threadIdx.x == 0) xb_words = make_uint4(0u, 0u, 0u, 0u);
  __syncthreads();
  XcdBarrier xb = xcd_barrier_post(pp->bar, (volatile LAS unsigned*)&xb_words);
#endif
  int rep = 0;
  for (int ph = ph_begin; ph < ph_end;) {
    run_phase(launder(pp), ph, lds, ssm, &slot, rep);
    bool again = false;
#if COOP
#ifdef REPEAT_SUB
    if (ph > 0 && ph < N_PHASES - 1) {
      if (REPEAT_SUB == 99) { xcd_barrier(xb); xcd_barrier(xb); xcd_barrier(xb); xcd_barrier(xb); }
      else if (((ph - 1) % 6 + 1) == REPEAT_SUB && rep == 0) again = true;
    }
#endif
    if (again || ph + 1 < ph_end) {
      if (ph_end > 1000) grid.sync();
      xcd_barrier(xb);
    }
#endif
    if (again) rep = 1; else { rep = 0; ++ph; }
  }
}

extern "C" void kernel_launch(void* const* d_in, const int* in_sizes, int n_in, void* d_out, int out_size, void* d_ws,
                              size_t ws_size, hipStream_t stream) {
  Params p{};
  p.x = (const float*)d_in[0]; p.pos = (const int*)d_in[1]; p.pre_g = (const float*)d_in[2]; p.w_in = (const float*)d_in[3];
  p.conv_w = (const float*)d_in[4]; p.conv_b = (const float*)d_in[5]; p.lru_wa = (const float*)d_in[6]; p.lru_ba = (const float*)d_in[7];
  p.lru_wx = (const float*)d_in[8]; p.lru_bx = (const float*)d_in[9]; p.lru_lam = (const float*)d_in[10]; p.q_g = (const float*)d_in[11];
  p.w_uq = (const float*)d_in[12]; p.kv_g = (const float*)d_in[13]; p.w_ukv = (const float*)d_in[14]; p.sgu_g = (const float*)d_in[15];
  p.sgu_bn = (const float*)d_in[16]; p.sgu_w = (const float*)d_in[17]; p.sgu_b = (const float*)d_in[18]; p.br_g = (const float*)d_in[19];
  p.w_out = (const float*)d_in[20]; p.post_g = (const float*)d_in[21];
  p.out = (float*)d_out;
  unsigned char* ws = (unsigned char*)d_ws;
  size_t off = 0;
  auto take = [&](size_t bytes) { unsigned char* q = ws + off; off += (bytes + 255) & ~(size_t)255; return q; };
  p.counters = (int*)take(1024);
  p.bar = (unsigned*)take(XCD_BAR_WORDS * 4);
  p.wInT = (u16*)take((size_t)NLAYER * DINP * DM * 2);
  p.wOutT = (u16*)take((size_t)NLAYER * DM * DM * 2);
  p.wUqT = (u16*)take((size_t)NLAYER * 768 * 192 * 2);
  p.wUkvT = (u16*)take((size_t)NLAYER * 768 * 128 * 2);
  p.waT = (u16*)take((size_t)NLAYER * 6 * 4096 * 2);
  p.wxT = (u16*)take((size_t)NLAYER * 6 * 4096 * 2);
  p.sguW = (u16*)take((size_t)NLAYER * 4 * 128 * 128 * 2);
  p.tab = (float2*)take((size_t)T_TOK * 16 * 8);
  p.hbuf = (u16*)take((size_t)T_TOK * DM * 2);
  p.proj = (u16*)take((size_t)T_TOK * DINP * 2);
  p.y2 = (u16*)take((size_t)T_TOK * DM * 2);
  p.Q = (u16*)take((size_t)T_TOK * 576 * 2);
  p.K = (u16*)take((size_t)T_TOK * 576 * 2);
  p.VT = (u16*)take((size_t)T_TOK * 384 * 2);
  p.hloc = (u16*)take((size_t)T_TOK * 384 * 2);
  p.cum = (u16*)take((size_t)T_TOK * 384 * 2);
  p.Ptile = (float*)take((size_t)512 * 384 * 4);
  p.Htile = (float*)take((size_t)512 * 384 * 4);
  p.carry = (float*)take((size_t)512 * 384 * 4);
  p.obuf = (u16*)take((size_t)T_TOK * 384 * 2);
  p.ycpre = (u16*)take((size_t)T_TOK * 256 * 2);
  if (off > ws_size) { fprintf(stderr, "workspace too small: need %zu have %zu\n", off, ws_size); return; }

  static int grid_blocks = 0;
  if (!grid_blocks) {
    int dev = 0, cus = 0, per_cu = 0;
    hipGetDevice(&dev);
    hipDeviceGetAttribute(&cus, hipDeviceAttributeMultiprocessorCount, dev);
    hipOccupancyMaxActiveBlocksPerMultiprocessor(&per_cu, mega_kernel, 256, 0);
    if (per_cu > 2) per_cu = 2;
    if (per_cu < 1) per_cu = 1;
    grid_blocks = cus * per_cu;
  }
#if COOP
  (void)hipMemsetAsync(d_ws, 0, 1024 + ((XCD_BAR_WORDS * 4 + 255) & ~255), stream);
  int pb = 0, pe = N_PHASES;
  void* args[] = {&p, &pb, &pe};
  hipError_t e = hipLaunchCooperativeKernel((void*)mega_kernel, dim3(grid_blocks), dim3(256), args, 0, stream);
  if (e != hipSuccess) fprintf(stderr, "cooperative launch failed: %s (grid %d)\n", hipGetErrorString(e), grid_blocks);
#else
  for (int ph = 0; ph < N_PHASES; ++ph) mega_kernel<<<grid_blocks, 256, 0, stream>>>(p, ph, ph + 1);
#endif
}
```

```cpp
#include <hip/hip_runtime.h>
#include <hip/hip_cooperative_groups.h>
#include <stdint.h>
#include <stdio.h>
namespace cg = cooperative_groups;

typedef unsigned short u16;
typedef __attribute__((ext_vector_type(8))) short bf16x8;
typedef __attribute__((ext_vector_type(16))) float f32x16;
typedef __attribute__((ext_vector_type(4))) unsigned u32x4;
typedef __attribute__((ext_vector_type(2))) unsigned u32x2;

#ifndef COOP
#define COOP 1
#endif

#define T_TOK 32768
#define SEQ 8192
#define DM 1024
#define DIN 2272
#define DINP 2304
#define NLAYER 4
#define EPSF 1e-6f
#define C_XA 0
#define C_GA 384
#define C_QL 768
#define C_KVL 960
#define C_KR 1088
#define C_GB 1120
#define C_U 1504
#define C_V 1760
#define C_GC 2016

#define LDT 72
#define TILE_U16 (128 * LDT)
#define LDS_BYTES 73728

struct Params {
  const float* x; const int* pos; const float* pre_g; const float* w_in; const float* conv_w; const float* conv_b;
  const float* lru_wa; const float* lru_ba; const float* lru_wx; const float* lru_bx; const float* lru_lam;
  const float* q_g; const float* w_uq; const float* kv_g; const float* w_ukv; const float* sgu_g; const float* sgu_bn;
  const float* sgu_w; const float* sgu_b; const float* br_g; const float* w_out; const float* post_g;
  float* out;
  u16* wInT; u16* wOutT; u16* wUqT; u16* wUkvT; u16* waT; u16* wxT; u16* sguW;
  float2* tab; int* counters; unsigned* bar;
  u16* hbuf;
  u16* proj;
  u16* y2;
  u16* Q; u16* K; u16* VT;
  u16* hloc; u16* cum; float* Ptile; float* Htile; float* carry;
  u16* obuf; u16* ycpre;
};

__device__ const double c_invfreq_rev[16] = {1.59154943091895345608e-01, 8.94994016088910132600e-02, 5.03292121044870352509e-02, 2.83021958306233986646e-02, 1.59154943091895338669e-02, 8.94994016088910236684e-03, 5.03292121044870369856e-03, 2.83021958306233986646e-03, 1.59154943091895356017e-03, 8.94994016088910236684e-04, 5.03292121044870326488e-04, 2.83021958306233954120e-04, 1.59154943091895350596e-04, 8.94994016088910182474e-05, 5.03292121044870353593e-05, 2.83021958306233960897e-05};
typedef const __attribute__((address_space(4))) Params* PP;
__device__ __forceinline__ PP launder(PP q) { asm volatile("" : "+s"(q)); return q; }
__device__ __forceinline__ float bf2f(u16 b) { return __uint_as_float(((unsigned)b) << 16); }
typedef __attribute__((ext_vector_type(2))) __bf16 bf16x2_t;
__device__ __forceinline__ u16 f2bf(float f) { return __builtin_bit_cast(u16, (__bf16)f); }
__device__ __forceinline__ unsigned pack2(float a, float b) { bf16x2_t v = {(__bf16)a, (__bf16)b}; return __builtin_bit_cast(unsigned, v); }
__device__ __forceinline__ float lo16(unsigned u) { return __uint_as_float(u << 16); }
__device__ __forceinline__ float hi16(unsigned u) { return __uint_as_float(u & 0xffff0000u); }
__device__ __forceinline__ void unpack8(uint4 a, float* v) {
  v[0] = lo16(a.x); v[1] = hi16(a.x); v[2] = lo16(a.y); v[3] = hi16(a.y);
  v[4] = lo16(a.z); v[5] = hi16(a.z); v[6] = lo16(a.w); v[7] = hi16(a.w);
}
__device__ __forceinline__ uint4 pack8(const float* v) {
  uint4 a; a.x = pack2(v[0], v[1]); a.y = pack2(v[2], v[3]); a.z = pack2(v[4], v[5]); a.w = pack2(v[6], v[7]); return a;
}
__device__ __forceinline__ float sigmoidf_(float x) { return __builtin_amdgcn_rcpf(1.f + __expf(-x)); }
__device__ __forceinline__ float siluf_(float x) { return x * __builtin_amdgcn_rcpf(1.f + __expf(-x)); }
__device__ __forceinline__ float geluf_(float x) {
  float u = 1.5957691216057308f * (x + 0.044715f * x * x * x);
  return x * __builtin_amdgcn_rcpf(1.f + __expf(-u));
}
__device__ __forceinline__ float wave_sum(float v) {
#pragma unroll
  for (int o = 32; o >= 1; o >>= 1) v += __shfl_xor(v, o);
  return v;
}
__device__ __forceinline__ int opaque_tid() { int t = threadIdx.x; asm volatile("" : "+v"(t)); return t; }
__device__ __forceinline__ f32x16 mfma32(bf16x8 a, bf16x8 b, f32x16 c) {
  return __builtin_amdgcn_mfma_f32_32x32x16_bf16(a, b, c, 0, 0, 0);
}

struct GStage { u32x4 w0, w1, w2, w3, x0, x1, x2, x3; };
__device__ __forceinline__ void gs_load(GStage& g, const u16* gw, int ldw, const u16* gx, int ldx, int k0) {
  g.w0 = *(const u32x4*)(gw + k0);
  g.w1 = *(const u32x4*)(gw + (size_t)32 * ldw + k0);
  g.w2 = *(const u32x4*)(gw + (size_t)64 * ldw + k0);
  g.w3 = *(const u32x4*)(gw + (size_t)96 * ldw + k0);
  g.x0 = *(const u32x4*)(gx + k0);
  g.x1 = *(const u32x4*)(gx + (size_t)32 * ldx + k0);
  g.x2 = *(const u32x4*)(gx + (size_t)64 * ldx + k0);
  g.x3 = *(const u32x4*)(gx + (size_t)96 * ldx + k0);
}
__device__ __forceinline__ void gs_store(const GStage& g, u16* db, int lo) {
  *(u32x4*)(db + lo) = g.w0;
  *(u32x4*)(db + lo + 32 * LDT) = g.w1;
  *(u32x4*)(db + lo + 64 * LDT) = g.w2;
  *(u32x4*)(db + lo + 96 * LDT) = g.w3;
  *(u32x4*)(db + TILE_U16 + lo) = g.x0;
  *(u32x4*)(db + TILE_U16 + lo + 32 * LDT) = g.x1;
  *(u32x4*)(db + TILE_U16 + lo + 64 * LDT) = g.x2;
  *(u32x4*)(db + TILE_U16 + lo + 96 * LDT) = g.x3;
}
__device__ __forceinline__ void gemm_kstep(const u16* sb, int wn, int wt, int r, int h, f32x16 (&acc)[2][2]) {
  const u16* bw = sb + (wn * 64 + r) * LDT + h * 8;
  const u16* bx = sb + TILE_U16 + (wt * 64 + r) * LDT + h * 8;
  __builtin_amdgcn_s_setprio(1);
#pragma unroll
  for (int ks = 0; ks < 4; ++ks) {
    bf16x8 a0 = *(const bf16x8*)(bw + ks * 16);
    bf16x8 a1 = *(const bf16x8*)(bw + 32 * LDT + ks * 16);
    bf16x8 b0 = *(const bf16x8*)(bx + ks * 16);
    bf16x8 b1 = *(const bf16x8*)(bx + 32 * LDT + ks * 16);
    acc[0][0] = mfma32(a0, b0, acc[0][0]);
    acc[0][1] = mfma32(a0, b1, acc[0][1]);
    acc[1][0] = mfma32(a1, b0, acc[1][0]);
    acc[1][1] = mfma32(a1, b1, acc[1][1]);
  }
  __builtin_amdgcn_s_setprio(0);
}
__device__ __forceinline__ void gemm_tile(const u16* __restrict__ W, int ldw, const u16* __restrict__ X, int ldx,
                                          int K, u16* lds, f32x16 (&acc)[2][2]) {
  const int tid = opaque_tid(), lane = tid & 63, w = tid >> 6, r = lane & 31, h = lane >> 5;
  const int wn = w >> 1, wt = w & 1;
#pragma unroll
  for (int a = 0; a < 2; ++a)
#pragma unroll
    for (int b = 0; b < 2; ++b)
#pragma unroll
      for (int i = 0; i < 16; ++i) acc[a][b][i] = 0.f;
  const int lrow = tid >> 3, lc = tid & 7;
  const u16* gw = W + (size_t)lrow * ldw + lc * 8;
  const u16* gx = X + (size_t)lrow * ldx + lc * 8;
  const int lo = lrow * LDT + lc * 8;
  const int nk = K >> 6;
  GStage A, B;
  gs_load(B, gw, ldw, gx, ldx, 0);
  if (nk > 1) gs_load(A, gw, ldw, gx, ldx, 64);
  gs_store(B, lds, lo);
  __syncthreads();
  for (int kt = 0; kt < nk; kt += 2) {
    if (kt + 2 < nk) gs_load(B, gw, ldw, gx, ldx, (kt + 2) * 64);
    gemm_kstep(lds, wn, wt, r, h, acc);
    if (kt + 1 < nk) gs_store(A, lds + 2 * TILE_U16, lo);
    __syncthreads();
    if (kt + 1 < nk) {
      if (kt + 3 < nk) gs_load(A, gw, ldw, gx, ldx, (kt + 3) * 64);
      gemm_kstep(lds + 2 * TILE_U16, wn, wt, r, h, acc);
      if (kt + 2 < nk) gs_store(B, lds, lo);
      __syncthreads();
    }
  }
}

__device__ __forceinline__ void stage_f32(float* st, f32x16 (&acc)[2][2]) {
  const int tid = opaque_tid(), lane = tid & 63, w = tid >> 6, r = lane & 31, h = lane >> 5;
  const int wn = w >> 1, wt = w & 1;
#pragma unroll
  for (int nb = 0; nb < 2; ++nb)
#pragma unroll
    for (int tb = 0; tb < 2; ++tb) {
      const int token = wt * 64 + tb * 32 + r;
#pragma unroll
      for (int g = 0; g < 4; ++g) {
        const int n0 = wn * 64 + nb * 32 + 8 * g + 4 * h;
        float4 v = make_float4(acc[nb][tb][4 * g], acc[nb][tb][4 * g + 1], acc[nb][tb][4 * g + 2], acc[nb][tb][4 * g + 3]);
        *(float4*)(st + token * 132 + n0) = v;
      }
    }
}
__device__ __forceinline__ void stage_bf16(u16* st, f32x16 (&acc)[2][2]) {
  const int tid = opaque_tid(), lane = tid & 63, w = tid >> 6, r = lane & 31, h = lane >> 5;
  const int wn = w >> 1, wt = w & 1;
#pragma unroll
  for (int nb = 0; nb < 2; ++nb)
#pragma unroll
    for (int tb = 0; tb < 2; ++tb) {
      const int token = wt * 64 + tb * 32 + r;
#pragma unroll
      for (int g = 0; g < 4; ++g) {
        const int n0 = wn * 64 + nb * 32 + 8 * g + 4 * h;
        uint2 v;
        v.x = pack2(acc[nb][tb][4 * g], acc[nb][tb][4 * g + 1]);
        v.y = pack2(acc[nb][tb][4 * g + 2], acc[nb][tb][4 * g + 3]);
        *(uint2*)(st + token * 136 + n0) = v;
      }
    }
}

__device__ void gemm_store_tile(const u16* W, int ldw, const u16* X, int ldx, int K, u16* out, int ldo, u16* lds) {
  f32x16 acc[2][2];
  gemm_tile(W, ldw, X, ldx, K, lds, acc);
  stage_bf16(lds, acc);
  __syncthreads();
  const int tid = opaque_tid();
#pragma unroll
  for (int i = 0; i < 8; ++i) {
    const int id = tid + 256 * i;
    const int row = id >> 4, c = id & 15;
    uint4 v = *(const uint4*)(lds + row * 136 + c * 8);
    *(uint4*)(out + (size_t)row * ldo + c * 8) = v;
  }
  __syncthreads();
}

__device__ void gemm_phase(const u16* __restrict__ Wb, int ldw, const u16* __restrict__ Xb, int ldx, int K,
                           u16* __restrict__ outb, int ldo, int ntn, int ntiles, u16* lds) {
  const int tid = opaque_tid(), lane = tid & 63, w = tid >> 6, r = lane & 31, h = lane >> 5;
  const int wn = w >> 1, wt = w & 1;
  const int lrow = tid >> 3, lc = tid & 7;
  const int lo = lrow * LDT + lc * 8;
  const int nk = K >> 6;
  const int nbl = gridDim.x >> 3;
  const int xl = blockIdx.x & 7, jl = blockIdx.x >> 3;
  const int mt_per = (ntiles / ntn) >> 3;
  const int L = mt_per * ntn;
  int q = jl;
  if (q >= L) return;
#define GP_MT(qq) (xl * mt_per + ((qq) / (8 * ntn)) * 8 + ((qq) % (8 * ntn)) % 8)
#define GP_NT(qq) (((qq) % (8 * ntn)) / 8)
  const u16* gw = Wb + (size_t)(GP_NT(q) * 128 + lrow) * ldw + lc * 8;
  const u16* gx = Xb + (size_t)(GP_MT(q) * 128 + lrow) * ldx + lc * 8;
  GStage A, B;
  gs_load(B, gw, ldw, gx, ldx, 0);
  gs_load(A, gw, ldw, gx, ldx, 64);
  for (; q < L; q += nbl) {
    const int qn = q + nbl;
    const bool has_next = qn < L;
    const int qq = has_next ? qn : q;
    const u16* gwn = Wb + (size_t)(GP_NT(qq) * 128 + lrow) * ldw + lc * 8;
    const u16* gxn = Xb + (size_t)(GP_MT(qq) * 128 + lrow) * ldx + lc * 8;
    f32x16 acc[2][2];
#pragma unroll
    for (int a = 0; a < 2; ++a)
#pragma unroll
      for (int b = 0; b < 2; ++b)
#pragma unroll
        for (int i = 0; i < 16; ++i) acc[a][b][i] = 0.f;
    gs_store(B, lds, lo);
    __syncthreads();
    for (int kt = 0; kt < nk; kt += 2) {
      if (kt + 2 < nk) gs_load(B, gw, ldw, gx, ldx, (kt + 2) * 64);
      else if (has_next) gs_load(B, gwn, ldw, gxn, ldx, 0);
      gemm_kstep(lds, wn, wt, r, h, acc);
      gs_store(A, lds + 2 * TILE_U16, lo);
      __syncthreads();
      if (kt + 3 < nk) gs_load(A, gw, ldw, gx, ldx, (kt + 3) * 64);
      else if (has_next) gs_load(A, gwn, ldw, gxn, ldx, 64);
      gemm_kstep(lds + 2 * TILE_U16, wn, wt, r, h, acc);
      if (kt + 2 < nk) gs_store(B, lds, lo);
      __syncthreads();
    }
    stage_bf16(lds, acc);
    __syncthreads();
    u16* out = outb + (size_t)GP_MT(q) * 128 * ldo + GP_NT(q) * 128;
#pragma unroll
    for (int i = 0; i < 8; ++i) {
      const int id = tid + 256 * i;
      const int row = id >> 4, c = id & 15;
      uint4 v = *(const uint4*)(lds + row * 136 + c * 8);
      *(uint4*)(out + (size_t)row * ldo + c * 8) = v;
    }
    __syncthreads();
    gw = gwn; gx = gxn;
  }
#undef GP_MT
#undef GP_NT
}

__device__ void prep_transpose(const float* __restrict__ src, size_t sstride, int nmat, int R, int C, u16* __restrict__ dst,
                               size_t dstride, int dld, const float* __restrict__ gk, int mode, float* tile, int bid, int nb) {
  const int tid = opaque_tid();
  const int tr = R >> 6, tc = (C + 63) >> 6;
  const int per = tr * tc;
  for (int t = bid; t < per * nmat; t += nb) {
    const int m = t / per, tt = t % per;
    const int r0 = (tt / tc) * 64, c0 = (tt % tc) * 64;
    const float* sm = src + (size_t)m * sstride;
    u16* dm = dst + (size_t)m * dstride;
    __syncthreads();
#pragma unroll
    for (int i = 0; i < 16; ++i) {
      const int rr = i * 4 + (tid >> 6), cc = tid & 63;
      float v = 0.f;
      if (c0 + cc < C) {
        v = sm[(size_t)(r0 + rr) * C + c0 + cc];
        if (gk) v *= gk[m * R + r0 + rr];
      }
      tile[rr * 65 + cc] = v;
    }
    __syncthreads();
#pragma unroll
    for (int i = 0; i < 16; ++i) {
      const int cc = i * 4 + (tid >> 6), rr = tid & 63;
      const int c = c0 + cc;
      if (c < C) {
        const int n = (mode == 1) ? (c / 96) * 128 + (c % 96) : c;
        dm[(size_t)n * dld + r0 + rr] = f2bf(tile[rr * 65 + cc]);
      }
    }
  }
}
__device__ void phase_prep(PP p, float* ldsf) {
  p = launder(p);
  const int bid = blockIdx.x, nb = gridDim.x, tid = opaque_tid();
  const int gtid = bid * 256 + tid, gn = nb * 256;
  if (bid == 0) p->counters[tid] = 0;
  prep_transpose(p->w_in, (size_t)DM * DIN, NLAYER, DM, DIN, p->wInT, (size_t)DINP * DM, DM, nullptr, 0, ldsf, bid, nb);
  prep_transpose(p->w_out, (size_t)DM * DM, NLAYER, DM, DM, p->wOutT, (size_t)DM * DM, DM, nullptr, 0, ldsf, (bid + 256) % nb, nb);
  prep_transpose(p->w_uq, (size_t)192 * 576, NLAYER, 192, 576, p->wUqT, (size_t)768 * 192, 192, p->q_g, 1, ldsf, (bid + 128) % nb, nb);
  prep_transpose(p->w_ukv, (size_t)128 * 768, NLAYER, 128, 768, p->wUkvT, (size_t)768 * 128, 128, p->kv_g, 0, ldsf, (bid + 384) % nb, nb);
  prep_transpose(p->lru_wa, 4096, NLAYER * 6, 64, 64, p->waT, 4096, 64, nullptr, 0, ldsf, (bid + 64) % nb, nb);
  prep_transpose(p->lru_wx, 4096, NLAYER * 6, 64, 64, p->wxT, 4096, 64, nullptr, 0, ldsf, (bid + 192) % nb, nb);
  for (int i = gtid; i < NLAYER * 32 * DM; i += gn) {
    const int l = i / (32 * DM), rem = i % (32 * DM);
    p->wInT[(size_t)l * DINP * DM + (size_t)DIN * DM + rem] = 0;
  }
  for (int i = gtid; i < NLAYER * 6 * 32 * 192; i += gn) {
    const int l = i / (6 * 32 * 192), rem = i % (6 * 32 * 192);
    const int hd = rem / (32 * 192), rem2 = rem % (32 * 192);
    p->wUqT[(size_t)l * 768 * 192 + (size_t)(hd * 128 + 96) * 192 + rem2] = 0;
  }
  for (int i = gtid; i < NLAYER * 4 * 128 * 128; i += gn) {
    const int ii = (i >> 7) & 127, jj = i & 127;
    const float v = (ii >= 64 || jj < 64) ? p->sgu_w[i] : 0.f;
    p->sguW[i] = f2bf(v);
  }
  for (int i = gtid; i < T_TOK * 16; i += gn) {
    const int t = i >> 4, k = i & 15;
    const double rev = (double)p->pos[t] * c_invfreq_rev[k];
    const double fr = rev - __builtin_rint(rev);
    const float f = (float)fr;
    p->tab[i] = make_float2(__builtin_amdgcn_cosf(f), __builtin_amdgcn_sinf(f));
  }
}

typedef __attribute__((ext_vector_type(4))) float f32x4;
__device__ void phase_norm(PP p, int l) {
  p = launder(p);
  const int tid_ = opaque_tid();
  const int lane = tid_ & 63;
  const int gw = blockIdx.x * 4 + (tid_ >> 6), nw = gridDim.x * 4;
  const float* xin = (l == 0) ? p->x : p->out;
  const float* gpost = p->post_g + (l > 0 ? l - 1 : 0) * DM;
  const float* gpre = p->pre_g + (l < NLAYER ? l : 0) * DM;
  constexpr int NTK = 4;
  for (int tok0 = gw; tok0 < T_TOK; tok0 += NTK * nw) {
    f32x4 xv[NTK][4];
    u32x2 yu[NTK][4];
#pragma unroll
    for (int t = 0; t < NTK; ++t) {
      const int tok = (tok0 + t * nw < T_TOK) ? tok0 + t * nw : tok0;
#pragma unroll
      for (int i = 0; i < 4; ++i) xv[t][i] = __builtin_nontemporal_load((const f32x4*)(xin + (size_t)tok * DM + i * 256 + lane * 4));
    }
    if (l > 0) {
#pragma unroll
      for (int t = 0; t < NTK; ++t) {
        const int tok = (tok0 + t * nw < T_TOK) ? tok0 + t * nw : tok0;
#pragma unroll
        for (int i = 0; i < 4; ++i) yu[t][i] = __builtin_nontemporal_load((const u32x2*)(p->y2 + (size_t)tok * DM + i * 256 + lane * 4));
      }
    }
#pragma unroll
    for (int t = 0; t < NTK; ++t) {
      const int tok = (tok0 + t * nw < T_TOK) ? tok0 + t * nw : tok0;
      if (l > 0) {
        float yv[16];
        float ss = 0.f;
#pragma unroll
        for (int i = 0; i < 4; ++i) {
          yv[4 * i] = lo16(yu[t][i].x); yv[4 * i + 1] = hi16(yu[t][i].x); yv[4 * i + 2] = lo16(yu[t][i].y); yv[4 * i + 3] = hi16(yu[t][i].y);
          ss += yv[4 * i] * yv[4 * i] + yv[4 * i + 1] * yv[4 * i + 1] + yv[4 * i + 2] * yv[4 * i + 2] + yv[4 * i + 3] * yv[4 * i + 3];
        }
        ss = wave_sum(ss);
        const float rs = rsqrtf(ss * (1.f / 1024.f) + EPSF);
#pragma unroll
        for (int i = 0; i < 4; ++i) {
          float4 gv = *(const float4*)(gpost + i * 256 + lane * 4);
          xv[t][i].x += yv[4 * i] * rs * gv.x; xv[t][i].y += yv[4 * i + 1] * rs * gv.y;
          xv[t][i].z += yv[4 * i + 2] * rs * gv.z; xv[t][i].w += yv[4 * i + 3] * rs * gv.w;
        }
      }
#pragma unroll
      for (int i = 0; i < 4; ++i) __builtin_nontemporal_store(xv[t][i], (f32x4*)(p->out + (size_t)tok * DM + i * 256 + lane * 4));
      if (l < NLAYER) {
        float ss = 0.f;
#pragma unroll
        for (int i = 0; i < 4; ++i) ss += xv[t][i].x * xv[t][i].x + xv[t][i].y * xv[t][i].y + xv[t][i].z * xv[t][i].z + xv[t][i].w * xv[t][i].w;
        ss = wave_sum(ss);
        const float rs = rsqrtf(ss * (1.f / 1024.f) + EPSF);
#pragma unroll
        for (int i = 0; i < 4; ++i) {
          float4 gv = *(const float4*)(gpre + i * 256 + lane * 4);
          uint2 u;
          u.x = pack2(xv[t][i].x * rs * gv.x, xv[t][i].y * rs * gv.y);
          u.y = pack2(xv[t][i].z * rs * gv.z, xv[t][i].w * rs * gv.w);
          *(uint2*)(p->hbuf + (size_t)tok * DM + i * 256 + lane * 4) = u;
        }
      }
    }
  }
}

__device__ void item_q(PP p, int l, int rt, int hd, u16* lds, float* ssm, bool do_rstd) {
  p = launder(p);
  const int tid = opaque_tid();
  const int m0 = rt * 128;
  if (do_rstd) {
    const int row = tid >> 1, half = tid & 1;
    const u16* src = p->proj + (size_t)(m0 + row) * DINP + C_QL + half * 96;
    float ss = 0.f;
#pragma unroll
    for (int i = 0; i < 12; ++i) {
      float v[8]; unpack8(*(const uint4*)(src + i * 8), v);
#pragma unroll
      for (int j = 0; j < 8; ++j) ss += v[j] * v[j];
    }
    ss += __shfl_xor(ss, 1);
    if (half == 0) ssm[row] = rsqrtf(ss * (1.f / 192.f) + EPSF);
  }
  f32x16 acc[2][2];
  gemm_tile(p->wUqT + (size_t)l * 768 * 192 + (size_t)hd * 128 * 192, 192, p->proj + (size_t)m0 * DINP + C_QL, DINP, 192, lds, acc);
  float* st = (float*)lds;
  stage_f32(st, acc);
  __syncthreads();
  const float qscale = 0.10206207261596577f * 1.4426950408889634f;
#pragma unroll
  for (int i = 0; i < 6; ++i) {
    const int u = tid + 256 * i;
    const int row = u / 12, dg = u % 12;
    const float sc = ssm[row] * qscale;
    const float* sr = st + row * 132;
    float o[8];
    if (dg < 8) {
      const float4 a = *(const float4*)(sr + dg * 8), bq = *(const float4*)(sr + dg * 8 + 4);
      o[0] = a.x * sc; o[1] = a.y * sc; o[2] = a.z * sc; o[3] = a.w * sc;
      o[4] = bq.x * sc; o[5] = bq.y * sc; o[6] = bq.z * sc; o[7] = bq.w * sc;
    } else {
      const int i0 = (dg & 1) * 8;
      const float2* tb = p->tab + (size_t)(m0 + row) * 16 + i0;
      const float4 a0 = *(const float4*)(sr + 64 + i0), a1 = *(const float4*)(sr + 68 + i0);
      const float4 b0 = *(const float4*)(sr + 80 + i0), b1 = *(const float4*)(sr + 84 + i0);
      const float x1[8] = {a0.x, a0.y, a0.z, a0.w, a1.x, a1.y, a1.z, a1.w};
      const float x2[8] = {b0.x, b0.y, b0.z, b0.w, b1.x, b1.y, b1.z, b1.w};
      const float4 t0 = *(const float4*)(tb), t1 = *(const float4*)(tb + 2), t2 = *(const float4*)(tb + 4), t3 = *(const float4*)(tb + 6);
      const float cc[8] = {t0.x, t0.z, t1.x, t1.z, t2.x, t2.z, t3.x, t3.z};
      const float sn[8] = {t0.y, t0.w, t1.y, t1.w, t2.y, t2.w, t3.y, t3.w};
      if (dg < 10) {
#pragma unroll
        for (int j = 0; j < 8; ++j) o[j] = (x1[j] * cc[j] - x2[j] * sn[j]) * sc;
      } else {
#pragma unroll
        for (int j = 0; j < 8; ++j) o[j] = (x2[j] * cc[j] + x1[j] * sn[j]) * sc;
      }
    }
    *(uint4*)(p->Q + ((size_t)(m0 + row) * 6 + hd) * 96 + dg * 8) = pack8(o);
  }
  __syncthreads();
}

__device__ void item_kv(PP p, int l, int rt, int hd, u16* lds, float* ssm, bool do_rstd) {
  p = launder(p);
  const int tid = opaque_tid();
  const int m0 = rt * 128;
  if (do_rstd) {
    const int row = tid >> 1, half = tid & 1;
    const u16* src = p->proj + (size_t)(m0 + row) * DINP + C_KVL + half * 64;
    float ss = 0.f;
#pragma unroll
    for (int i = 0; i < 8; ++i) {
      float v[8]; unpack8(*(const uint4*)(src + i * 8), v);
#pragma unroll
      for (int j = 0; j < 8; ++j) ss += v[j] * v[j];
    }
    ss += __shfl_xor(ss, 1);
    if (half == 0) ssm[row] = rsqrtf(ss * (1.f / 128.f) + EPSF);
  }
  f32x16 acc[2][2];
  gemm_tile(p->wUkvT + (size_t)l * 768 * 128 + (size_t)hd * 128 * 128, 128, p->proj + (size_t)m0 * DINP + C_KVL, DINP, 128, lds, acc);
  float* st = (float*)lds;
  stage_f32(st, acc);
  __syncthreads();
  const int kb_ = m0 / SEQ, ks0_ = m0 % SEQ;
#pragma unroll
  for (int i = 0; i < 4; ++i) {
    const int u = tid + 256 * i;
    const int row = u >> 3, dg = u & 7;
    const float sc = ssm[row];
    const float* sr = st + row * 132 + dg * 8;
    float o[8];
    {
      const float4 a = *(const float4*)(sr), bq = *(const float4*)(sr + 4);
      o[0] = a.x * sc; o[1] = a.y * sc; o[2] = a.z * sc; o[3] = a.w * sc;
      o[4] = bq.x * sc; o[5] = bq.y * sc; o[6] = bq.z * sc; o[7] = bq.w * sc;
    }
    *(uint4*)(p->K + ((size_t)(kb_ * 6 + hd) * SEQ + ks0_ + row) * 96 + dg * 8) = pack8(o);
  }
  if (hd == 0) {
#pragma unroll
    for (int i = 0; i < 2; ++i) {
      const int u = tid + 256 * i;
      const int row = u >> 2, dq = u & 3;
      const int i0 = (dq & 1) * 8;
      const u16* kr = p->proj + (size_t)(m0 + row) * DINP + C_KR;
      float x1[8], x2[8], o[8];
      unpack8(*(const uint4*)(kr + i0), x1);
      unpack8(*(const uint4*)(kr + 16 + i0), x2);
      const float2* tb = p->tab + (size_t)(m0 + row) * 16 + i0;
      if (dq < 2) {
#pragma unroll
        for (int j = 0; j < 8; ++j) { float2 cs = tb[j]; o[j] = x1[j] * cs.x - x2[j] * cs.y; }
      } else {
#pragma unroll
        for (int j = 0; j < 8; ++j) { float2 cs = tb[j]; o[j] = x2[j] * cs.x + x1[j] * cs.y; }
      }
      const uint4 ov = pack8(o);
#pragma unroll
      for (int hh2 = 0; hh2 < 6; ++hh2)
        *(uint4*)(p->K + ((size_t)(kb_ * 6 + hh2) * SEQ + ks0_ + row) * 96 + 64 + dq * 8) = ov;
    }
  }
  const int b = m0 / SEQ, s0 = m0 % SEQ;
#pragma unroll
  for (int i = 0; i < 4; ++i) {
    const int u = tid + 256 * i;
    const int dv = u & 63, tg = u >> 6;
    float o[8];
#pragma unroll
    for (int j = 0; j < 8; ++j) o[j] = st[(tg * 8 + j) * 132 + 64 + dv] * ssm[tg * 8 + j];
    u16* vdst = p->VT + (((size_t)(b * 6 + hd) * 128 + (s0 >> 6) + (tg >> 3)) * 64 + dv) * 64 + ((tg & 7) >> 1) * 16 + (tg & 1) * 4;
    uint2 lo2, hi2;
    lo2.x = pack2(o[0], o[1]); lo2.y = pack2(o[2], o[3]);
    hi2.x = pack2(o[4], o[5]); hi2.y = pack2(o[6], o[7]);
    *(uint2*)(vdst) = lo2;
    *(uint2*)(vdst + 8) = hi2;
  }
  __syncthreads();
}

__device__ void item_lru(PP p, int l, int tt, int hd, u16* lds, float* ssm) {
  p = launder(p);
  const int tid = opaque_tid(), lane = tid & 63, w = tid >> 6, r = lane & 31, h = lane >> 5;
  const int t0 = tt * 64;
  const int s0 = t0 % SEQ;
  float* xaf = (float*)lds;
  u16* xcb = lds + 8576;
  float* aarr = (float*)(lds + 8576 + 4608);
  float* barr = aarr + 4096;
  const int c = tid & 63;
  const int cg = hd * 64 + c;
  bf16x8 wfa[4], wfx[4];
  {
    const int cbk_ = w & 1;
    const u16* wa_ = p->waT + (size_t)(l * 6 + hd) * 4096 + (cbk_ * 32 + r) * 64 + h * 8;
    const u16* wx_ = p->wxT + (size_t)(l * 6 + hd) * 4096 + (cbk_ * 32 + r) * 64 + h * 8;
#pragma unroll
    for (int ks = 0; ks < 4; ++ks) { wfa[ks] = *(const bf16x8*)(wa_ + ks * 16); wfx[ks] = *(const bf16x8*)(wx_ + ks * 16); }
  }
  for (int u = tid; u < 67 * 8; u += 256) {
    const int row = u >> 3, c8 = u & 7;
    float v[8];
    if (s0 + row - 3 >= 0) {
      unpack8(*(const uint4*)(p->proj + (size_t)(t0 + row - 3) * DINP + C_XA + hd * 64 + c8 * 8), v);
    } else {
#pragma unroll
      for (int j = 0; j < 8; ++j) v[j] = 0.f;
    }
    *(float4*)(xaf + row * 64 + c8 * 8) = make_float4(v[0], v[1], v[2], v[3]);
    *(float4*)(xaf + row * 64 + c8 * 8 + 4) = make_float4(v[4], v[5], v[6], v[7]);
  }
  __syncthreads();
  const float cw0 = p->conv_w[(l * 4 + 0) * 384 + cg], cw1 = p->conv_w[(l * 4 + 1) * 384 + cg];
  const float cw2 = p->conv_w[(l * 4 + 2) * 384 + cg], cw3 = p->conv_w[(l * 4 + 3) * 384 + cg];
  const float cbias = p->conv_b[l * 384 + cg];
  {
    const int tq = tid >> 6;
    for (int t = tq * 16; t < tq * 16 + 16; ++t) {
      const float xc = cbias + cw0 * xaf[t * 64 + c] + cw1 * xaf[(t + 1) * 64 + c] + cw2 * xaf[(t + 2) * 64 + c] + cw3 * xaf[(t + 3) * 64 + c];
      xcb[t * LDT + c] = f2bf(xc);
    }
  }
  __syncthreads();
  {
    const int tb = w >> 1, cbk = w & 1;
    f32x16 aa, ax;
#pragma unroll
    for (int i = 0; i < 16; ++i) { aa[i] = 0.f; ax[i] = 0.f; }
    const u16* xr = xcb + (tb * 32 + r) * LDT + h * 8;
#pragma unroll
    for (int ks = 0; ks < 4; ++ks) {
      bf16x8 af = *(const bf16x8*)(xr + ks * 16);
      aa = mfma32(af, wfa[ks], aa);
      ax = mfma32(af, wfx[ks], ax);
    }
    const int cc = cbk * 32 + r;
    const int cgl = hd * 64 + cc;
    const float ba = p->lru_ba[l * 384 + cgl], bx = p->lru_bx[l * 384 + cgl];
    const float lam = p->lru_lam[l * 384 + cgl];
    const float nl = -lam;
    const float sp = fmaxf(nl, 0.f) + log1pf(expf(-fabsf(nl)));
#pragma unroll
    for (int reg = 0; reg < 16; ++reg) {
      const int t = tb * 32 + (reg & 3) + 8 * (reg >> 2) + 4 * h;
      const float xc = bf2f(xcb[t * LDT + cc]);
      const float ga = sigmoidf_(aa[reg] + ba);
      const float gx = sigmoidf_(ax[reg] + bx);
      const float la = -8.f * ga * sp;
      const float a = __expf(la);
      const float om = (la > -5e-4f) ? (-2.f * la) * (1.f + la) : (1.f - a * a);
      const float mult = sqrtf(fmaxf(om, 0.f));
      aarr[t * 64 + cc] = a;
      barr[t * 64 + cc] = mult * gx * xc;
    }
  }
  __syncthreads();
  const int seg = tid >> 6;
  u16* h16 = (u16*)aarr;
  u16* c16 = (u16*)barr;
  float pr[16], hr[16];
#pragma unroll
  for (int j = 0; j < 16; ++j) { pr[j] = aarr[(seg * 16 + j) * 64 + c]; hr[j] = barr[(seg * 16 + j) * 64 + c]; }
  {
    float hh = 0.f, P = 1.f;
#pragma unroll
    for (int j = 0; j < 16; ++j) { hh = pr[j] * hh + hr[j]; P *= pr[j]; hr[j] = hh; pr[j] = P; }
    ssm[seg * 64 + c] = P;
    ssm[256 + seg * 64 + c] = hh;
  }
  __syncthreads();
  {
    float Hc = 0.f, Pc = 1.f;
    for (int s2 = 0; s2 < seg; ++s2) {
      const float Ps = ssm[s2 * 64 + c], Hs = ssm[256 + s2 * 64 + c];
      Hc = Ps * Hc + Hs; Pc *= Ps;
    }
    float hl = 0.f, cm = 1.f;
#pragma unroll
    for (int j = 0; j < 16; ++j) {
      hl = hr[j] + pr[j] * Hc;
      cm = pr[j] * Pc;
      h16[(seg * 16 + j) * 64 + c] = f2bf(hl);
      c16[(seg * 16 + j) * 64 + c] = f2bf(cm);
    }
    if (seg == 3) {
      p->Htile[(size_t)tt * 384 + cg] = hl;
      p->Ptile[(size_t)tt * 384 + cg] = cm;
    }
  }
  __syncthreads();
#pragma unroll
  for (int i = 0; i < 2; ++i) {
    const int id = tid + 256 * i;
    const int row = id >> 3, c8 = id & 7;
    const uint4 hv = *(const uint4*)(h16 + row * 64 + c8 * 8);
    const uint4 cv = *(const uint4*)(c16 + row * 64 + c8 * 8);
    *(uint4*)(p->hloc + (size_t)(t0 + row) * 384 + hd * 64 + c8 * 8) = hv;
    *(uint4*)(p->cum + (size_t)(t0 + row) * 384 + hd * 64 + c8 * 8) = cv;
  }
  __syncthreads();
}

__device__ void item_sgu(PP p, int l, int nbk, u16* lds, float* ssm) {
  p = launder(p);
  const int tid = opaque_tid(), lane = tid & 63, w = tid >> 6, r = lane & 31, h = lane >> 5;
  const int m0 = nbk * 128;
  {
    const int row = tid >> 1, half = tid & 1;
    const u16* src = p->proj + (size_t)(m0 + row) * DINP + C_V + half * 128;
    float s1 = 0.f, s2 = 0.f;
#pragma unroll
    for (int i = 0; i < 16; ++i) {
      float v[8]; unpack8(*(const uint4*)(src + i * 8), v);
#pragma unroll
      for (int j = 0; j < 8; ++j) { const float gq = geluf_(v[j]); s1 += gq; s2 += gq * gq; }
    }
    s1 += __shfl_xor(s1, 1); s2 += __shfl_xor(s2, 1);
    if (half == 0) {
      const float mu = s1 * (1.f / 256.f);
      const float var = fmaxf(s2 * (1.f / 256.f) - mu * mu, 0.f);
      ssm[row] = mu; ssm[128 + row] = rsqrtf(var + EPSF);
    }
  }
  u16* vbT = lds;
  for (int g = 0; g < 4; ++g) {
    __syncthreads();
    {
      const int j = tid & 127, chalf = tid >> 7;
      const float mu = ssm[j], rs = ssm[128 + j];
      const u16* src = p->proj + (size_t)(m0 + j) * DINP + C_V + g * 64 + chalf * 32;
      const float* lg = p->sgu_g + l * 256 + g * 64 + chalf * 32;
      const float* lb = p->sgu_bn + l * 256 + g * 64 + chalf * 32;
#pragma unroll
      for (int i = 0; i < 4; ++i) {
        float v[8]; unpack8(*(const uint4*)(src + i * 8), v);
#pragma unroll
        for (int q = 0; q < 8; ++q) {
          const int cc = chalf * 32 + i * 8 + q;
          const float val = (geluf_(v[q]) - mu) * rs * lg[i * 8 + q] + lb[i * 8 + q];
          vbT[cc * 136 + j] = f2bf(val);
        }
      }
    }
    __syncthreads();
    f32x16 a0, a1;
#pragma unroll
    for (int i = 0; i < 16; ++i) { a0[i] = 0.f; a1[i] = 0.f; }
    const u16* wr = p->sguW + ((size_t)(l * 4 + g) * 128 + w * 32 + r) * 128 + h * 8;
    const u16* v0 = vbT + r * 136 + h * 8;
    const u16* v1 = vbT + (32 + r) * 136 + h * 8;
    const int nks = (w < 2) ? 4 : 8;
    for (int ks = 0; ks < nks; ++ks) {
      bf16x8 af = *(const bf16x8*)(wr + ks * 16);
      bf16x8 b0 = *(const bf16x8*)(v0 + ks * 16);
      bf16x8 b1 = *(const bf16x8*)(v1 + ks * 16);
      a0 = mfma32(af, b0, a0);
      a1 = mfma32(af, b1, a1);
    }
    float* stg = (float*)(lds + 8704);
#pragma unroll
    for (int reg = 0; reg < 16; ++reg) {
      const int i = w * 32 + (reg & 3) + 8 * (reg >> 2) + 4 * h;
      const float bsv = p->sgu_b[(l * 4 + g) * 128 + i];
      stg[i * 68 + r] = a0[reg] + bsv;
      stg[i * 68 + 32 + r] = a1[reg] + bsv;
    }
    __syncthreads();
#pragma unroll
    for (int k = 0; k < 4; ++k) {
      const int u = tid + 256 * k;
      const int i = u >> 3, c8 = u & 7;
      const size_t tok = (size_t)(m0 + i);
      const int ch = g * 64 + c8 * 8;
      const float4 m0v = *(const float4*)(stg + i * 68 + c8 * 8), m1v = *(const float4*)(stg + i * 68 + c8 * 8 + 4);
      const float mx[8] = {m0v.x, m0v.y, m0v.z, m0v.w, m1v.x, m1v.y, m1v.z, m1v.w};
      float uu[8], gcv[8], o[8];
      unpack8(*(const uint4*)(p->proj + tok * DINP + C_U + ch), uu);
      unpack8(*(const uint4*)(p->proj + tok * DINP + C_GC + ch), gcv);
#pragma unroll
      for (int q = 0; q < 8; ++q) o[q] = geluf_(uu[q]) * mx[q] * siluf_(gcv[q]);
      *(uint4*)(p->ycpre + tok * 256 + ch) = pack8(o);
    }
  }
  __syncthreads();
}

__device__ void item_carry(PP p, int ci) {
  p = launder(p);
  const int idx = ci * 256 + opaque_tid();
  const int b = idx / 384, c = idx % 384;
  float carry = 0.f;
  for (int tt = 0; tt < 128; ++tt) {
    const size_t o = (size_t)(b * 128 + tt) * 384 + c;
    p->carry[o] = carry;
    carry = p->Ptile[o] * carry + p->Htile[o];
  }
}

#define KLD 104
#define VLD 72
#define ATT_STAGE (64 * KLD + 64 * VLD)
struct AStage { u32x4 k0, k1, k2, v0, v1; };
__device__ __forceinline__ void as_load(AStage& g, const u16* kg, const u16* vg, int kt) {
  const u16* kp = kg + (size_t)kt * 6144;
  g.k0 = *(const u32x4*)(kp); g.k1 = *(const u32x4*)(kp + 2048); g.k2 = *(const u32x4*)(kp + 4096);
  const u16* vp = vg + (size_t)kt * 4096;
  g.v0 = *(const u32x4*)(vp); g.v1 = *(const u32x4*)(vp + 2048);
#ifdef DUP_LOADS
  {
    u32x4 t0 = *(const volatile u32x4*)(kp), t1 = *(const volatile u32x4*)(kp + 2048), t2 = *(const volatile u32x4*)(kp + 4096);
    u32x4 t3 = *(const volatile u32x4*)(vp), t4 = *(const volatile u32x4*)(vp + 2048);
    asm volatile("" :: "v"(t0), "v"(t1), "v"(t2), "v"(t3), "v"(t4));
  }
#endif
}
__device__ __forceinline__ void as_store(const AStage& g, u16* db, int kl0, int kl1, int kl2, int vl) {
  *(u32x4*)(db + kl0) = g.k0; *(u32x4*)(db + kl1) = g.k1; *(u32x4*)(db + kl2) = g.k2;
  *(u32x4*)(db + vl) = g.v0; *(u32x4*)(db + vl + 32 * VLD) = g.v1;
}
__device__ __forceinline__ float max3f(float a, float b, float c) {
  float d; asm("v_max3_f32 %0, %1, %2, %3" : "=v"(d) : "v"(a), "v"(b), "v"(c)); return d;
}
__device__ __forceinline__ bf16x8 pack_p(const f32x16& s, int o) {
  u32x4 pu;
  pu.x = pack2(s[o + 0], s[o + 1]); pu.y = pack2(s[o + 2], s[o + 3]);
  pu.z = pack2(s[o + 4], s[o + 5]); pu.w = pack2(s[o + 6], s[o + 7]);
  return __builtin_bit_cast(bf16x8, pu);
}
__device__ __forceinline__ void attn_qk(const u16* kp, const bf16x8 (&qa)[6], f32x16& s0, f32x16& s1) {
#pragma unroll
  for (int ks = 0; ks < 6; ++ks) {
    bf16x8 k0 = *(const bf16x8*)(kp + ks * 16);
    bf16x8 k1 = *(const bf16x8*)(kp + 32 * KLD + ks * 16);
    s0 = mfma32(k0, qa[ks], s0);
    s1 = mfma32(k1, qa[ks], s1);
  }
}
__device__ __forceinline__ void attn_tile(const u16* sb, const bf16x8 (&qa)[6], f32x16& o0, f32x16& o1, f32x16& lacc,
                                          float& m, bool& mz, int r, int h, bool first) {
  const u16* kp = sb + r * KLD + h * 8;
  f32x16 s0, s1;
  __builtin_amdgcn_s_setprio(1);
  if (mz) {
#pragma unroll
    for (int i = 0; i < 16; ++i) { s0[i] = 0.f; s1[i] = 0.f; }
    attn_qk(kp, qa, s0, s1);
  } else {
#pragma unroll
    for (int i = 0; i < 16; ++i) { s0[i] = -m; s1[i] = -m; }
    attn_qk(kp, qa, s0, s1);
  }
  __builtin_amdgcn_s_setprio(0);
  float mxa = max3f(s0[0], s0[1], s0[2]), mxb = max3f(s0[3], s0[4], s0[5]);
  float mxc = max3f(s0[6], s0[7], s0[8]), mxd = max3f(s0[9], s0[10], s0[11]);
  mxa = max3f(mxa, s0[12], s0[13]); mxb = max3f(mxb, s0[14], s0[15]);
  mxc = max3f(mxc, s1[0], s1[1]); mxd = max3f(mxd, s1[2], s1[3]);
  mxa = max3f(mxa, s1[4], s1[5]); mxb = max3f(mxb, s1[6], s1[7]);
  mxc = max3f(mxc, s1[8], s1[9]); mxd = max3f(mxd, s1[10], s1[11]);
  mxa = max3f(mxa, s1[12], s1[13]); mxb = max3f(mxb, s1[14], s1[15]);
  const float lm = max3f(mxa, mxb, fmaxf(mxc, mxd));
  bool slow;
  if (first) {
    const float mx = fmaxf(lm, __shfl_xor(lm, 32));
    slow = __any(mx > 30.f || mx < -30.f);
  } else {
    slow = __any(lm > 30.f);
  }
  if (slow) {
    const float mx = fmaxf(lm, __shfl_xor(lm, 32));
    const float d = first ? mx : fmaxf(mx, 0.f);
    const float alpha = first ? 1.f : __builtin_amdgcn_exp2f(-d);
    m += d;
    mz = false;
#pragma unroll
    for (int i = 0; i < 16; ++i) { s0[i] -= d; s1[i] -= d; o0[i] *= alpha; o1[i] *= alpha; }
    lacc[0] *= alpha;
  }
  float pa = 0.f, pb = 0.f, pc = 0.f, pd = 0.f;
#pragma unroll
  for (int i = 0; i < 16; ++i) {
    s0[i] = __builtin_amdgcn_exp2f(s0[i]); s1[i] = __builtin_amdgcn_exp2f(s1[i]);
    if ((i & 3) == 0) pa += s0[i] + s1[i];
    else if ((i & 3) == 1) pb += s0[i] + s1[i];
    else if ((i & 3) == 2) pc += s0[i] + s1[i];
    else pd += s0[i] + s1[i];
  }
  lacc[0] += (pa + pb) + (pc + pd);
  const u16* vp = sb + 64 * KLD + r * VLD + 8 * h;
  __builtin_amdgcn_s_setprio(1);
#pragma unroll
  for (int kb = 0; kb < 2; ++kb) {
#pragma unroll
    for (int s = 0; s < 2; ++s) {
      const bf16x8 pf = pack_p(kb == 0 ? s0 : s1, 8 * s);
      const int koff = kb * 32 + 16 * s;
      const bf16x8 v0 = *(const bf16x8*)(vp + koff);
      const bf16x8 v1 = *(const bf16x8*)(vp + 32 * VLD + koff);
      o0 = mfma32(v0, pf, o0);
      o1 = mfma32(v1, pf, o1);
    }
  }
  __builtin_amdgcn_s_setprio(0);
}
__device__ __forceinline__ void attn_write_o(u16* op, const f32x16& o0, const f32x16& o1, float inv) {
#pragma unroll
  for (int g = 0; g < 4; ++g) {
    uint2 v;
    v.x = pack2(o0[4 * g] * inv, o0[4 * g + 1] * inv); v.y = pack2(o0[4 * g + 2] * inv, o0[4 * g + 3] * inv);
    *(uint2*)(op + 8 * g) = v;
    v.x = pack2(o1[4 * g] * inv, o1[4 * g + 1] * inv); v.y = pack2(o1[4 * g + 2] * inv, o1[4 * g + 3] * inv);
    *(uint2*)(op + 32 + 8 * g) = v;
  }
}

__device__ void item_attn(PP p, int qb, int b, int hh, u16* lds) {
  p = launder(p);
  const int tid = opaque_tid(), lane = tid & 63, w = tid >> 6, r = lane & 31, h = lane >> 5;
  const size_t tokbase = (size_t)b * SEQ;
  const int q0 = qb * 128 + w * 32;
  bf16x8 qa[6];
  {
    const u16* qp = p->Q + ((tokbase + q0 + r) * 6 + hh) * 96 + h * 8;
#pragma unroll
    for (int ks = 0; ks < 6; ++ks) qa[ks] = *(const bf16x8*)(qp + ks * 16);
  }
  f32x16 oa0, oa1, lacc;
#pragma unroll
  for (int i = 0; i < 16; ++i) { oa0[i] = 0.f; oa1[i] = 0.f; lacc[i] = 0.f; }
  float ma = 0.f;
  bool mz = true;
  const int ntiles = 2 * qb + 2;
  const int my_ntiles = 2 * qb + 1 + (w >> 1);
  const u16* kg = p->K + (size_t)(b * 6 + hh) * SEQ * 96 + tid * 8;
  const u16* vg = p->VT + (size_t)(b * 6 + hh) * SEQ * 64 + tid * 8;
  const int id1 = tid + 256, id2 = tid + 512;
  const int kl0 = (tid / 12) * KLD + (tid % 12) * 8;
  const int kl1 = (id1 / 12) * KLD + (id1 % 12) * 8;
  const int kl2 = (id2 / 12) * KLD + (id2 % 12) * 8;
  const int vl = 64 * KLD + (tid >> 3) * VLD + (tid & 7) * 8;
  AStage A, B;
  as_load(B, kg, vg, 0);
  as_load(A, kg, vg, 1);
  as_store(B, lds, kl0, kl1, kl2, vl);
  __syncthreads();
  for (int kt = 0; kt < ntiles; kt += 2) {
    if (kt + 2 < ntiles) as_load(B, kg, vg, kt + 2);
    attn_tile(lds, qa, oa0, oa1, lacc, ma, mz, r, h, kt == 0);
    as_store(A, lds + ATT_STAGE, kl0, kl1, kl2, vl);
    __syncthreads();
    if (kt + 3 < ntiles) as_load(A, kg, vg, kt + 3);
    if (kt + 1 < my_ntiles) attn_tile(lds + ATT_STAGE, qa, oa0, oa1, lacc, ma, mz, r, h, false);
    if (kt + 2 < ntiles) as_store(B, lds, kl0, kl1, kl2, vl);
    __syncthreads();
  }
  const float lta = lacc[0] + __shfl_xor(lacc[0], 32);
  u16* op = p->obuf + (tokbase + q0 + r) * 384 + hh * 64 + 4 * h;
  attn_write_o(op, oa0, oa1, 1.f / lta);
}

__device__ void phase_y(PP p, int l) {
  p = launder(p);
  const int tid_ = opaque_tid();
  const int lane = tid_ & 63;
  const int gw = blockIdx.x * 4 + (tid_ >> 6), nw = gridDim.x * 4;
  const float* bg = p->br_g + l * DM + lane * 16;
  const int seg = (lane < 24) ? 0 : (lane < 48) ? 1 : 2;
  const u16* xbase; const u16* gbase; size_t xs, gs;
  if (seg == 0) { xbase = p->hloc + lane * 16; xs = 384; gbase = p->proj + C_GA + lane * 16; gs = DINP; }
  else if (seg == 1) { xbase = p->obuf + (lane - 24) * 16; xs = 384; gbase = p->proj + C_GB + (lane - 24) * 16; gs = DINP; }
  else { xbase = p->ycpre + (lane - 48) * 16; xs = 256; gbase = xbase; gs = 256; }
  for (int tok0 = gw; tok0 < T_TOK; tok0 += 2 * nw) {
    const int tok1 = (tok0 + nw < T_TOK) ? tok0 + nw : tok0;
    uint4 xr[2][2], gr[2][2], cr_[2][2];
    float4 cy[2][4];
#pragma unroll
    for (int t = 0; t < 2; ++t) {
      const size_t tok = (size_t)(t ? tok1 : tok0);
      xr[t][0] = *(const uint4*)(xbase + tok * xs); xr[t][1] = *(const uint4*)(xbase + tok * xs + 8);
      gr[t][0] = *(const uint4*)(gbase + tok * gs); gr[t][1] = *(const uint4*)(gbase + tok * gs + 8);
    }
    if (seg == 0) {
#pragma unroll
      for (int t = 0; t < 2; ++t) {
        const size_t tok = (size_t)(t ? tok1 : tok0);
        cr_[t][0] = *(const uint4*)(p->cum + tok * 384 + lane * 16); cr_[t][1] = *(const uint4*)(p->cum + tok * 384 + lane * 16 + 8);
        const float* cp = p->carry + (tok >> 6) * 384 + lane * 16;
#pragma unroll
        for (int i = 0; i < 4; ++i) cy[t][i] = *(const float4*)(cp + 4 * i);
      }
    }
#pragma unroll
    for (int t = 0; t < 2; ++t) {
      const size_t tok = (size_t)(t ? tok1 : tok0);
      float v[16], g[16];
      unpack8(xr[t][0], v); unpack8(xr[t][1], v + 8);
      unpack8(gr[t][0], g); unpack8(gr[t][1], g + 8);
      if (seg == 0) {
        float cm[16];
        unpack8(cr_[t][0], cm); unpack8(cr_[t][1], cm + 8);
#pragma unroll
        for (int i = 0; i < 4; ++i) {
          v[4 * i] += cm[4 * i] * cy[t][i].x; v[4 * i + 1] += cm[4 * i + 1] * cy[t][i].y;
          v[4 * i + 2] += cm[4 * i + 2] * cy[t][i].z; v[4 * i + 3] += cm[4 * i + 3] * cy[t][i].w;
        }
      }
      if (seg < 2) {
#pragma unroll
        for (int j = 0; j < 16; ++j) v[j] *= siluf_(g[j]);
      }
      float ss = 0.f;
#pragma unroll
      for (int j = 0; j < 16; ++j) ss += v[j] * v[j];
      const float sa = wave_sum(seg == 0 ? ss : 0.f);
      const float sb = wave_sum(seg == 1 ? ss : 0.f);
      const float sc = wave_sum(seg == 2 ? ss : 0.f);
      const float rs = (seg == 0) ? rsqrtf(sa * (1.f / 384.f) + EPSF)
                     : (seg == 1) ? rsqrtf(sb * (1.f / 384.f) + EPSF) : rsqrtf(sc * (1.f / 256.f) + EPSF);
      float o[16];
#pragma unroll
      for (int j = 0; j < 16; ++j) o[j] = v[j] * rs * bg[j];
      *(uint4*)(p->hbuf + tok * DM + lane * 16) = pack8(o);
      *(uint4*)(p->hbuf + tok * DM + lane * 16 + 8) = pack8(o + 8);
    }
  }
}

__device__ __forceinline__ int next_item(int* counter, int* slot) {
  __syncthreads();
  if (threadIdx.x == 0) *slot = atomicAdd(counter, 1);
  __syncthreads();
  return *slot;
}


#define XB_TMO      128
#define XB_XCNT(j)  (256  + 64 * (j))
#define XB_XSUB(j)  (1280 + 64 * (j))
#define XB_XGEN(j)  (2304 + 64 * (j))
#define XB_TOP      3328
#define XB_TOPGEN   3392
#define XCD_BAR_WORDS 3456
#define XB_SPIN_CAP (1u << 18)
#define LAS __attribute__((address_space(3)))
__device__ __forceinline__ unsigned xb_ld(unsigned* p)              { return __hip_atomic_load(p, __ATOMIC_RELAXED, __HIP_MEMORY_SCOPE_AGENT); }
__device__ __forceinline__ unsigned xb_add(unsigned* p, unsigned v) { return __hip_atomic_fetch_add(p, v, __ATOMIC_RELAXED, __HIP_MEMORY_SCOPE_AGENT); }
__device__ __forceinline__ unsigned xb_xcc_id() { return (unsigned)__builtin_amdgcn_s_getreg((3 << 11) | 20) & 0xFu; }
#define XB_SPIN(cond, bar) do { unsigned _sp = 0; while (cond) { __builtin_amdgcn_s_sleep(1); \
    if ((++_sp & 255u) == 0u) { if (xb_ld(&(bar)[XB_TMO])) break; if (_sp > XB_SPIN_CAP) { atomicAdd(&(bar)[XB_TMO], 1u); break; } } } } while (0)
struct XcdBarrier { unsigned* bar; unsigned x; volatile LAS unsigned* st; };
__device__ __forceinline__ XcdBarrier xcd_barrier_post(unsigned* bar, volatile LAS unsigned* st) {
    XcdBarrier b; b.bar = bar; b.x = xb_xcc_id(); b.st = st;
    if (threadIdx.x == 0) (void)xb_add(&bar[XB_XCNT(b.x)], 1u);
    return b;
}
__device__ __forceinline__ void xcd_barrier_complete(unsigned* bar, unsigned x, unsigned& nloc, unsigned& nx) {
    const unsigned G = gridDim.x * gridDim.y * gridDim.z;
    unsigned sum, cnt, mine, sp = 0u;
    for (;;) {
        sum = 0u; cnt = 0u; mine = 0u;
#pragma unroll
        for (unsigned j = 0; j < 16; ++j) { const unsigned c = xb_ld(&bar[XB_XCNT(j)]); sum += c; cnt += (c > 0u) ? 1u : 0u; mine = (j == x) ? c : mine; }
        if (sum == G) break;
        __builtin_amdgcn_s_sleep(1);
        if ((++sp & 255u) == 0u) { if (xb_ld(&bar[XB_TMO])) break; if (sp > XB_SPIN_CAP) { atomicAdd(&bar[XB_TMO], 1u); break; } }
    }
    nloc = mine > 0u ? mine : 1u; nx = cnt > 0u ? cnt : 1u;
}
__device__ __forceinline__ void xcd_barrier(const XcdBarrier& b) {
    asm volatile("s_waitcnt vmcnt(0)" ::: "memory");
    __syncthreads();
    if (threadIdx.x == 0) {
        unsigned* bar = b.bar;
        __builtin_amdgcn_s_waitcnt(0);
        unsigned nloc = b.st[0], nx = b.st[1];
        if (nloc == 0u) { xcd_barrier_complete(bar, b.x, nloc, nx); b.st[0] = nloc; b.st[1] = nx; }
        const unsigned old = xb_add(&bar[XB_XSUB(b.x)], 1u);
        const unsigned gen = old / nloc;
        if (old + 1u == (gen + 1u) * nloc) {
            __builtin_amdgcn_fence(__ATOMIC_RELEASE, "agent");
            asm volatile("s_waitcnt vmcnt(0)" ::: "memory");
            const unsigned og = xb_add(&bar[XB_TOP], 1u);
            const unsigned tg = og / nx;
            if (og + 1u == (tg + 1u) * nx) xb_add(&bar[XB_TOPGEN], 1u);
            else XB_SPIN(xb_ld(&bar[XB_TOPGEN]) == tg, bar);
            __builtin_amdgcn_fence(__ATOMIC_ACQUIRE, "agent");
            xb_add(&bar[XB_XGEN(b.x)], 1u);
            asm volatile("s_waitcnt vmcnt(0)" ::: "memory");
        } else {
            XB_SPIN(xb_ld(&bar[XB_XGEN(b.x)]) == gen, bar);
            __builtin_amdgcn_fence(__ATOMIC_ACQUIRE, "agent");
            asm volatile("s_waitcnt vmcnt(0)" ::: "memory");
        }
    }
    __syncthreads();
}

#define N_PHASES (1 + 6 * NLAYER + 1)

__device__ void run_phase(PP p, int ph, u16* lds, float* ssm, int* slot, int rep) {
  int l = (ph - 1) / 6, sub = (ph - 1) % 6 + 1;
  if (ph == 0) { sub = 0; l = 0; }
  if (ph == N_PHASES - 1) { sub = 1; l = NLAYER; }
#ifdef ONLYSUB
  sub = ONLYSUB;
#endif
  const int bid = blockIdx.x, nb = gridDim.x;
  if (sub == 0) { phase_prep(p, (float*)lds); return; }
  if (sub == 1) { phase_norm(p, l); return; }
  if (sub == 2) {
    gemm_phase(p->wInT + (size_t)l * DINP * DM, DM, p->hbuf, DM, DM, p->proj, DINP, 18, 256 * 18, lds);
    return;
  }
  if (sub == 3) {
    int* ctr = p->counters + l * 16 + rep * 64;
    for (;;) {
      int it = next_item(ctr, slot);
      if (it >= 256 + 768 + 768 + 3072) break;
      if (it < 256) item_sgu(p, l, it, lds, ssm);
      else if (it < 256 + 768) {
        const int k = it - 256; const int rt = k / 3, hp = (k % 3) * 2;
#pragma unroll 1
        for (int h2 = 0; h2 < 2; ++h2) item_q(p, l, rt, hp + h2, lds, ssm, h2 == 0);
      } else if (it < 256 + 1536) {
        const int k = it - 256 - 768; const int rt = k / 3, hp = (k % 3) * 2;
#pragma unroll 1
        for (int h2 = 0; h2 < 2; ++h2) item_kv(p, l, rt, hp + h2, lds, ssm, h2 == 0);
      } else { const int k = it - 256 - 1536; item_lru(p, l, k / 6, k % 6, lds, ssm); }
    }
    return;
  }
  if (sub == 4) {
    if (bid < 6) item_carry(p, bid);
    const int xq = (int)(xb_xcc_id() & 7u);
    int* cbase = p->counters + l * 16 + 8 + rep * 64;
    for (;;) {
      __syncthreads();
      if (threadIdx.x == 0) {
        int got = -1;
        for (int dq = 0; dq < 8 && got < 0; ++dq) {
          const int q = (xq + dq) & 7;
          if (__hip_atomic_load(cbase + q, __ATOMIC_RELAXED, __HIP_MEMORY_SCOPE_AGENT) < 192) {
            const int it = atomicAdd(cbase + q, 1);
            if (it < 192) got = q * 256 + it;
          }
        }
        *slot = got;
      }
      __syncthreads();
      const int got = *slot;
      if (got < 0) break;
      const int q = got >> 8, it = got & 255;
      int qb, bh;
      if (it < 64) { qb = 63 - it; bh = q * 3; }
      else { const int j = it - 64; qb = 63 - (j >> 1); bh = q * 3 + 1 + (j & 1); }
      item_attn(p, qb, bh / 6, bh % 6, lds);
    }
    return;
  }
  if (sub == 5) { phase_y(p, l); return; }
  gemm_phase(p->wOutT + (size_t)l * DM * DM, DM, p->hbuf, DM, DM, p->y2, DM, 8, 256 * 8, lds);
}

__global__ void __launch_bounds__(256, 2) mega_kernel(Params p, int ph_begin, int ph_end) {
  __shared__ __attribute__((aligned(16))) unsigned char lds_raw[LDS_BYTES];
  __shared__ float ssm[512];
  __shared__ int slot;
  u16* lds = (u16*)lds_raw;
  PP pp = (PP)__builtin_amdgcn_kernarg_segment_ptr();
#if COOP
  cg::grid_group grid = cg::this_grid();
  __shared__ uint4 xb_words;
  if (threadIdx.x == 0) xb_words = make_uint4(0u, 0u, 0u, 0u);
  __syncthreads();
  XcdBarrier xb = xcd_barrier_post(pp->bar, (volatile LAS unsigned*)&xb_words);
#endif
  int rep = 0;
  for (int ph = ph_begin; ph < ph_end;) {
    run_phase(launder(pp), ph, lds, ssm, &slot, rep);
    bool again = false;
#if COOP
#ifdef REPEAT_SUB
    if (ph > 0 && ph < N_PHASES - 1) {
      if (REPEAT_SUB == 99) { xcd_barrier(xb); xcd_barrier(xb); xcd_barrier(xb); xcd_barrier(xb); }
      else if (((ph - 1) % 6 + 1) == REPEAT_SUB && rep == 0) again = true;
    }
#endif
    if (again || ph + 1 < ph_end) {
      if (ph_end > 1000) grid.sync();
      xcd_barrier(xb);
    }
#endif
    if (again) rep = 1; else { rep = 0; ++ph; }
  }
}

extern "C" void kernel_launch(void* const* d_in, const int* in_sizes, int n_in, void* d_out, int out_size, void* d_ws,
                              size_t ws_size, hipStream_t stream) {
  Params p{};
  p.x = (const float*)d_in[0]; p.pos = (const int*)d_in[1]; p.pre_g = (const float*)d_in[2]; p.w_in = (const float*)d_in[3];
  p.conv_w = (const float*)d_in[4]; p.conv_b = (const float*)d_in[5]; p.lru_wa = (const float*)d_in[6]; p.lru_ba = (const float*)d_in[7];
  p.lru_wx = (const float*)d_in[8]; p.lru_bx = (const float*)d_in[9]; p.lru_lam = (const float*)d_in[10]; p.q_g = (const float*)d_in[11];
  p.w_uq = (const float*)d_in[12]; p.kv_g = (const float*)d_in[13]; p.w_ukv = (const float*)d_in[14]; p.sgu_g = (const float*)d_in[15];
  p.sgu_bn = (const float*)d_in[16]; p.sgu_w = (const float*)d_in[17]; p.sgu_b = (const float*)d_in[18]; p.br_g = (const float*)d_in[19];
  p.w_out = (const float*)d_in[20]; p.post_g = (const float*)d_in[21];
  p.out = (float*)d_out;
  unsigned char* ws = (unsigned char*)d_ws;
  size_t off = 0;
  auto take = [&](size_t bytes) { unsigned char* q = ws + off; off += (bytes + 255) & ~(size_t)255; return q; };
  p.counters = (int*)take(1024);
  p.bar = (unsigned*)take(XCD_BAR_WORDS * 4);
  p.wInT = (u16*)take((size_t)NLAYER * DINP * DM * 2);
  p.wOutT = (u16*)take((size_t)NLAYER * DM * DM * 2);
  p.wUqT = (u16*)take((size_t)NLAYER * 768 * 192 * 2);
  p.wUkvT = (u16*)take((size_t)NLAYER * 768 * 128 * 2);
  p.waT = (u16*)take((size_t)NLAYER * 6 * 4096 * 2);
  p.wxT = (u16*)take((size_t)NLAYER * 6 * 4096 * 2);
  p.sguW = (u16*)take((size_t)NLAYER * 4 * 128 * 128 * 2);
  p.tab = (float2*)take((size_t)T_TOK * 16 * 8);
  p.hbuf = (u16*)take((size_t)T_TOK * DM * 2);
  p.proj = (u16*)take((size_t)T_TOK * DINP * 2);
  p.y2 = (u16*)take((size_t)T_TOK * DM * 2);
  p.Q = (u16*)take((size_t)T_TOK * 576 * 2);
  p.K = (u16*)take((size_t)T_TOK * 576 * 2);
  p.VT = (u16*)take((size_t)T_TOK * 384 * 2);
  p.hloc = (u16*)take((size_t)T_TOK * 384 * 2);
  p.cum = (u16*)take((size_t)T_TOK * 384 * 2);
  p.Ptile = (float*)take((size_t)512 * 384 * 4);
  p.Htile = (float*)take((size_t)512 * 384 * 4);
  p.carry = (float*)take((size_t)512 * 384 * 4);
  p.obuf = (u16*)take((size_t)T_TOK * 384 * 2);
  p.ycpre = (u16*)take((size_t)T_TOK * 256 * 2);
  if (off > ws_size) { fprintf(stderr, "workspace too small: need %zu have %zu\n", off, ws_size); return; }

  static int grid_blocks = 0;
  if (!grid_blocks) {
    int dev = 0, cus = 0, per_cu = 0;
    hipGetDevice(&dev);
    hipDeviceGetAttribute(&cus, hipDeviceAttributeMultiprocessorCount, dev);
    hipOccupancyMaxActiveBlocksPerMultiprocessor(&per_cu, mega_kernel, 256, 0);
    if (per_cu > 2) per_cu = 2;
    if (per_cu < 1) per_cu = 1;
    grid_blocks = cus * per_cu;
  }
#if COOP
  (void)hipMemsetAsync(d_ws, 0, 1024 + ((XCD_BAR_WORDS * 4 + 255) & ~255), stream);
  int pb = 0, pe = N_PHASES;
  void* args[] = {&p, &pb, &pe};
  hipError_t e = hipLaunchCooperativeKernel((void*)mega_kernel, dim3(grid_blocks), dim3(256), args, 0, stream);
  if (e != hipSuccess) fprintf(stderr, "cooperative launch failed: %s (grid %d)\n", hipGetErrorString(e), grid_blocks);
#else
  for (int ph = 0; ph < N_PHASES; ++ph) mega_kernel<<<grid_blocks, 256, 0, stream>>>(p, ph, ph + 1);
#endif
}
```

```cpp
#include <hip/hip_runtime.h>
#include <hip/hip_cooperative_groups.h>
#include <stdint.h>
#include <stdio.h>
namespace cg = cooperative_groups;

typedef unsigned short u16;
typedef __attribute__((ext_vector_type(8))) short bf16x8;
typedef __attribute__((ext_vector_type(16))) float f32x16;
typedef __attribute__((ext_vector_type(4))) unsigned u32x4;
typedef __attribute__((ext_vector_type(2))) unsigned u32x2;

#ifndef COOP
#define COOP 1
#endif

#define T_TOK 32768
#define SEQ 8192
#define DM 1024
#define DIN 2272
#define DINP 2304
#define NLAYER 4
#define EPSF 1e-6f
#define C_XA 0
#define C_GA 384
#define C_QL 768
#define C_KVL 960
#define C_KR 1088
#define C_GB 1120
#define C_U 1504
#define C_V 1760
#define C_GC 2016

#define LDT 72
#define TILE_U16 (128 * LDT)
#define LDS_BYTES 73728

struct Params {
  const float* x; const int* pos; const float* pre_g; const float* w_in; const float* conv_w; const float* conv_b;
  const float* lru_wa; const float* lru_ba; const float* lru_wx; const float* lru_bx; const float* lru_lam;
  const float* q_g; const float* w_uq; const float* kv_g; const float* w_ukv; const float* sgu_g; const float* sgu_bn;
  const float* sgu_w; const float* sgu_b; const float* br_g; const float* w_out; const float* post_g;
  float* out;
  u16* wInT; u16* wOutT; u16* wUqT; u16* wUkvT; u16* waT; u16* wxT; u16* sguW;
  float2* tab; int* counters; unsigned* bar;
  u16* hbuf;
  u16* proj;
  u16* y2;
  u16* Q; u16* K; u16* VT;
  u16* hloc; u16* cum; float* Ptile; float* Htile; float* carry;
  u16* obuf; u16* ycpre;
};

__device__ const double c_invfreq_rev[16] = {1.59154943091895345608e-01, 8.94994016088910132600e-02, 5.03292121044870352509e-02, 2.83021958306233986646e-02, 1.59154943091895338669e-02, 8.94994016088910236684e-03, 5.03292121044870369856e-03, 2.83021958306233986646e-03, 1.59154943091895356017e-03, 8.94994016088910236684e-04, 5.03292121044870326488e-04, 2.83021958306233954120e-04, 1.59154943091895350596e-04, 8.94994016088910182474e-05, 5.03292121044870353593e-05, 2.83021958306233960897e-05};
typedef const __attribute__((address_space(4))) Params* PP;
__device__ __forceinline__ PP launder(PP q) { asm volatile("" : "+s"(q)); return q; }
__device__ __forceinline__ float bf2f(u16 b) { return __uint_as_float(((unsigned)b) << 16); }
typedef __attribute__((ext_vector_type(2))) __bf16 bf16x2_t;
__device__ __forceinline__ u16 f2bf(float f) { return __builtin_bit_cast(u16, (__bf16)f); }
__device__ __forceinline__ unsigned pack2(float a, float b) { bf16x2_t v = {(__bf16)a, (__bf16)b}; return __builtin_bit_cast(unsigned, v); }
__device__ __forceinline__ float lo16(unsigned u) { return __uint_as_float(u << 16); }
__device__ __forceinline__ float hi16(unsigned u) { return __uint_as_float(u & 0xffff0000u); }
__device__ __forceinline__ void unpack8(uint4 a, float* v) {
  v[0] = lo16(a.x); v[1] = hi16(a.x); v[2] = lo16(a.y); v[3] = hi16(a.y);
  v[4] = lo16(a.z); v[5] = hi16(a.z); v[6] = lo16(a.w); v[7] = hi16(a.w);
}
__device__ __forceinline__ uint4 pack8(const float* v) {
  uint4 a; a.x = pack2(v[0], v[1]); a.y = pack2(v[2], v[3]); a.z = pack2(v[4], v[5]); a.w = pack2(v[6], v[7]); return a;
}
__device__ __forceinline__ float sigmoidf_(float x) { return __builtin_amdgcn_rcpf(1.f + __expf(-x)); }
__device__ __forceinline__ float siluf_(float x) { return x * __builtin_amdgcn_rcpf(1.f + __expf(-x)); }
__device__ __forceinline__ float geluf_(float x) {
  float u = 1.5957691216057308f * (x + 0.044715f * x * x * x);
  return x * __builtin_amdgcn_rcpf(1.f + __expf(-u));
}
__device__ __forceinline__ float wave_sum(float v) {
#pragma unroll
  for (int o = 32; o >= 1; o >>= 1) v += __shfl_xor(v, o);
  return v;
}
__device__ __forceinline__ int opaque_tid() { int t = threadIdx.x; asm volatile("" : "+v"(t)); return t; }
__device__ __forceinline__ f32x16 mfma32(bf16x8 a, bf16x8 b, f32x16 c) {
  return __builtin_amdgcn_mfma_f32_32x32x16_bf16(a, b, c, 0, 0, 0);
}

struct GStage { u32x4 w0, w1, w2, w3, x0, x1, x2, x3; };
__device__ __forceinline__ void gs_load(GStage& g, const u16* gw, int ldw, const u16* gx, int ldx, int k0) {
  g.w0 = *(const u32x4*)(gw + k0);
  g.w1 = *(const u32x4*)(gw + (size_t)32 * ldw + k0);
  g.w2 = *(const u32x4*)(gw + (size_t)64 * ldw + k0);
  g.w3 = *(const u32x4*)(gw + (size_t)96 * ldw + k0);
  g.x0 = *(const u32x4*)(gx + k0);
  g.x1 = *(const u32x4*)(gx + (size_t)32 * ldx + k0);
  g.x2 = *(const u32x4*)(gx + (size_t)64 * ldx + k0);
  g.x3 = *(const u32x4*)(gx + (size_t)96 * ldx + k0);
}
__device__ __forceinline__ void gs_store(const GStage& g, u16* db, int lo) {
  *(u32x4*)(db + lo) = g.w0;
  *(u32x4*)(db + lo + 32 * LDT) = g.w1;
  *(u32x4*)(db + lo + 64 * LDT) = g.w2;
  *(u32x4*)(db + lo + 96 * LDT) = g.w3;
  *(u32x4*)(db + TILE_U16 + lo) = g.x0;
  *(u32x4*)(db + TILE_U16 + lo + 32 * LDT) = g.x1;
  *(u32x4*)(db + TILE_U16 + lo + 64 * LDT) = g.x2;
  *(u32x4*)(db + TILE_U16 + lo + 96 * LDT) = g.x3;
}
__device__ __forceinline__ void gemm_kstep(const u16* sb, int wn, int wt, int r, int h, f32x16 (&acc)[2][2]) {
  const u16* bw = sb + (wn * 64 + r) * LDT + h * 8;
  const u16* bx = sb + TILE_U16 + (wt * 64 + r) * LDT + h * 8;
  __builtin_amdgcn_s_setprio(1);
#pragma unroll
  for (int ks = 0; ks < 4; ++ks) {
    bf16x8 a0 = *(const bf16x8*)(bw + ks * 16);
    bf16x8 a1 = *(const bf16x8*)(bw + 32 * LDT + ks * 16);
    bf16x8 b0 = *(const bf16x8*)(bx + ks * 16);
    bf16x8 b1 = *(const bf16x8*)(bx + 32 * LDT + ks * 16);
    acc[0][0] = mfma32(a0, b0, acc[0][0]);
    acc[0][1] = mfma32(a0, b1, acc[0][1]);
    acc[1][0] = mfma32(a1, b0, acc[1][0]);
    acc[1][1] = mfma32(a1, b1, acc[1][1]);
  }
  __builtin_amdgcn_s_setprio(0);
}
__device__ __forceinline__ void gemm_tile(const u16* __restrict__ W, int ldw, const u16* __restrict__ X, int ldx,
                                          int K, u16* lds, f32x16 (&acc)[2][2]) {
  const int tid = opaque_tid(), lane = tid & 63, w = tid >> 6, r = lane & 31, h = lane >> 5;
  const int wn = w >> 1, wt = w & 1;
#pragma unroll
  for (int a = 0; a < 2; ++a)
#pragma unroll
    for (int b = 0; b < 2; ++b)
#pragma unroll
      for (int i = 0; i < 16; ++i) acc[a][b][i] = 0.f;
  const int lrow = tid >> 3, lc = tid & 7;
  const u16* gw = W + (size_t)lrow * ldw + lc * 8;
  const u16* gx = X + (size_t)lrow * ldx + lc * 8;
  const int lo = lrow * LDT + lc * 8;
  const int nk = K >> 6;
  GStage A, B;
  gs_load(B, gw, ldw, gx, ldx, 0);
  if (nk > 1) gs_load(A, gw, ldw, gx, ldx, 64);
  gs_store(B, lds, lo);
  __syncthreads();
  for (int kt = 0; kt < nk; kt += 2) {
    if (kt + 2 < nk) gs_load(B, gw, ldw, gx, ldx, (kt + 2) * 64);
    gemm_kstep(lds, wn, wt, r, h, acc);
    if (kt + 1 < nk) gs_store(A, lds + 2 * TILE_U16, lo);
    __syncthreads();
    if (kt + 1 < nk) {
      if (kt + 3 < nk) gs_load(A, gw, ldw, gx, ldx, (kt + 3) * 64);
      gemm_kstep(lds + 2 * TILE_U16, wn, wt, r, h, acc);
      if (kt + 2 < nk) gs_store(B, lds, lo);
      __syncthreads();
    }
  }
}

__device__ __forceinline__ void stage_f32(float* st, f32x16 (&acc)[2][2]) {
  const int tid = opaque_tid(), lane = tid & 63, w = tid >> 6, r = lane & 31, h = lane >> 5;
  const int wn = w >> 1, wt = w & 1;
#pragma unroll
  for (int nb = 0; nb < 2; ++nb)
#pragma unroll
    for (int tb = 0; tb < 2; ++tb) {
      const int token = wt * 64 + tb * 32 + r;
#pragma unroll
      for (int g = 0; g < 4; ++g) {
        const int n0 = wn * 64 + nb * 32 + 8 * g + 4 * h;
        float4 v = make_float4(acc[nb][tb][4 * g], acc[nb][tb][4 * g + 1], acc[nb][tb][4 * g + 2], acc[nb][tb][4 * g + 3]);
        *(float4*)(st + token * 132 + n0) = v;
      }
    }
}
__device__ __forceinline__ void stage_bf16(u16* st, f32x16 (&acc)[2][2]) {
  const int tid = opaque_tid(), lane = tid & 63, w = tid >> 6, r = lane & 31, h = lane >> 5;
  const int wn = w >> 1, wt = w & 1;
#pragma unroll
  for (int nb = 0; nb < 2; ++nb)
#pragma unroll
    for (int tb = 0; tb < 2; ++tb) {
      const int token = wt * 64 + tb * 32 + r;
#pragma unroll
      for (int g = 0; g < 4; ++g) {
        const int n0 = wn * 64 + nb * 32 + 8 * g + 4 * h;
        uint2 v;
        v.x = pack2(acc[nb][tb][4 * g], acc[nb][tb][4 * g + 1]);
        v.y = pack2(acc[nb][tb][4 * g + 2], acc[nb][tb][4 * g + 3]);
        *(uint2*)(st + token * 136 + n0) = v;
      }
    }
}

__device__ void gemm_store_tile(const u16* W, int ldw, const u16* X, int ldx, int K, u16* out, int ldo, u16* lds) {
  f32x16 acc[2][2];
  gemm_tile(W, ldw, X, ldx, K, lds, acc);
  stage_bf16(lds, acc);
  __syncthreads();
  const int tid = opaque_tid();
#pragma unroll
  for (int i = 0; i < 8; ++i) {
    const int id = tid + 256 * i;
    const int row = id >> 4, c = id & 15;
    uint4 v = *(const uint4*)(lds + row * 136 + c * 8);
    *(uint4*)(out + (size_t)row * ldo + c * 8) = v;
  }
  __syncthreads();
}

__device__ void gemm_phase(const u16* __restrict__ Wb, int ldw, const u16* __restrict__ Xb, int ldx, int K,
                           u16* __restrict__ outb, int ldo, int ntn, int ntiles, u16* lds) {
  const int tid = opaque_tid(), lane = tid & 63, w = tid >> 6, r = lane & 31, h = lane >> 5;
  const int wn = w >> 1, wt = w & 1;
  const int lrow = tid >> 3, lc = tid & 7;
  const int lo = lrow * LDT + lc * 8;
  const int nk = K >> 6;
  const int nbl = gridDim.x >> 3;
  const int xl = blockIdx.x & 7, jl = blockIdx.x >> 3;
  const int mt_per = (ntiles / ntn) >> 3;
  const int L = mt_per * ntn;
  int q = jl;
  if (q >= L) return;
#define GP_MT(qq) (xl * mt_per + ((qq) / (8 * ntn)) * 8 + ((qq) % (8 * ntn)) % 8)
#define GP_NT(qq) (((qq) % (8 * ntn)) / 8)
  const u16* gw = Wb + (size_t)(GP_NT(q) * 128 + lrow) * ldw + lc * 8;
  const u16* gx = Xb + (size_t)(GP_MT(q) * 128 + lrow) * ldx + lc * 8;
  GStage A, B;
  gs_load(B, gw, ldw, gx, ldx, 0);
  gs_load(A, gw, ldw, gx, ldx, 64);
  for (; q < L; q += nbl) {
    const int qn = q + nbl;
    const bool has_next = qn < L;
    const int qq = has_next ? qn : q;
    const u16* gwn = Wb + (size_t)(GP_NT(qq) * 128 + lrow) * ldw + lc * 8;
    const u16* gxn = Xb + (size_t)(GP_MT(qq) * 128 + lrow) * ldx + lc * 8;
    f32x16 acc[2][2];
#pragma unroll
    for (int a = 0; a < 2; ++a)
#pragma unroll
      for (int b = 0; b < 2; ++b)
#pragma unroll
        for (int i = 0; i < 16; ++i) acc[a][b][i] = 0.f;
    gs_store(B, lds, lo);
    __syncthreads();
    for (int kt = 0; kt < nk; kt += 2) {
      if (kt + 2 < nk) gs_load(B, gw, ldw, gx, ldx, (kt + 2) * 64);
      else if (has_next) gs_load(B, gwn, ldw, gxn, ldx, 0);
      gemm_kstep(lds, wn, wt, r, h, acc);
      gs_store(A, lds + 2 * TILE_U16, lo);
      __syncthreads();
      if (kt + 3 < nk) gs_load(A, gw, ldw, gx, ldx, (kt + 3) * 64);
      else if (has_next) gs_load(A, gwn, ldw, gxn, ldx, 64);
      gemm_kstep(lds + 2 * TILE_U16, wn, wt, r, h, acc);
      if (kt + 2 < nk) gs_store(B, lds, lo);
      __syncthreads();
    }
    stage_bf16(lds, acc);
    __syncthreads();
    u16* out = outb + (size_t)GP_MT(q) * 128 * ldo + GP_NT(q) * 128;
#pragma unroll
    for (int i = 0; i < 8; ++i) {
      const int id = tid + 256 * i;
      const int row = id >> 4, c = id & 15;
      uint4 v = *(const uint4*)(lds + row * 136 + c * 8);
      *(uint4*)(out + (size_t)row * ldo + c * 8) = v;
    }
    __syncthreads();
    gw = gwn; gx = gxn;
  }
#undef GP_MT
#undef GP_NT
}

__device__ void prep_transpose(const float* __restrict__ src, size_t sstride, int nmat, int R, int C, u16* __restrict__ dst,
                               size_t dstride, int dld, const float* __restrict__ gk, int mode, float* tile, int bid, int nb) {
  const int tid = opaque_tid();
  const int tr = R >> 6, tc = (C + 63) >> 6;
  const int per = tr * tc;
  for (int t = bid; t < per * nmat; t += nb) {
    const int m = t / per, tt = t % per;
    const int r0 = (tt / tc) * 64, c0 = (tt % tc) * 64;
    const float* sm = src + (size_t)m * sstride;
    u16* dm = dst + (size_t)m * dstride;
    __syncthreads();
#pragma unroll
    for (int i = 0; i < 16; ++i) {
      const int rr = i * 4 + (tid >> 6), cc = tid & 63;
      float v = 0.f;
      if (c0 + cc < C) {
        v = sm[(size_t)(r0 + rr) * C + c0 + cc];
        if (gk) v *= gk[m * R + r0 + rr];
      }
      tile[rr * 65 + cc] = v;
    }
    __syncthreads();
#pragma unroll
    for (int i = 0; i < 16; ++i) {
      const int cc = i * 4 + (tid >> 6), rr = tid & 63;
      const int c = c0 + cc;
      if (c < C) {
        const int n = (mode == 1) ? (c / 96) * 128 + (c % 96) : c;
        dm[(size_t)n * dld + r0 + rr] = f2bf(tile[rr * 65 + cc]);
      }
    }
  }
}
__device__ void phase_prep(PP p, float* ldsf) {
  p = launder(p);
  const int bid = blockIdx.x, nb = gridDim.x, tid = opaque_tid();
  const int gtid = bid * 256 + tid, gn = nb * 256;
  if (bid == 0) p->counters[tid] = 0;
  prep_transpose(p->w_in, (size_t)DM * DIN, NLAYER, DM, DIN, p->wInT, (size_t)DINP * DM, DM, nullptr, 0, ldsf, bid, nb);
  prep_transpose(p->w_out, (size_t)DM * DM, NLAYER, DM, DM, p->wOutT, (size_t)DM * DM, DM, nullptr, 0, ldsf, (bid + 256) % nb, nb);
  prep_transpose(p->w_uq, (size_t)192 * 576, NLAYER, 192, 576, p->wUqT, (size_t)768 * 192, 192, p->q_g, 1, ldsf, (bid + 128) % nb, nb);
  prep_transpose(p->w_ukv, (size_t)128 * 768, NLAYER, 128, 768, p->wUkvT, (size_t)768 * 128, 128, p->kv_g, 0, ldsf, (bid + 384) % nb, nb);
  prep_transpose(p->lru_wa, 4096, NLAYER * 6, 64, 64, p->waT, 4096, 64, nullptr, 0, ldsf, (bid + 64) % nb, nb);
  prep_transpose(p->lru_wx, 4096, NLAYER * 6, 64, 64, p->wxT, 4096, 64, nullptr, 0, ldsf, (bid + 192) % nb, nb);
  for (int i = gtid; i < NLAYER * 32 * DM; i += gn) {
    const int l = i / (32 * DM), rem = i % (32 * DM);
    p->wInT[(size_t)l * DINP * DM + (size_t)DIN * DM + rem] = 0;
  }
  for (int i = gtid; i < NLAYER * 6 * 32 * 192; i += gn) {
    const int l = i / (6 * 32 * 192), rem = i % (6 * 32 * 192);
    const int hd = rem / (32 * 192), rem2 = rem % (32 * 192);
    p->wUqT[(size_t)l * 768 * 192 + (size_t)(hd * 128 + 96) * 192 + rem2] = 0;
  }
  for (int i = gtid; i < NLAYER * 4 * 128 * 128; i += gn) {
    const int ii = (i >> 7) & 127, jj = i & 127;
    const float v = (ii >= 64 || jj < 64) ? p->sgu_w[i] : 0.f;
    p->sguW[i] = f2bf(v);
  }
  for (int i = gtid; i < T_TOK * 16; i += gn) {
    const int t = i >> 4, k = i & 15;
    const double rev = (double)p->pos[t] * c_invfreq_rev[k];
    const double fr = rev - __builtin_rint(rev);
    const float f = (float)fr;
    p->tab[i] = make_float2(__builtin_amdgcn_cosf(f), __builtin_amdgcn_sinf(f));
  }
}

typedef __attribute__((ext_vector_type(4))) float f32x4;
__device__ void phase_norm(PP p, int l) {
  p = launder(p);
  const int tid_ = opaque_tid();
  const int lane = tid_ & 63;
  const int gw = blockIdx.x * 4 + (tid_ >> 6), nw = gridDim.x * 4;
  const float* xin = (l == 0) ? p->x : p->out;
  const float* gpost = p->post_g + (l > 0 ? l - 1 : 0) * DM;
  const float* gpre = p->pre_g + (l < NLAYER ? l : 0) * DM;
  constexpr int NTK = 4;
  for (int tok0 = gw; tok0 < T_TOK; tok0 += NTK * nw) {
    f32x4 xv[NTK][4];
    u32x2 yu[NTK][4];
#pragma unroll
    for (int t = 0; t < NTK; ++t) {
      const int tok = (tok0 + t * nw < T_TOK) ? tok0 + t * nw : tok0;
#pragma unroll
      for (int i = 0; i < 4; ++i) xv[t][i] = __builtin_nontemporal_load((const f32x4*)(xin + (size_t)tok * DM + i * 256 + lane * 4));
    }
    if (l > 0) {
#pragma unroll
      for (int t = 0; t < NTK; ++t) {
        const int tok = (tok0 + t * nw < T_TOK) ? tok0 + t * nw : tok0;
#pragma unroll
        for (int i = 0; i < 4; ++i) yu[t][i] = __builtin_nontemporal_load((const u32x2*)(p->y2 + (size_t)tok * DM + i * 256 + lane * 4));
      }
    }
#pragma unroll
    for (int t = 0; t < NTK; ++t) {
      const int tok = (tok0 + t * nw < T_TOK) ? tok0 + t * nw : tok0;
      if (l > 0) {
        float yv[16];
        float ss = 0.f;
#pragma unroll
        for (int i = 0; i < 4; ++i) {
          yv[4 * i] = lo16(yu[t][i].x); yv[4 * i + 1] = hi16(yu[t][i].x); yv[4 * i + 2] = lo16(yu[t][i].y); yv[4 * i + 3] = hi16(yu[t][i].y);
          ss += yv[4 * i] * yv[4 * i] + yv[4 * i + 1] * yv[4 * i + 1] + yv[4 * i + 2] * yv[4 * i + 2] + yv[4 * i + 3] * yv[4 * i + 3];
        }
        ss = wave_sum(ss);
        const float rs = rsqrtf(ss * (1.f / 1024.f) + EPSF);
#pragma unroll
        for (int i = 0; i < 4; ++i) {
          float4 gv = *(const float4*)(gpost + i * 256 + lane * 4);
          xv[t][i].x += yv[4 * i] * rs * gv.x; xv[t][i].y += yv[4 * i + 1] * rs * gv.y;
          xv[t][i].z += yv[4 * i + 2] * rs * gv.z; xv[t][i].w += yv[4 * i + 3] * rs * gv.w;
        }
      }
#pragma unroll
      for (int i = 0; i < 4; ++i) __builtin_nontemporal_store(xv[t][i], (f32x4*)(p->out + (size_t)tok * DM + i * 256 + lane * 4));
      if (l < NLAYER) {
        float ss = 0.f;
#pragma unroll
        for (int i = 0; i < 4; ++i) ss += xv[t][i].x * xv[t][i].x + xv[t][i].y * xv[t][i].y + xv[t][i].z * xv[t][i].z + xv[t][i].w * xv[t][i].w;
        ss = wave_sum(ss);
        const float rs = rsqrtf(ss * (1.f / 1024.f) + EPSF);
#pragma unroll
        for (int i = 0; i < 4; ++i) {
          float4 gv = *(const float4*)(gpre + i * 256 + lane * 4);
          uint2 u;
          u.x = pack2(xv[t][i].x * rs * gv.x, xv[t][i].y * rs * gv.y);
          u.y = pack2(xv[t][i].z * rs * gv.z, xv[t][i].w * rs * gv.w);
          *(uint2*)(p->hbuf + (size_t)tok * DM + i * 256 + lane * 4) = u;
        }
      }
    }
  }
}

__device__ void item_q(PP p, int l, int rt, int hd, u16* lds, float* ssm, bool do_rstd) {
  p = launder(p);
  const int tid = opaque_tid();
  const int m0 = rt * 128;
  if (do_rstd) {
    const int row = tid >> 1, half = tid & 1;
    const u16* src = p->proj + (size_t)(m0 + row) * DINP + C_QL + half * 96;
    float ss = 0.f;
#pragma unroll
    for (int i = 0; i < 12; ++i) {
      float v[8]; unpack8(*(const uint4*)(src + i * 8), v);
#pragma unroll
      for (int j = 0; j < 8; ++j) ss += v[j] * v[j];
    }
    ss += __shfl_xor(ss, 1);
    if (half == 0) ssm[row] = rsqrtf(ss * (1.f / 192.f) + EPSF);
  }
  f32x16 acc[2][2];
  gemm_tile(p->wUqT + (size_t)l * 768 * 192 + (size_t)hd * 128 * 192, 192, p->proj + (size_t)m0 * DINP + C_QL, DINP, 192, lds, acc);
  float* st = (float*)lds;
  stage_f32(st, acc);
  __syncthreads();
  const float qscale = 0.10206207261596577f * 1.4426950408889634f;
#pragma unroll
  for (int i = 0; i < 6; ++i) {
    const int u = tid + 256 * i;
    const int row = u / 12, dg = u % 12;
    const float sc = ssm[row] * qscale;
    const float* sr = st + row * 132;
    float o[8];
    if (dg < 8) {
      const float4 a = *(const float4*)(sr + dg * 8), bq = *(const float4*)(sr + dg * 8 + 4);
      o[0] = a.x * sc; o[1] = a.y * sc; o[2] = a.z * sc; o[3] = a.w * sc;
      o[4] = bq.x * sc; o[5] = bq.y * sc; o[6] = bq.z * sc; o[7] = bq.w * sc;
    } else {
      const int i0 = (dg & 1) * 8;
      const float2* tb = p->tab + (size_t)(m0 + row) * 16 + i0;
      const float4 a0 = *(const float4*)(sr + 64 + i0), a1 = *(const float4*)(sr + 68 + i0);
      const float4 b0 = *(const float4*)(sr + 80 + i0), b1 = *(const float4*)(sr + 84 + i0);
      const float x1[8] = {a0.x, a0.y, a0.z, a0.w, a1.x, a1.y, a1.z, a1.w};
      const float x2[8] = {b0.x, b0.y, b0.z, b0.w, b1.x, b1.y, b1.z, b1.w};
      const float4 t0 = *(const float4*)(tb), t1 = *(const float4*)(tb + 2), t2 = *(const float4*)(tb + 4), t3 = *(const float4*)(tb + 6);
      const float cc[8] = {t0.x, t0.z, t1.x, t1.z, t2.x, t2.z, t3.x, t3.z};
      const float sn[8] = {t0.y, t0.w, t1.y, t1.w, t2.y, t2.w, t3.y, t3.w};
      if (dg < 10) {
#pragma unroll
        for (int j = 0; j < 8; ++j) o[j] = (x1[j] * cc[j] - x2[j] * sn[j]) * sc;
      } else {
#pragma unroll
        for (int j = 0; j < 8; ++j) o[j] = (x2[j] * cc[j] + x1[j] * sn[j]) * sc;
      }
    }
    *(uint4*)(p->Q + ((size_t)(m0 + row) * 6 + hd) * 96 + dg * 8) = pack8(o);
  }
  __syncthreads();
}

__device__ void item_kv(PP p, int l, int rt, int hd, u16* lds, float* ssm, bool do_rstd) {
  p = launder(p);
  const int tid = opaque_tid();
  const int m0 = rt * 128;
  if (do_rstd) {
    const int row = tid >> 1, half = tid & 1;
    const u16* src = p->proj + (size_t)(m0 + row) * DINP + C_KVL + half * 64;
    float ss = 0.f;
#pragma unroll
    for (int i = 0; i < 8; ++i) {
      float v[8]; unpack8(*(const uint4*)(src + i * 8), v);
#pragma unroll
      for (int j = 0; j < 8; ++j) ss += v[j] * v[j];
    }
    ss += __shfl_xor(ss, 1);
    if (half == 0) ssm[row] = rsqrtf(ss * (1.f / 128.f) + EPSF);
  }
  f32x16 acc[2][2];
  gemm_tile(p->wUkvT + (size_t)l * 768 * 128 + (size_t)hd * 128 * 128, 128, p->proj + (size_t)m0 * DINP + C_KVL, DINP, 128, lds, acc);
  float* st = (float*)lds;
  stage_f32(st, acc);
  __syncthreads();
  const int kb_ = m0 / SEQ, ks0_ = m0 % SEQ;
#pragma unroll
  for (int i = 0; i < 4; ++i) {
    const int u = tid + 256 * i;
    const int row = u >> 3, dg = u & 7;
    const float sc = ssm[row];
    const float* sr = st + row * 132 + dg * 8;
    float o[8];
    {
      const float4 a = *(const float4*)(sr), bq = *(const float4*)(sr + 4);
      o[0] = a.x * sc; o[1] = a.y * sc; o[2] = a.z * sc; o[3] = a.w * sc;
      o[4] = bq.x * sc; o[5] = bq.y * sc; o[6] = bq.z * sc; o[7] = bq.w * sc;
    }
    *(uint4*)(p->K + ((size_t)(kb_ * 6 + hd) * SEQ + ks0_ + row) * 96 + dg * 8) = pack8(o);
  }
  if (hd == 0) {
#pragma unroll
    for (int i = 0; i < 2; ++i) {
      const int u = tid + 256 * i;
      const int row = u >> 2, dq = u & 3;
      const int i0 = (dq & 1) * 8;
      const u16* kr = p->proj + (size_t)(m0 + row) * DINP + C_KR;
      float x1[8], x2[8], o[8];
      unpack8(*(const uint4*)(kr + i0), x1);
      unpack8(*(const uint4*)(kr + 16 + i0), x2);
      const float2* tb = p->tab + (size_t)(m0 + row) * 16 + i0;
      if (dq < 2) {
#pragma unroll
        for (int j = 0; j < 8; ++j) { float2 cs = tb[j]; o[j] = x1[j] * cs.x - x2[j] * cs.y; }
      } else {
#pragma unroll
        for (int j = 0; j < 8; ++j) { float2 cs = tb[j]; o[j] = x2[j] * cs.x + x1[j] * cs.y; }
      }
      const uint4 ov = pack8(o);
#pragma unroll
      for (int hh2 = 0; hh2 < 6; ++hh2)
        *(uint4*)(p->K + ((size_t)(kb_ * 6 + hh2) * SEQ + ks0_ + row) * 96 + 64 + dq * 8) = ov;
    }
  }
  const int b = m0 / SEQ, s0 = m0 % SEQ;
#pragma unroll
  for (int i = 0; i < 4; ++i) {
    const int u = tid + 256 * i;
    const int dv = u & 63, tg = u >> 6;
    float o[8];
#pragma unroll
    for (int j = 0; j < 8; ++j) o[j] = st[(tg * 8 + j) * 132 + 64 + dv] * ssm[tg * 8 + j];
    u16* vdst = p->VT + (((size_t)(b * 6 + hd) * 128 + (s0 >> 6) + (tg >> 3)) * 64 + dv) * 64 + ((tg & 7) >> 1) * 16 + (tg & 1) * 4;
    uint2 lo2, hi2;
    lo2.x = pack2(o[0], o[1]); lo2.y = pack2(o[2], o[3]);
    hi2.x = pack2(o[4], o[5]); hi2.y = pack2(o[6], o[7]);
    *(uint2*)(vdst) = lo2;
    *(uint2*)(vdst + 8) = hi2;
  }
  __syncthreads();
}

__device__ void item_lru(PP p, int l, int tt, int hd, u16* lds, float* ssm) {
  p = launder(p);
  const int tid = opaque_tid(), lane = tid & 63, w = tid >> 6, r = lane & 31, h = lane >> 5;
  const int t0 = tt * 64;
  const int s0 = t0 % SEQ;
  float* xaf = (float*)lds;
  u16* xcb = lds + 8576;
  float* aarr = (float*)(lds + 8576 + 4608);
  float* barr = aarr + 4096;
  const int c = tid & 63;
  const int cg = hd * 64 + c;
  bf16x8 wfa[4], wfx[4];
  {
    const int cbk_ = w & 1;
    const u16* wa_ = p->waT + (size_t)(l * 6 + hd) * 4096 + (cbk_ * 32 + r) * 64 + h * 8;
    const u16* wx_ = p->wxT + (size_t)(l * 6 + hd) * 4096 + (cbk_ * 32 + r) * 64 + h * 8;
#pragma unroll
    for (int ks = 0; ks < 4; ++ks) { wfa[ks] = *(const bf16x8*)(wa_ + ks * 16); wfx[ks] = *(const bf16x8*)(wx_ + ks * 16); }
  }
  for (int u = tid; u < 67 * 8; u += 256) {
    const int row = u >> 3, c8 = u & 7;
    float v[8];
    if (s0 + row - 3 >= 0) {
      unpack8(*(const uint4*)(p->proj + (size_t)(t0 + row - 3) * DINP + C_XA + hd * 64 + c8 * 8), v);
    } else {
#pragma unroll
      for (int j = 0; j < 8; ++j) v[j] = 0.f;
    }
    *(float4*)(xaf + row * 64 + c8 * 8) = make_float4(v[0], v[1], v[2], v[3]);
    *(float4*)(xaf + row * 64 + c8 * 8 + 4) = make_float4(v[4], v[5], v[6], v[7]);
  }
  __syncthreads();
  const float cw0 = p->conv_w[(l * 4 + 0) * 384 + cg], cw1 = p->conv_w[(l * 4 + 1) * 384 + cg];
  const float cw2 = p->conv_w[(l * 4 + 2) * 384 + cg], cw3 = p->conv_w[(l * 4 + 3) * 384 + cg];
  const float cbias = p->conv_b[l * 384 + cg];
  {
    const int tq = tid >> 6;
    for (int t = tq * 16; t < tq * 16 + 16; ++t) {
      const float xc = cbias + cw0 * xaf[t * 64 + c] + cw1 * xaf[(t + 1) * 64 + c] + cw2 * xaf[(t + 2) * 64 + c] + cw3 * xaf[(t + 3) * 64 + c];
      xcb[t * LDT + c] = f2bf(xc);
    }
  }
  __syncthreads();
  {
    const int tb = w >> 1, cbk = w & 1;
    f32x16 aa, ax;
#pragma unroll
    for (int i = 0; i < 16; ++i) { aa[i] = 0.f; ax[i] = 0.f; }
    const u16* xr = xcb + (tb * 32 + r) * LDT + h * 8;
#pragma unroll
    for (int ks = 0; ks < 4; ++ks) {
      bf16x8 af = *(const bf16x8*)(xr + ks * 16);
      aa = mfma32(af, wfa[ks], aa);
      ax = mfma32(af, wfx[ks], ax);
    }
    const int cc = cbk * 32 + r;
    const int cgl = hd * 64 + cc;
    const float ba = p->lru_ba[l * 384 + cgl], bx = p->lru_bx[l * 384 + cgl];
    const float lam = p->lru_lam[l * 384 + cgl];
    const float nl = -lam;
    const float sp = fmaxf(nl, 0.f) + log1pf(expf(-fabsf(nl)));
#pragma unroll
    for (int reg = 0; reg < 16; ++reg) {
      const int t = tb * 32 + (reg & 3) + 8 * (reg >> 2) + 4 * h;
      const float xc = bf2f(xcb[t * LDT + cc]);
      const float ga = sigmoidf_(aa[reg] + ba);
      const float gx = sigmoidf_(ax[reg] + bx);
      const float la = -8.f * ga * sp;
      const float a = __expf(la);
      const float om = (la > -5e-4f) ? (-2.f * la) * (1.f + la) : (1.f - a * a);
      const float mult = sqrtf(fmaxf(om, 0.f));
      aarr[t * 64 + cc] = a;
      barr[t * 64 + cc] = mult * gx * xc;
    }
  }
  __syncthreads();
  const int seg = tid >> 6;
  u16* h16 = (u16*)aarr;
  u16* c16 = (u16*)barr;
  float pr[16], hr[16];
#pragma unroll
  for (int j = 0; j < 16; ++j) { pr[j] = aarr[(seg * 16 + j) * 64 + c]; hr[j] = barr[(seg * 16 + j) * 64 + c]; }
  {
    float hh = 0.f, P = 1.f;
#pragma unroll
    for (int j = 0; j < 16; ++j) { hh = pr[j] * hh + hr[j]; P *= pr[j]; hr[j] = hh; pr[j] = P; }
    ssm[seg * 64 + c] = P;
    ssm[256 + seg * 64 + c] = hh;
  }
  __syncthreads();
  {
    float Hc = 0.f, Pc = 1.f;
    for (int s2 = 0; s2 < seg; ++s2) {
      const float Ps = ssm[s2 * 64 + c], Hs = ssm[256 + s2 * 64 + c];
      Hc = Ps * Hc + Hs; Pc *= Ps;
    }
    float hl = 0.f, cm = 1.f;
#pragma unroll
    for (int j = 0; j < 16; ++j) {
      hl = hr[j] + pr[j] * Hc;
      cm = pr[j] * Pc;
      h16[(seg * 16 + j) * 64 + c] = f2bf(hl);
      c16[(seg * 16 + j) * 64 + c] = f2bf(cm);
    }
    if (seg == 3) {
      p->Htile[(size_t)tt * 384 + cg] = hl;
      p->Ptile[(size_t)tt * 384 + cg] = cm;
    }
  }
  __syncthreads();
#pragma unroll
  for (int i = 0; i < 2; ++i) {
    const int id = tid + 256 * i;
    const int row = id >> 3, c8 = id & 7;
    const uint4 hv = *(const uint4*)(h16 + row * 64 + c8 * 8);
    const uint4 cv = *(const uint4*)(c16 + row * 64 + c8 * 8);
    *(uint4*)(p->hloc + (size_t)(t0 + row) * 384 + hd * 64 + c8 * 8) = hv;
    *(uint4*)(p->cum + (size_t)(t0 + row) * 384 + hd * 64 + c8 * 8) = cv;
  }
  __syncthreads();
}

__device__ void item_sgu(PP p, int l, int nbk, u16* lds, float* ssm) {
  p = launder(p);
  const int tid = opaque_tid(), lane = tid & 63, w = tid >> 6, r = lane & 31, h = lane >> 5;
  const int m0 = nbk * 128;
  {
    const int row = tid >> 1, half = tid & 1;
    const u16* src = p->proj + (size_t)(m0 + row) * DINP + C_V + half * 128;
    float s1 = 0.f, s2 = 0.f;
#pragma unroll
    for (int i = 0; i < 16; ++i) {
      float v[8]; unpack8(*(const uint4*)(src + i * 8), v);
#pragma unroll
      for (int j = 0; j < 8; ++j) { const float gq = geluf_(v[j]); s1 += gq; s2 += gq * gq; }
    }
    s1 += __shfl_xor(s1, 1); s2 += __shfl_xor(s2, 1);
    if (half == 0) {
      const float mu = s1 * (1.f / 256.f);
      const float var = fmaxf(s2 * (1.f / 256.f) - mu * mu, 0.f);
      ssm[row] = mu; ssm[128 + row] = rsqrtf(var + EPSF);
    }
  }
  u16* vbT = lds;
  for (int g = 0; g < 4; ++g) {
    __syncthreads();
    {
      const int j = tid & 127, chalf = tid >> 7;
      const float mu = ssm[j], rs = ssm[128 + j];
      const u16* src = p->proj + (size_t)(m0 + j) * DINP + C_V + g * 64 + chalf * 32;
      const float* lg = p->sgu_g + l * 256 + g * 64 + chalf * 32;
      const float* lb = p->sgu_bn + l * 256 + g * 64 + chalf * 32;
#pragma unroll
      for (int i = 0; i < 4; ++i) {
        float v[8]; unpack8(*(const uint4*)(src + i * 8), v);
#pragma unroll
        for (int q = 0; q < 8; ++q) {
          const int cc = chalf * 32 + i * 8 + q;
          const float val = (geluf_(v[q]) - mu) * rs * lg[i * 8 + q] + lb[i * 8 + q];
          vbT[cc * 136 + j] = f2bf(val);
        }
      }
    }
    __syncthreads();
    f32x16 a0, a1;
#pragma unroll
    for (int i = 0; i < 16; ++i) { a0[i] = 0.f; a1[i] = 0.f; }
    const u16* wr = p->sguW + ((size_t)(l * 4 + g) * 128 + w * 32 + r) * 128 + h * 8;
    const u16* v0 = vbT + r * 136 + h * 8;
    const u16* v1 = vbT + (32 + r) * 136 + h * 8;
    const int nks = (w < 2) ? 4 : 8;
    for (int ks = 0; ks < nks; ++ks) {
      bf16x8 af = *(const bf16x8*)(wr + ks * 16);
      bf16x8 b0 = *(const bf16x8*)(v0 + ks * 16);
      bf16x8 b1 = *(const bf16x8*)(v1 + ks * 16);
      a0 = mfma32(af, b0, a0);
      a1 = mfma32(af, b1, a1);
    }
    float* stg = (float*)(lds + 8704);
#pragma unroll
    for (int reg = 0; reg < 16; ++reg) {
      const int i = w * 32 + (reg & 3) + 8 * (reg >> 2) + 4 * h;
      const float bsv = p->sgu_b[(l * 4 + g) * 128 + i];
      stg[i * 68 + r] = a0[reg] + bsv;
      stg[i * 68 + 32 + r] = a1[reg] + bsv;
    }
    __syncthreads();
#pragma unroll
    for (int k = 0; k < 4; ++k) {
      const int u = tid + 256 * k;
      const int i = u >> 3, c8 = u & 7;
      const size_t tok = (size_t)(m0 + i);
      const int ch = g * 64 + c8 * 8;
      const float4 m0v = *(const float4*)(stg + i * 68 + c8 * 8), m1v = *(const float4*)(stg + i * 68 + c8 * 8 + 4);
      const float mx[8] = {m0v.x, m0v.y, m0v.z, m0v.w, m1v.x, m1v.y, m1v.z, m1v.w};
      float uu[8], gcv[8], o[8];
      unpack8(*(const uint4*)(p->proj + tok * DINP + C_U + ch), uu);
      unpack8(*(const uint4*)(p->proj + tok * DINP + C_GC + ch), gcv);
#pragma unroll
      for (int q = 0; q < 8; ++q) o[q] = geluf_(uu[q]) * mx[q] * siluf_(gcv[q]);
      *(uint4*)(p->ycpre + tok * 256 + ch) = pack8(o);
    }
  }
  __syncthreads();
}

__device__ void item_carry(PP p, int ci) {
  p = launder(p);
  const int idx = ci * 256 + opaque_tid();
  const int b = idx / 384, c = idx % 384;
  float carry = 0.f;
  for (int tt = 0; tt < 128; ++tt) {
    const size_t o = (size_t)(b * 128 + tt) * 384 + c;
    p->carry[o] = carry;
    carry = p->Ptile[o] * carry + p->Htile[o];
  }
}

#define KLD 104
#define VLD 72
#define ATT_STAGE (64 * KLD + 64 * VLD)
struct AStage { u32x4 k0, k1, k2, v0, v1; };
__device__ __forceinline__ void as_load(AStage& g, const u16* kg, const u16* vg, int kt) {
  const u16* kp = kg + (size_t)kt * 6144;
  g.k0 = *(const u32x4*)(kp); g.k1 = *(const u32x4*)(kp + 2048); g.k2 = *(const u32x4*)(kp + 4096);
  const u16* vp = vg + (size_t)kt * 4096;
  g.v0 = *(const u32x4*)(vp); g.v1 = *(const u32x4*)(vp + 2048);
#ifdef DUP_LOADS
  {
    u32x4 t0 = *(const volatile u32x4*)(kp), t1 = *(const volatile u32x4*)(kp + 2048), t2 = *(const volatile u32x4*)(kp + 4096);
    u32x4 t3 = *(const volatile u32x4*)(vp), t4 = *(const volatile u32x4*)(vp + 2048);
    asm volatile("" :: "v"(t0), "v"(t1), "v"(t2), "v"(t3), "v"(t4));
  }
#endif
}
__device__ __forceinline__ void as_store(const AStage& g, u16* db, int kl0, int kl1, int kl2, int vl) {
  *(u32x4*)(db + kl0) = g.k0; *(u32x4*)(db + kl1) = g.k1; *(u32x4*)(db + kl2) = g.k2;
  *(u32x4*)(db + vl) = g.v0; *(u32x4*)(db + vl + 32 * VLD) = g.v1;
}
__device__ __forceinline__ float max3f(float a, float b, float c) {
  float d; asm("v_max3_f32 %0, %1, %2, %3" : "=v"(d) : "v"(a), "v"(b), "v"(c)); return d;
}
__device__ __forceinline__ bf16x8 pack_p(const f32x16& s, int o) {
  u32x4 pu;
  pu.x = pack2(s[o + 0], s[o + 1]); pu.y = pack2(s[o + 2], s[o + 3]);
  pu.z = pack2(s[o + 4], s[o + 5]); pu.w = pack2(s[o + 6], s[o + 7]);
  return __builtin_bit_cast(bf16x8, pu);
}
__device__ __forceinline__ void attn_qk(const u16* kp, const bf16x8 (&qa)[6], f32x16& s0, f32x16& s1) {
#pragma unroll
  for (int ks = 0; ks < 6; ++ks) {
    bf16x8 k0 = *(const bf16x8*)(kp + ks * 16);
    bf16x8 k1 = *(const bf16x8*)(kp + 32 * KLD + ks * 16);
    s0 = mfma32(k0, qa[ks], s0);
    s1 = mfma32(k1, qa[ks], s1);
  }
}
__device__ __forceinline__ void attn_tile(const u16* sb, const bf16x8 (&qa)[6], f32x16& o0, f32x16& o1, f32x16& lacc,
                                          float& m, bool& mz, int r, int h, bool first) {
  const u16* kp = sb + r * KLD + h * 8;
  f32x16 s0, s1;
  __builtin_amdgcn_s_setprio(1);
  if (mz) {
#pragma unroll
    for (int i = 0; i < 16; ++i) { s0[i] = 0.f; s1[i] = 0.f; }
    attn_qk(kp, qa, s0, s1);
  } else {
#pragma unroll
    for (int i = 0; i < 16; ++i) { s0[i] = -m; s1[i] = -m; }
    attn_qk(kp, qa, s0, s1);
  }
  __builtin_amdgcn_s_setprio(0);
  float mxa = max3f(s0[0], s0[1], s0[2]), mxb = max3f(s0[3], s0[4], s0[5]);
  float mxc = max3f(s0[6], s0[7], s0[8]), mxd = max3f(s0[9], s0[10], s0[11]);
  mxa = max3f(mxa, s0[12], s0[13]); mxb = max3f(mxb, s0[14], s0[15]);
  mxc = max3f(mxc, s1[0], s1[1]); mxd = max3f(mxd, s1[2], s1[3]);
  mxa = max3f(mxa, s1[4], s1[5]); mxb = max3f(mxb, s1[6], s1[7]);
  mxc = max3f(mxc, s1[8], s1[9]); mxd = max3f(mxd, s1[10], s1[11]);
  mxa = max3f(mxa, s1[12], s1[13]); mxb = max3f(mxb, s1[14], s1[15]);
  const float lm = max3f(mxa, mxb, fmaxf(mxc, mxd));
  bool slow;
  if (first) {
    const float mx = fmaxf(lm, __shfl_xor(lm, 32));
    slow = __any(mx > 30.f || mx < -30.f);
  } else {
    slow = __any(lm > 30.f);
  }
  if (slow) {
    const float mx = fmaxf(lm, __shfl_xor(lm, 32));
    const float d = first ? mx : fmaxf(mx, 0.f);
    const float alpha = first ? 1.f : __builtin_amdgcn_exp2f(-d);
    m += d;
    mz = false;
#pragma unroll
    for (int i = 0; i < 16; ++i) { s0[i] -= d; s1[i] -= d; o0[i] *= alpha; o1[i] *= alpha; }
    lacc[0] *= alpha;
  }
  float pa = 0.f, pb = 0.f, pc = 0.f, pd = 0.f;
#pragma unroll
  for (int i = 0; i < 16; ++i) {
    s0[i] = __builtin_amdgcn_exp2f(s0[i]); s1[i] = __builtin_amdgcn_exp2f(s1[i]);
    if ((i & 3) == 0) pa += s0[i] + s1[i];
    else if ((i & 3) == 1) pb += s0[i] + s1[i];
    else if ((i & 3) == 2) pc += s0[i] + s1[i];
    else pd += s0[i] + s1[i];
  }
  lacc[0] += (pa + pb) + (pc + pd);
  const u16* vp = sb + 64 * KLD + r * VLD + 8 * h;
  __builtin_amdgcn_s_setprio(1);
#pragma unroll
  for (int kb = 0; kb < 2; ++kb) {
#pragma unroll
    for (int s = 0; s < 2; ++s) {
      const bf16x8 pf = pack_p(kb == 0 ? s0 : s1, 8 * s);
      const int koff = kb * 32 + 16 * s;
      const bf16x8 v0 = *(const bf16x8*)(vp + koff);
      const bf16x8 v1 = *(const bf16x8*)(vp + 32 * VLD + koff);
      o0 = mfma32(v0, pf, o0);
      o1 = mfma32(v1, pf, o1);
    }
  }
  __builtin_amdgcn_s_setprio(0);
}
__device__ __forceinline__ void attn_write_o(u16* op, const f32x16& o0, const f32x16& o1, float inv) {
#pragma unroll
  for (int g = 0; g < 4; ++g) {
    uint2 v;
    v.x = pack2(o0[4 * g] * inv, o0[4 * g + 1] * inv); v.y = pack2(o0[4 * g + 2] * inv, o0[4 * g + 3] * inv);
    *(uint2*)(op + 8 * g) = v;
    v.x = pack2(o1[4 * g] * inv, o1[4 * g + 1] * inv); v.y = pack2(o1[4 * g + 2] * inv, o1[4 * g + 3] * inv);
    *(uint2*)(op + 32 + 8 * g) = v;
  }
}

__device__ void item_attn(PP p, int qb, int b, int hh, u16* lds) {
  p = launder(p);
  const int tid = opaque_tid(), lane = tid & 63, w = tid >> 6, r = lane & 31, h = lane >> 5;
  const size_t tokbase = (size_t)b * SEQ;
  const int q0 = qb * 128 + w * 32;
  bf16x8 qa[6];
  {
    const u16* qp = p->Q + ((tokbase + q0 + r) * 6 + hh) * 96 + h * 8;
#pragma unroll
    for (int ks = 0; ks < 6; ++ks) qa[ks] = *(const bf16x8*)(qp + ks * 16);
  }
  f32x16 oa0, oa1, lacc;
#pragma unroll
  for (int i = 0; i < 16; ++i) { oa0[i] = 0.f; oa1[i] = 0.f; lacc[i] = 0.f; }
  float ma = 0.f;
  bool mz = true;
  const int ntiles = 2 * qb + 2;
  const int my_ntiles = 2 * qb + 1 + (w >> 1);
  const u16* kg = p->K + (size_t)(b * 6 + hh) * SEQ * 96 + tid * 8;
  const u16* vg = p->VT + (size_t)(b * 6 + hh) * SEQ * 64 + tid * 8;
  const int id1 = tid + 256, id2 = tid + 512;
  const int kl0 = (tid / 12) * KLD + (tid % 12) * 8;
  const int kl1 = (id1 / 12) * KLD + (id1 % 12) * 8;
  const int kl2 = (id2 / 12) * KLD + (id2 % 12) * 8;
  const int vl = 64 * KLD + (tid >> 3) * VLD + (tid & 7) * 8;
  AStage A, B;
  as_load(B, kg, vg, 0);
  as_load(A, kg, vg, 1);
  as_store(B, lds, kl0, kl1, kl2, vl);
  __syncthreads();
  for (int kt = 0; kt < ntiles; kt += 2) {
    if (kt + 2 < ntiles) as_load(B, kg, vg, kt + 2);
    attn_tile(lds, qa, oa0, oa1, lacc, ma, mz, r, h, kt == 0);
    as_store(A, lds + ATT_STAGE, kl0, kl1, kl2, vl);
    __syncthreads();
    if (kt + 3 < ntiles) as_load(A, kg, vg, kt + 3);
    if (kt + 1 < my_ntiles) attn_tile(lds + ATT_STAGE, qa, oa0, oa1, lacc, ma, mz, r, h, false);
    if (kt + 2 < ntiles) as_store(B, lds, kl0, kl1, kl2, vl);
    __syncthreads();
  }
  const float lta = lacc[0] + __shfl_xor(lacc[0], 32);
  u16* op = p->obuf + (tokbase + q0 + r) * 384 + hh * 64 + 4 * h;
  attn_write_o(op, oa0, oa1, 1.f / lta);
}

__device__ void phase_y(PP p, int l) {
  p = launder(p);
  const int tid_ = opaque_tid();
  const int lane = tid_ & 63;
  const int gw = blockIdx.x * 4 + (tid_ >> 6), nw = gridDim.x * 4;
  const float* bg = p->br_g + l * DM + lane * 16;
  const int seg = (lane < 24) ? 0 : (lane < 48) ? 1 : 2;
  const u16* xbase; const u16* gbase; size_t xs, gs;
  if (seg == 0) { xbase = p->hloc + lane * 16; xs = 384; gbase = p->proj + C_GA + lane * 16; gs = DINP; }
  else if (seg == 1) { xbase = p->obuf + (lane - 24) * 16; xs = 384; gbase = p->proj + C_GB + (lane - 24) * 16; gs = DINP; }
  else { xbase = p->ycpre + (lane - 48) * 16; xs = 256; gbase = xbase; gs = 256; }
  for (int tok0 = gw; tok0 < T_TOK; tok0 += 2 * nw) {
    const int tok1 = (tok0 + nw < T_TOK) ? tok0 + nw : tok0;
    uint4 xr[2][2], gr[2][2], cr_[2][2];
    float4 cy[2][4];
#pragma unroll
    for (int t = 0; t < 2; ++t) {
      const size_t tok = (size_t)(t ? tok1 : tok0);
      xr[t][0] = *(const uint4*)(xbase + tok * xs); xr[t][1] = *(const uint4*)(xbase + tok * xs + 8);
      gr[t][0] = *(const uint4*)(gbase + tok * gs); gr[t][1] = *(const uint4*)(gbase + tok * gs + 8);
    }
    if (seg == 0) {
#pragma unroll
      for (int t = 0; t < 2; ++t) {
        const size_t tok = (size_t)(t ? tok1 : tok0);
        cr_[t][0] = *(const uint4*)(p->cum + tok * 384 + lane * 16); cr_[t][1] = *(const uint4*)(p->cum + tok * 384 + lane * 16 + 8);
        const float* cp = p->carry + (tok >> 6) * 384 + lane * 16;
#pragma unroll
        for (int i = 0; i < 4; ++i) cy[t][i] = *(const float4*)(cp + 4 * i);
      }
    }
#pragma unroll
    for (int t = 0; t < 2; ++t) {
      const size_t tok = (size_t)(t ? tok1 : tok0);
      float v[16], g[16];
      unpack8(xr[t][0], v); unpack8(xr[t][1], v + 8);
      unpack8(gr[t][0], g); unpack8(gr[t][1], g + 8);
      if (seg == 0) {
        float cm[16];
        unpack8(cr_[t][0], cm); unpack8(cr_[t][1], cm + 8);
#pragma unroll
        for (int i = 0; i < 4; ++i) {
          v[4 * i] += cm[4 * i] * cy[t][i].x; v[4 * i + 1] += cm[4 * i + 1] * cy[t][i].y;
          v[4 * i + 2] += cm[4 * i + 2] * cy[t][i].z; v[4 * i + 3] += cm[4 * i + 3] * cy[t][i].w;
        }
      }
      if (seg < 2) {
#pragma unroll
        for (int j = 0; j < 16; ++j) v[j] *= siluf_(g[j]);
      }
      float ss = 0.f;
#pragma unroll
      for (int j = 0; j < 16; ++j) ss += v[j] * v[j];
      const float sa = wave_sum(seg == 0 ? ss : 0.f);
      const float sb = wave_sum(seg == 1 ? ss : 0.f);
      const float sc = wave_sum(seg == 2 ? ss : 0.f);
      const float rs = (seg == 0) ? rsqrtf(sa * (1.f / 384.f) + EPSF)
                     : (seg == 1) ? rsqrtf(sb * (1.f / 384.f) + EPSF) : rsqrtf(sc * (1.f / 256.f) + EPSF);
      float o[16];
#pragma unroll
      for (int j = 0; j < 16; ++j) o[j] = v[j] * rs * bg[j];
      *(uint4*)(p->hbuf + tok * DM + lane * 16) = pack8(o);
      *(uint4*)(p->hbuf + tok * DM + lane * 16 + 8) = pack8(o + 8);
    }
  }
}

__device__ __forceinline__ int next_item(int* counter, int* slot) {
  __syncthreads();
  if (threadIdx.x == 0) *slot = atomicAdd(counter, 1);
  __syncthreads();
  return *slot;
}


#define XB_TMO      128
#define XB_XCNT(j)  (256  + 64 * (j))
#define XB_XSUB(j)  (1280 + 64 * (j))
#define XB_XGEN(j)  (2304 + 64 * (j))
#define XB_TOP      3328
#define XB_TOPGEN   3392
#define XCD_BAR_WORDS 3456
#define XB_SPIN_CAP (1u << 18)
#define LAS __attribute__((address_space(3)))
__device__ __forceinline__ unsigned xb_ld(unsigned* p)              { return __hip_atomic_load(p, __ATOMIC_RELAXED, __HIP_MEMORY_SCOPE_AGENT); }
__device__ __forceinline__ unsigned xb_add(unsigned* p, unsigned v) { return __hip_atomic_fetch_add(p, v, __ATOMIC_RELAXED, __HIP_MEMORY_SCOPE_AGENT); }
__device__ __forceinline__ unsigned xb_xcc_id() { return (unsigned)__builtin_amdgcn_s_getreg((3 << 11) | 20) & 0xFu; }
#define XB_SPIN(cond, bar) do { unsigned _sp = 0; while (cond) { __builtin_amdgcn_s_sleep(1); \
    if ((++_sp & 255u) == 0u) { if (xb_ld(&(bar)[XB_TMO])) break; if (_sp > XB_SPIN_CAP) { atomicAdd(&(bar)[XB_TMO], 1u); break; } } } } while (0)
struct XcdBarrier { unsigned* bar; unsigned x; volatile LAS unsigned* st; };
__device__ __forceinline__ XcdBarrier xcd_barrier_post(unsigned* bar, volatile LAS unsigned* st) {
    XcdBarrier b; b.bar = bar; b.x = xb_xcc_id(); b.st = st;
    if (threadIdx.x == 0) (void)xb_add(&bar[XB_XCNT(b.x)], 1u);
    return b;
}
__device__ __forceinline__ void xcd_barrier_complete(unsigned* bar, unsigned x, unsigned& nloc, unsigned& nx) {
    const unsigned G = gridDim.x * gridDim.y * gridDim.z;
    unsigned sum, cnt, mine, sp = 0u;
    for (;;) {
        sum = 0u; cnt = 0u; mine = 0u;
#pragma unroll
        for (unsigned j = 0; j < 16; ++j) { const unsigned c = xb_ld(&bar[XB_XCNT(j)]); sum += c; cnt += (c > 0u) ? 1u : 0u; mine = (j == x) ? c : mine; }
        if (sum == G) break;
        __builtin_amdgcn_s_sleep(1);
        if ((++sp & 255u) == 0u) { if (xb_ld(&bar[XB_TMO])) break; if (sp > XB_SPIN_CAP) { atomicAdd(&bar[XB_TMO], 1u); break; } }
    }
    nloc = mine > 0u ? mine : 1u; nx = cnt > 0u ? cnt : 1u;
}
__device__ __forceinline__ void xcd_barrier(const XcdBarrier& b) {
    asm volatile("s_waitcnt vmcnt(0)" ::: "memory");
    __syncthreads();
    if (threadIdx.x == 0) {
        unsigned* bar = b.bar;
        __builtin_amdgcn_s_waitcnt(0);
        unsigned nloc = b.st[0], nx = b.st[1];
        if (nloc == 0u) { xcd_barrier_complete(bar, b.x, nloc, nx); b.st[0] = nloc; b.st[1] = nx; }
        const unsigned old = xb_add(&bar[XB_XSUB(b.x)], 1u);
        const unsigned gen = old / nloc;
        if (old + 1u == (gen + 1u) * nloc) {
            __builtin_amdgcn_fence(__ATOMIC_RELEASE, "agent");
            asm volatile("s_waitcnt vmcnt(0)" ::: "memory");
            const unsigned og = xb_add(&bar[XB_TOP], 1u);
            const unsigned tg = og / nx;
            if (og + 1u == (tg + 1u) * nx) xb_add(&bar[XB_TOPGEN], 1u);
            else XB_SPIN(xb_ld(&bar[XB_TOPGEN]) == tg, bar);
            __builtin_amdgcn_fence(__ATOMIC_ACQUIRE, "agent");
            xb_add(&bar[XB_XGEN(b.x)], 1u);
            asm volatile("s_waitcnt vmcnt(0)" ::: "memory");
        } else {
            XB_SPIN(xb_ld(&bar[XB_XGEN(b.x)]) == gen, bar);
            __builtin_amdgcn_fence(__ATOMIC_ACQUIRE, "agent");
            asm volatile("s_waitcnt vmcnt(0)" ::: "memory");
        }
    }
    __syncthreads();
}

#define N_PHASES (1 + 6 * NLAYER + 1)

__device__ void run_phase(PP p, int ph, u16* lds, float* ssm, int* slot, int rep) {
  int l = (ph - 1) / 6, sub = (ph - 1) % 6 + 1;
  if (ph == 0) { sub = 0; l = 0; }
  if (ph == N_PHASES - 1) { sub = 1; l = NLAYER; }
#ifdef ONLYSUB
  sub = ONLYSUB;
#endif
  const int bid = blockIdx.x, nb = gridDim.x;
  if (sub == 0) { phase_prep(p, (float*)lds); return; }
  if (sub == 1) { phase_norm(p, l); return; }
  if (sub == 2) {
    gemm_phase(p->wInT + (size_t)l * DINP * DM, DM, p->hbuf, DM, DM, p->proj, DINP, 18, 256 * 18, lds);
    return;
  }
  if (sub == 3) {
    int* ctr = p->counters + l * 16 + rep * 64;
    for (;;) {
      int it = next_item(ctr, slot);
      if (it >= 256 + 512 + 512 + 3072) break;
      if (it < 256) item_sgu(p, l, it, lds, ssm);
      else if (it < 256 + 512) {
        const int k = it - 256; const int rt = k >> 1, hp = (k & 1) * 3;
#pragma unroll 1
        for (int h2 = 0; h2 < 3; ++h2) item_q(p, l, rt, hp + h2, lds, ssm, h2 == 0);
      } else if (it < 256 + 1024) {
        const int k = it - 256 - 512; const int rt = k >> 1, hp = (k & 1) * 3;
#pragma unroll 1
        for (int h2 = 0; h2 < 3; ++h2) item_kv(p, l, rt, hp + h2, lds, ssm, h2 == 0);
      } else { const int k = it - 256 - 1024; item_lru(p, l, k / 6, k % 6, lds, ssm); }
    }
    return;
  }
  if (sub == 4) {
    if (bid < 6) item_carry(p, bid);
    const int xq = (int)(xb_xcc_id() & 7u);
    int* cbase = p->counters + l * 16 + 8 + rep * 64;
    for (;;) {
      __syncthreads();
      if (threadIdx.x == 0) {
        int got = -1;
        for (int dq = 0; dq < 8 && got < 0; ++dq) {
          const int q = (xq + dq) & 7;
          if (__hip_atomic_load(cbase + q, __ATOMIC_RELAXED, __HIP_MEMORY_SCOPE_AGENT) < 192) {
            const int it = atomicAdd(cbase + q, 1);
            if (it < 192) got = q * 256 + it;
          }
        }
        *slot = got;
      }
      __syncthreads();
      const int got = *slot;
      if (got < 0) break;
      const int q = got >> 8, it = got & 255;
      int qb, bh;
      if (it < 64) { qb = 63 - it; bh = q * 3; }
      else { const int j = it - 64; qb = 63 - (j >> 1); bh = q * 3 + 1 + (j & 1); }
      item_attn(p, qb, bh / 6, bh % 6, lds);
    }
    return;
  }
  if (sub == 5) { phase_y(p, l); return; }
  gemm_phase(p->wOutT + (size_t)l * DM * DM, DM, p->hbuf, DM, DM, p->y2, DM, 8, 256 * 8, lds);
}

__global__ void __launch_bounds__(256, 2) mega_kernel(Params p, int ph_begin, int ph_end) {
  __shared__ __attribute__((aligned(16))) unsigned char lds_raw[LDS_BYTES];
  __shared__ float ssm[512];
  __shared__ int slot;
  u16* lds = (u16*)lds_raw;
  PP pp = (PP)__builtin_amdgcn_kernarg_segment_ptr();
#if COOP
  cg::grid_group grid = cg::this_grid();
  __shared__ uint4 xb_words;
  if (threadIdx.x == 0) xb_words = make_uint4(0u, 0u, 0u, 0u);
  __syncthreads();
  XcdBarrier xb = xcd_barrier_post(pp->bar, (volatile LAS unsigned*)&xb_words);
#endif
  int rep = 0;
  for (int ph = ph_begin; ph < ph_end;) {
    run_phase(launder(pp), ph, lds, ssm, &slot, rep);
    bool again = false;
#if COOP
#ifdef REPEAT_SUB
    if (ph > 0 && ph < N_PHASES - 1) {
      if (REPEAT_SUB == 99) { xcd_barrier(xb); xcd_barrier(xb); xcd_barrier(xb); xcd_barrier(xb); }
      else if (((ph - 1) % 6 + 1) == REPEAT_SUB && rep == 0) again = true;
    }
#endif
    if (again || ph + 1 < ph_end) {
      if (ph_end > 1000) grid.sync();
      xcd_barrier(xb);
    }
#endif
    if (again) rep = 1; else { rep = 0; ++ph; }
  }
}

extern "C" void kernel_launch(void* const* d_in, const int* in_sizes, int n_in, void* d_out, int out_size, void* d_ws,
                              size_t ws_size, hipStream_t stream) {
  Params p{};
  p.x = (const float*)d_in[0]; p.pos = (const int*)d_in[1]; p.pre_g = (const float*)d_in[2]; p.w_in = (const float*)d_in[3];
  p.conv_w = (const float*)d_in[4]; p.conv_b = (const float*)d_in[5]; p.lru_wa = (const float*)d_in[6]; p.lru_ba = (const float*)d_in[7];
  p.lru_wx = (const float*)d_in[8]; p.lru_bx = (const float*)d_in[9]; p.lru_lam = (const float*)d_in[10]; p.q_g = (const float*)d_in[11];
  p.w_uq = (const float*)d_in[12]; p.kv_g = (const float*)d_in[13]; p.w_ukv = (const float*)d_in[14]; p.sgu_g = (const float*)d_in[15];
  p.sgu_bn = (const float*)d_in[16]; p.sgu_w = (const float*)d_in[17]; p.sgu_b = (const float*)d_in[18]; p.br_g = (const float*)d_in[19];
  p.w_out = (const float*)d_in[20]; p.post_g = (const float*)d_in[21];
  p.out = (float*)d_out;
  unsigned char* ws = (unsigned char*)d_ws;
  size_t off = 0;
  auto take = [&](size_t bytes) { unsigned char* q = ws + off; off += (bytes + 255) & ~(size_t)255; return q; };
  p.counters = (int*)take(1024);
  p.bar = (unsigned*)take(XCD_BAR_WORDS * 4);
  p.wInT = (u16*)take((size_t)NLAYER * DINP * DM * 2);
  p.wOutT = (u16*)take((size_t)NLAYER * DM * DM * 2);
  p.wUqT = (u16*)take((size_t)NLAYER * 768 * 192 * 2);
  p.wUkvT = (u16*)take((size_t)NLAYER * 768 * 128 * 2);
  p.waT = (u16*)take((size_t)NLAYER * 6 * 4096 * 2);
  p.wxT = (u16*)take((size_t)NLAYER * 6 * 4096 * 2);
  p.sguW = (u16*)take((size_t)NLAYER * 4 * 128 * 128 * 2);
  p.tab = (float2*)take((size_t)T_TOK * 16 * 8);
  p.hbuf = (u16*)take((size_t)T_TOK * DM * 2);
  p.proj = (u16*)take((size_t)T_TOK * DINP * 2);
  p.y2 = (u16*)take((size_t)T_TOK * DM * 2);
  p.Q = (u16*)take((size_t)T_TOK * 576 * 2);
  p.K = (u16*)take((size_t)T_TOK * 576 * 2);
  p.VT = (u16*)take((size_t)T_TOK * 384 * 2);
  p.hloc = (u16*)take((size_t)T_TOK * 384 * 2);
  p.cum = (u16*)take((size_t)T_TOK * 384 * 2);
  p.Ptile = (float*)take((size_t)512 * 384 * 4);
  p.Htile = (float*)take((size_t)512 * 384 * 4);
  p.carry = (float*)take((size_t)512 * 384 * 4);
  p.obuf = (u16*)take((size_t)T_TOK * 384 * 2);
  p.ycpre = (u16*)take((size_t)T_TOK * 256 * 2);
  if (off > ws_size) { fprintf(stderr, "workspace too small: need %zu have %zu\n", off, ws_size); return; }

  static int grid_blocks = 0;
  if (!grid_blocks) {
    int dev = 0, cus = 0, per_cu = 0;
    hipGetDevice(&dev);
    hipDeviceGetAttribute(&cus, hipDeviceAttributeMultiprocessorCount, dev);
    hipOccupancyMaxActiveBlocksPerMultiprocessor(&per_cu, mega_kernel, 256, 0);
    if (per_cu > 2) per_cu = 2;
    if (per_cu < 1) per_cu = 1;
    grid_blocks = cus * per_cu;
  }
#if COOP
  (void)hipMemsetAsync(d_ws, 0, 1024 + ((XCD_BAR_WORDS * 4 + 255) & ~255), stream);
  int pb = 0, pe = N_PHASES;
  void* args[] = {&p, &pb, &pe};
  hipError_t e = hipLaunchCooperativeKernel((void*)mega_kernel, dim3(grid_blocks), dim3(256), args, 0, stream);
  if (e != hipSuccess) fprintf(stderr, "cooperative launch failed: %s (grid %d)\n", hipGetErrorString(e), grid_blocks);
#else
  for (int ph = 0; ph < N_PHASES; ++ph) mega_kernel<<<grid_blocks, 256, 0, stream>>>(p, ph, ph + 1);
#endif
}
```

```cpp
#include <hip/hip_runtime.h>
#include <hip/hip_cooperative_groups.h>
#include <stdint.h>
#include <stdio.h>
namespace cg = cooperative_groups;

typedef unsigned short u16;
typedef __attribute__((ext_vector_type(8))) short bf16x8;
typedef __attribute__((ext_vector_type(16))) float f32x16;
typedef __attribute__((ext_vector_type(4))) unsigned u32x4;
typedef __attribute__((ext_vector_type(2))) unsigned u32x2;

#ifndef COOP
#define COOP 1
#endif

#define T_TOK 32768
#define SEQ 8192
#define DM 1024
#define DIN 2272
#define DINP 2304
#define NLAYER 4
#define EPSF 1e-6f
#define C_XA 0
#define C_GA 384
#define C_QL 768
#define C_KVL 960
#define C_KR 1088
#define C_GB 1120
#define C_U 1504
#define C_V 1760
#define C_GC 2016

#define LDT 72
#define TILE_U16 (128 * LDT)
#define LDS_BYTES 73728

struct Params {
  const float* x; const int* pos; const float* pre_g; const float* w_in; const float* conv_w; const float* conv_b;
  const float* lru_wa; const float* lru_ba; const float* lru_wx; const float* lru_bx; const float* lru_lam;
  const float* q_g; const float* w_uq; const float* kv_g; const float* w_ukv; const float* sgu_g; const float* sgu_bn;
  const float* sgu_w; const float* sgu_b; const float* br_g; const float* w_out; const float* post_g;
  float* out;
  u16* wInT; u16* wOutT; u16* wUqT; u16* wUkvT; u16* waT; u16* wxT; u16* sguW;
  float2* tab; int* counters; unsigned* bar;
  u16* hbuf;
  u16* proj;
  u16* y2;
  u16* Q; u16* K; u16* VT;
  u16* hloc; u16* cum; float* Ptile; float* Htile; float* carry;
  u16* obuf; u16* ycpre;
};

__device__ const double c_invfreq_rev[16] = {1.59154943091895345608e-01, 8.94994016088910132600e-02, 5.03292121044870352509e-02, 2.83021958306233986646e-02, 1.59154943091895338669e-02, 8.94994016088910236684e-03, 5.03292121044870369856e-03, 2.83021958306233986646e-03, 1.59154943091895356017e-03, 8.94994016088910236684e-04, 5.03292121044870326488e-04, 2.83021958306233954120e-04, 1.59154943091895350596e-04, 8.94994016088910182474e-05, 5.03292121044870353593e-05, 2.83021958306233960897e-05};
typedef const __attribute__((address_space(4))) Params* PP;
__device__ __forceinline__ PP launder(PP q) { asm volatile("" : "+s"(q)); return q; }
__device__ __forceinline__ float bf2f(u16 b) { return __uint_as_float(((unsigned)b) << 16); }
typedef __attribute__((ext_vector_type(2))) __bf16 bf16x2_t;
__device__ __forceinline__ u16 f2bf(float f) { return __builtin_bit_cast(u16, (__bf16)f); }
__device__ __forceinline__ unsigned pack2(float a, float b) { bf16x2_t v = {(__bf16)a, (__bf16)b}; return __builtin_bit_cast(unsigned, v); }
__device__ __forceinline__ float lo16(unsigned u) { return __uint_as_float(u << 16); }
__device__ __forceinline__ float hi16(unsigned u) { return __uint_as_float(u & 0xffff0000u); }
__device__ __forceinline__ void unpack8(uint4 a, float* v) {
  v[0] = lo16(a.x); v[1] = hi16(a.x); v[2] = lo16(a.y); v[3] = hi16(a.y);
  v[4] = lo16(a.z); v[5] = hi16(a.z); v[6] = lo16(a.w); v[7] = hi16(a.w);
}
__device__ __forceinline__ uint4 pack8(const float* v) {
  uint4 a; a.x = pack2(v[0], v[1]); a.y = pack2(v[2], v[3]); a.z = pack2(v[4], v[5]); a.w = pack2(v[6], v[7]); return a;
}
__device__ __forceinline__ float sigmoidf_(float x) { return __builtin_amdgcn_rcpf(1.f + __expf(-x)); }
__device__ __forceinline__ float siluf_(float x) { return x * __builtin_amdgcn_rcpf(1.f + __expf(-x)); }
__device__ __forceinline__ float geluf_(float x) {
  float u = 1.5957691216057308f * (x + 0.044715f * x * x * x);
  return x * __builtin_amdgcn_rcpf(1.f + __expf(-u));
}
__device__ __forceinline__ float wave_sum(float v) {
#pragma unroll
  for (int o = 32; o >= 1; o >>= 1) v += __shfl_xor(v, o);
  return v;
}
__device__ __forceinline__ int opaque_tid() { int t = threadIdx.x; asm volatile("" : "+v"(t)); return t; }
__device__ __forceinline__ f32x16 mfma32(bf16x8 a, bf16x8 b, f32x16 c) {
  return __builtin_amdgcn_mfma_f32_32x32x16_bf16(a, b, c, 0, 0, 0);
}

struct GStage { u32x4 w0, w1, w2, w3, x0, x1, x2, x3; };
__device__ __forceinline__ void gs_load(GStage& g, const u16* gw, int ldw, const u16* gx, int ldx, int k0) {
  g.w0 = *(const u32x4*)(gw + k0);
  g.w1 = *(const u32x4*)(gw + (size_t)32 * ldw + k0);
  g.w2 = *(const u32x4*)(gw + (size_t)64 * ldw + k0);
  g.w3 = *(const u32x4*)(gw + (size_t)96 * ldw + k0);
  g.x0 = *(const u32x4*)(gx + k0);
  g.x1 = *(const u32x4*)(gx + (size_t)32 * ldx + k0);
  g.x2 = *(const u32x4*)(gx + (size_t)64 * ldx + k0);
  g.x3 = *(const u32x4*)(gx + (size_t)96 * ldx + k0);
}
__device__ __forceinline__ void gs_store(const GStage& g, u16* db, int lo) {
  *(u32x4*)(db + lo) = g.w0;
  *(u32x4*)(db + lo + 32 * LDT) = g.w1;
  *(u32x4*)(db + lo + 64 * LDT) = g.w2;
  *(u32x4*)(db + lo + 96 * LDT) = g.w3;
  *(u32x4*)(db + TILE_U16 + lo) = g.x0;
  *(u32x4*)(db + TILE_U16 + lo + 32 * LDT) = g.x1;
  *(u32x4*)(db + TILE_U16 + lo + 64 * LDT) = g.x2;
  *(u32x4*)(db + TILE_U16 + lo + 96 * LDT) = g.x3;
}
__device__ __forceinline__ void gemm_kstep(const u16* sb, int wn, int wt, int r, int h, f32x16 (&acc)[2][2]) {
  const u16* bw = sb + (wn * 64 + r) * LDT + h * 8;
  const u16* bx = sb + TILE_U16 + (wt * 64 + r) * LDT + h * 8;
  __builtin_amdgcn_s_setprio(1);
#pragma unroll
  for (int ks = 0; ks < 4; ++ks) {
    bf16x8 a0 = *(const bf16x8*)(bw + ks * 16);
    bf16x8 a1 = *(const bf16x8*)(bw + 32 * LDT + ks * 16);
    bf16x8 b0 = *(const bf16x8*)(bx + ks * 16);
    bf16x8 b1 = *(const bf16x8*)(bx + 32 * LDT + ks * 16);
    acc[0][0] = mfma32(a0, b0, acc[0][0]);
    acc[0][1] = mfma32(a0, b1, acc[0][1]);
    acc[1][0] = mfma32(a1, b0, acc[1][0]);
    acc[1][1] = mfma32(a1, b1, acc[1][1]);
  }
  __builtin_amdgcn_s_setprio(0);
}
__device__ __forceinline__ void gemm_tile(const u16* __restrict__ W, int ldw, const u16* __restrict__ X, int ldx,
                                          int K, u16* lds, f32x16 (&acc)[2][2]) {
  const int tid = opaque_tid(), lane = tid & 63, w = tid >> 6, r = lane & 31, h = lane >> 5;
  const int wn = w >> 1, wt = w & 1;
#pragma unroll
  for (int a = 0; a < 2; ++a)
#pragma unroll
    for (int b = 0; b < 2; ++b)
#pragma unroll
      for (int i = 0; i < 16; ++i) acc[a][b][i] = 0.f;
  const int lrow = tid >> 3, lc = tid & 7;
  const u16* gw = W + (size_t)lrow * ldw + lc * 8;
  const u16* gx = X + (size_t)lrow * ldx + lc * 8;
  const int lo = lrow * LDT + lc * 8;
  const int nk = K >> 6;
  GStage A, B;
  gs_load(B, gw, ldw, gx, ldx, 0);
  if (nk > 1) gs_load(A, gw, ldw, gx, ldx, 64);
  gs_store(B, lds, lo);
  __syncthreads();
  for (int kt = 0; kt < nk; kt += 2) {
    if (kt + 2 < nk) gs_load(B, gw, ldw, gx, ldx, (kt + 2) * 64);
    gemm_kstep(lds, wn, wt, r, h, acc);
    if (kt + 1 < nk) gs_store(A, lds + 2 * TILE_U16, lo);
    __syncthreads();
    if (kt + 1 < nk) {
      if (kt + 3 < nk) gs_load(A, gw, ldw, gx, ldx, (kt + 3) * 64);
      gemm_kstep(lds + 2 * TILE_U16, wn, wt, r, h, acc);
      if (kt + 2 < nk) gs_store(B, lds, lo);
      __syncthreads();
    }
  }
}

__device__ __forceinline__ void stage_f32(float* st, f32x16 (&acc)[2][2]) {
  const int tid = opaque_tid(), lane = tid & 63, w = tid >> 6, r = lane & 31, h = lane >> 5;
  const int wn = w >> 1, wt = w & 1;
#pragma unroll
  for (int nb = 0; nb < 2; ++nb)
#pragma unroll
    for (int tb = 0; tb < 2; ++tb) {
      const int token = wt * 64 + tb * 32 + r;
#pragma unroll
      for (int g = 0; g < 4; ++g) {
        const int n0 = wn * 64 + nb * 32 + 8 * g + 4 * h;
        float4 v = make_float4(acc[nb][tb][4 * g], acc[nb][tb][4 * g + 1], acc[nb][tb][4 * g + 2], acc[nb][tb][4 * g + 3]);
        *(float4*)(st + token * 132 + n0) = v;
      }
    }
}
__device__ __forceinline__ void stage_bf16(u16* st, f32x16 (&acc)[2][2]) {
  const int tid = opaque_tid(), lane = tid & 63, w = tid >> 6, r = lane & 31, h = lane >> 5;
  const int wn = w >> 1, wt = w & 1;
#pragma unroll
  for (int nb = 0; nb < 2; ++nb)
#pragma unroll
    for (int tb = 0; tb < 2; ++tb) {
      const int token = wt * 64 + tb * 32 + r;
#pragma unroll
      for (int g = 0; g < 4; ++g) {
        const int n0 = wn * 64 + nb * 32 + 8 * g + 4 * h;
        uint2 v;
        v.x = pack2(acc[nb][tb][4 * g], acc[nb][tb][4 * g + 1]);
        v.y = pack2(acc[nb][tb][4 * g + 2], acc[nb][tb][4 * g + 3]);
        *(uint2*)(st + token * 136 + n0) = v;
      }
    }
}

__device__ void gemm_store_tile(const u16* W, int ldw, const u16* X, int ldx, int K, u16* out, int ldo, u16* lds) {
  f32x16 acc[2][2];
  gemm_tile(W, ldw, X, ldx, K, lds, acc);
  stage_bf16(lds, acc);
  __syncthreads();
  const int tid = opaque_tid();
#pragma unroll
  for (int i = 0; i < 8; ++i) {
    const int id = tid + 256 * i;
    const int row = id >> 4, c = id & 15;
    uint4 v = *(const uint4*)(lds + row * 136 + c * 8);
    *(uint4*)(out + (size_t)row * ldo + c * 8) = v;
  }
  __syncthreads();
}

__device__ void gemm_phase(const u16* __restrict__ Wb, int ldw, const u16* __restrict__ Xb, int ldx, int K,
                           u16* __restrict__ outb, int ldo, int ntn, int ntiles, u16* lds) {
  const int tid = opaque_tid(), lane = tid & 63, w = tid >> 6, r = lane & 31, h = lane >> 5;
  const int wn = w >> 1, wt = w & 1;
  const int lrow = tid >> 3, lc = tid & 7;
  const int lo = lrow * LDT + lc * 8;
  const int nk = K >> 6;
  const int nbl = gridDim.x >> 3;
  const int xl = blockIdx.x & 7, jl = blockIdx.x >> 3;
  const int mt_per = (ntiles / ntn) >> 3;
  const int L = mt_per * ntn;
  int q = jl;
  if (q >= L) return;
#define GP_MT(qq) (xl * mt_per + ((qq) / (8 * ntn)) * 8 + ((qq) % (8 * ntn)) % 8)
#define GP_NT(qq) (((qq) % (8 * ntn)) / 8)
  const u16* gw = Wb + (size_t)(GP_NT(q) * 128 + lrow) * ldw + lc * 8;
  const u16* gx = Xb + (size_t)(GP_MT(q) * 128 + lrow) * ldx + lc * 8;
  GStage A, B;
  gs_load(B, gw, ldw, gx, ldx, 0);
  gs_load(A, gw, ldw, gx, ldx, 64);
  for (; q < L; q += nbl) {
    const int qn = q + nbl;
    const bool has_next = qn < L;
    const int qq = has_next ? qn : q;
    const u16* gwn = Wb + (size_t)(GP_NT(qq) * 128 + lrow) * ldw + lc * 8;
    const u16* gxn = Xb + (size_t)(GP_MT(qq) * 128 + lrow) * ldx + lc * 8;
    f32x16 acc[2][2];
#pragma unroll
    for (int a = 0; a < 2; ++a)
#pragma unroll
      for (int b = 0; b < 2; ++b)
#pragma unroll
        for (int i = 0; i < 16; ++i) acc[a][b][i] = 0.f;
    gs_store(B, lds, lo);
    __syncthreads();
    for (int kt = 0; kt < nk; kt += 2) {
      if (kt + 2 < nk) gs_load(B, gw, ldw, gx, ldx, (kt + 2) * 64);
      else if (has_next) gs_load(B, gwn, ldw, gxn, ldx, 0);
      gemm_kstep(lds, wn, wt, r, h, acc);
      gs_store(A, lds + 2 * TILE_U16, lo);
      __syncthreads();
      if (kt + 3 < nk) gs_load(A, gw, ldw, gx, ldx, (kt + 3) * 64);
      else if (has_next) gs_load(A, gwn, ldw, gxn, ldx, 64);
      gemm_kstep(lds + 2 * TILE_U16, wn, wt, r, h, acc);
      if (kt + 2 < nk) gs_store(B, lds, lo);
      __syncthreads();
    }
    stage_bf16(lds, acc);
    __syncthreads();
    u16* out = outb + (size_t)GP_MT(q) * 128 * ldo + GP_NT(q) * 128;
#pragma unroll
    for (int i = 0; i < 8; ++i) {
      const int id = tid + 256 * i;
      const int row = id >> 4, c = id & 15;
      uint4 v = *(const uint4*)(lds + row * 136 + c * 8);
      *(uint4*)(out + (size_t)row * ldo + c * 8) = v;
    }
    __syncthreads();
    gw = gwn; gx = gxn;
  }
#undef GP_MT
#undef GP_NT
}

__device__ void prep_transpose(const float* __restrict__ src, size_t sstride, int nmat, int R, int C, u16* __restrict__ dst,
                               size_t dstride, int dld, const float* __restrict__ gk, int mode, float* tile, int bid, int nb) {
  const int tid = opaque_tid();
  const int tr = R >> 6, tc = (C + 63) >> 6;
  const int per = tr * tc;
  for (int t = bid; t < per * nmat; t += nb) {
    const int m = t / per, tt = t % per;
    const int r0 = (tt / tc) * 64, c0 = (tt % tc) * 64;
    const float* sm = src + (size_t)m * sstride;
    u16* dm = dst + (size_t)m * dstride;
    __syncthreads();
#pragma unroll
    for (int i = 0; i < 16; ++i) {
      const int rr = i * 4 + (tid >> 6), cc = tid & 63;
      float v = 0.f;
      if (c0 + cc < C) {
        v = sm[(size_t)(r0 + rr) * C + c0 + cc];
        if (gk) v *= gk[m * R + r0 + rr];
      }
      tile[rr * 65 + cc] = v;
    }
    __syncthreads();
#pragma unroll
    for (int i = 0; i < 16; ++i) {
      const int cc = i * 4 + (tid >> 6), rr = tid & 63;
      const int c = c0 + cc;
      if (c < C) {
        const int n = (mode == 1) ? (c / 96) * 128 + (c % 96) : c;
        dm[(size_t)n * dld + r0 + rr] = f2bf(tile[rr * 65 + cc]);
      }
    }
  }
}
__device__ void phase_prep(PP p, float* ldsf) {
  p = launder(p);
  const int bid = blockIdx.x, nb = gridDim.x, tid = opaque_tid();
  const int gtid = bid * 256 + tid, gn = nb * 256;
  if (bid == 0) p->counters[tid] = 0;
  prep_transpose(p->w_in, (size_t)DM * DIN, NLAYER, DM, DIN, p->wInT, (size_t)DINP * DM, DM, nullptr, 0, ldsf, bid, nb);
  prep_transpose(p->w_out, (size_t)DM * DM, NLAYER, DM, DM, p->wOutT, (size_t)DM * DM, DM, nullptr, 0, ldsf, (bid + 256) % nb, nb);
  prep_transpose(p->w_uq, (size_t)192 * 576, NLAYER, 192, 576, p->wUqT, (size_t)768 * 192, 192, p->q_g, 1, ldsf, (bid + 128) % nb, nb);
  prep_transpose(p->w_ukv, (size_t)128 * 768, NLAYER, 128, 768, p->wUkvT, (size_t)768 * 128, 128, p->kv_g, 0, ldsf, (bid + 384) % nb, nb);
  prep_transpose(p->lru_wa, 4096, NLAYER * 6, 64, 64, p->waT, 4096, 64, nullptr, 0, ldsf, (bid + 64) % nb, nb);
  prep_transpose(p->lru_wx, 4096, NLAYER * 6, 64, 64, p->wxT, 4096, 64, nullptr, 0, ldsf, (bid + 192) % nb, nb);
  for (int i = gtid; i < NLAYER * 32 * DM; i += gn) {
    const int l = i / (32 * DM), rem = i % (32 * DM);
    p->wInT[(size_t)l * DINP * DM + (size_t)DIN * DM + rem] = 0;
  }
  for (int i = gtid; i < NLAYER * 6 * 32 * 192; i += gn) {
    const int l = i / (6 * 32 * 192), rem = i % (6 * 32 * 192);
    const int hd = rem / (32 * 192), rem2 = rem % (32 * 192);
    p->wUqT[(size_t)l * 768 * 192 + (size_t)(hd * 128 + 96) * 192 + rem2] = 0;
  }
  for (int i = gtid; i < NLAYER * 4 * 128 * 128; i += gn) {
    const int ii = (i >> 7) & 127, jj = i & 127;
    const float v = (ii >= 64 || jj < 64) ? p->sgu_w[i] : 0.f;
    p->sguW[i] = f2bf(v);
  }
  for (int i = gtid; i < T_TOK * 16; i += gn) {
    const int t = i >> 4, k = i & 15;
    const double rev = (double)p->pos[t] * c_invfreq_rev[k];
    const double fr = rev - __builtin_rint(rev);
    const float f = (float)fr;
    p->tab[i] = make_float2(__builtin_amdgcn_cosf(f), __builtin_amdgcn_sinf(f));
  }
}

typedef __attribute__((ext_vector_type(4))) float f32x4;
__device__ void phase_norm(PP p, int l) {
  p = launder(p);
  const int tid_ = opaque_tid();
  const int lane = tid_ & 63;
  const int gw = blockIdx.x * 4 + (tid_ >> 6), nw = gridDim.x * 4;
  const float* xin = (l <= 1) ? p->x : p->out;
  const float* gpost = p->post_g + (l > 0 ? l - 1 : 0) * DM;
  const float* gpre = p->pre_g + (l < NLAYER ? l : 0) * DM;
  constexpr int NTK = 4;
  for (int tok0 = gw; tok0 < T_TOK; tok0 += NTK * nw) {
    f32x4 xv[NTK][4];
    u32x2 yu[NTK][4];
#pragma unroll
    for (int t = 0; t < NTK; ++t) {
      const int tok = (tok0 + t * nw < T_TOK) ? tok0 + t * nw : tok0;
#pragma unroll
      for (int i = 0; i < 4; ++i) xv[t][i] = __builtin_nontemporal_load((const f32x4*)(xin + (size_t)tok * DM + i * 256 + lane * 4));
    }
    if (l > 0) {
#pragma unroll
      for (int t = 0; t < NTK; ++t) {
        const int tok = (tok0 + t * nw < T_TOK) ? tok0 + t * nw : tok0;
#pragma unroll
        for (int i = 0; i < 4; ++i) yu[t][i] = __builtin_nontemporal_load((const u32x2*)(p->y2 + (size_t)tok * DM + i * 256 + lane * 4));
      }
    }
#pragma unroll
    for (int t = 0; t < NTK; ++t) {
      const int tok = (tok0 + t * nw < T_TOK) ? tok0 + t * nw : tok0;
      if (l > 0) {
        float yv[16];
        float ss = 0.f;
#pragma unroll
        for (int i = 0; i < 4; ++i) {
          yv[4 * i] = lo16(yu[t][i].x); yv[4 * i + 1] = hi16(yu[t][i].x); yv[4 * i + 2] = lo16(yu[t][i].y); yv[4 * i + 3] = hi16(yu[t][i].y);
          ss += yv[4 * i] * yv[4 * i] + yv[4 * i + 1] * yv[4 * i + 1] + yv[4 * i + 2] * yv[4 * i + 2] + yv[4 * i + 3] * yv[4 * i + 3];
        }
        ss = wave_sum(ss);
        const float rs = rsqrtf(ss * (1.f / 1024.f) + EPSF);
#pragma unroll
        for (int i = 0; i < 4; ++i) {
          float4 gv = *(const float4*)(gpost + i * 256 + lane * 4);
          xv[t][i].x += yv[4 * i] * rs * gv.x; xv[t][i].y += yv[4 * i + 1] * rs * gv.y;
          xv[t][i].z += yv[4 * i + 2] * rs * gv.z; xv[t][i].w += yv[4 * i + 3] * rs * gv.w;
        }
      }
      if (l > 0) {
#pragma unroll
        for (int i = 0; i < 4; ++i) __builtin_nontemporal_store(xv[t][i], (f32x4*)(p->out + (size_t)tok * DM + i * 256 + lane * 4));
      }
      if (l < NLAYER) {
        float ss = 0.f;
#pragma unroll
        for (int i = 0; i < 4; ++i) ss += xv[t][i].x * xv[t][i].x + xv[t][i].y * xv[t][i].y + xv[t][i].z * xv[t][i].z + xv[t][i].w * xv[t][i].w;
        ss = wave_sum(ss);
        const float rs = rsqrtf(ss * (1.f / 1024.f) + EPSF);
#pragma unroll
        for (int i = 0; i < 4; ++i) {
          float4 gv = *(const float4*)(gpre + i * 256 + lane * 4);
          uint2 u;
          u.x = pack2(xv[t][i].x * rs * gv.x, xv[t][i].y * rs * gv.y);
          u.y = pack2(xv[t][i].z * rs * gv.z, xv[t][i].w * rs * gv.w);
          *(uint2*)(p->hbuf + (size_t)tok * DM + i * 256 + lane * 4) = u;
        }
      }
    }
  }
}

__device__ void item_q(PP p, int l, int rt, int hd, u16* lds, float* ssm) {
  p = launder(p);
  const int tid = opaque_tid();
  const int m0 = rt * 128;
  {
    const int row = tid >> 1, half = tid & 1;
    const u16* src = p->proj + (size_t)(m0 + row) * DINP + C_QL + half * 96;
    float ss = 0.f;
#pragma unroll
    for (int i = 0; i < 12; ++i) {
      float v[8]; unpack8(*(const uint4*)(src + i * 8), v);
#pragma unroll
      for (int j = 0; j < 8; ++j) ss += v[j] * v[j];
    }
    ss += __shfl_xor(ss, 1);
    if (half == 0) ssm[row] = rsqrtf(ss * (1.f / 192.f) + EPSF);
  }
  f32x16 acc[2][2];
  gemm_tile(p->wUqT + (size_t)l * 768 * 192 + (size_t)hd * 128 * 192, 192, p->proj + (size_t)m0 * DINP + C_QL, DINP, 192, lds, acc);
  float* st = (float*)lds;
  stage_f32(st, acc);
  __syncthreads();
  const float qscale = 0.10206207261596577f * 1.4426950408889634f;
#pragma unroll
  for (int i = 0; i < 6; ++i) {
    const int u = tid + 256 * i;
    const int row = u / 12, dg = u % 12;
    const float sc = ssm[row] * qscale;
    const float* sr = st + row * 132;
    float o[8];
    if (dg < 8) {
      const float4 a = *(const float4*)(sr + dg * 8), bq = *(const float4*)(sr + dg * 8 + 4);
      o[0] = a.x * sc; o[1] = a.y * sc; o[2] = a.z * sc; o[3] = a.w * sc;
      o[4] = bq.x * sc; o[5] = bq.y * sc; o[6] = bq.z * sc; o[7] = bq.w * sc;
    } else {
      const int i0 = (dg & 1) * 8;
      const float2* tb = p->tab + (size_t)(m0 + row) * 16 + i0;
      const float4 a0 = *(const float4*)(sr + 64 + i0), a1 = *(const float4*)(sr + 68 + i0);
      const float4 b0 = *(const float4*)(sr + 80 + i0), b1 = *(const float4*)(sr + 84 + i0);
      const float x1[8] = {a0.x, a0.y, a0.z, a0.w, a1.x, a1.y, a1.z, a1.w};
      const float x2[8] = {b0.x, b0.y, b0.z, b0.w, b1.x, b1.y, b1.z, b1.w};
      const float4 t0 = *(const float4*)(tb), t1 = *(const float4*)(tb + 2), t2 = *(const float4*)(tb + 4), t3 = *(const float4*)(tb + 6);
      const float cc[8] = {t0.x, t0.z, t1.x, t1.z, t2.x, t2.z, t3.x, t3.z};
      const float sn[8] = {t0.y, t0.w, t1.y, t1.w, t2.y, t2.w, t3.y, t3.w};
      if (dg < 10) {
#pragma unroll
        for (int j = 0; j < 8; ++j) o[j] = (x1[j] * cc[j] - x2[j] * sn[j]) * sc;
      } else {
#pragma unroll
        for (int j = 0; j < 8; ++j) o[j] = (x2[j] * cc[j] + x1[j] * sn[j]) * sc;
      }
    }
    *(uint4*)(p->Q + ((size_t)(m0 + row) * 6 + hd) * 96 + dg * 8) = pack8(o);
  }
  __syncthreads();
}

__device__ void item_kv(PP p, int l, int rt, int hd, u16* lds, float* ssm) {
  p = launder(p);
  const int tid = opaque_tid();
  const int m0 = rt * 128;
  {
    const int row = tid >> 1, half = tid & 1;
    const u16* src = p->proj + (size_t)(m0 + row) * DINP + C_KVL + half * 64;
    float ss = 0.f;
#pragma unroll
    for (int i = 0; i < 8; ++i) {
      float v[8]; unpack8(*(const uint4*)(src + i * 8), v);
#pragma unroll
      for (int j = 0; j < 8; ++j) ss += v[j] * v[j];
    }
    ss += __shfl_xor(ss, 1);
    if (half == 0) ssm[row] = rsqrtf(ss * (1.f / 128.f) + EPSF);
  }
  f32x16 acc[2][2];
  gemm_tile(p->wUkvT + (size_t)l * 768 * 128 + (size_t)hd * 128 * 128, 128, p->proj + (size_t)m0 * DINP + C_KVL, DINP, 128, lds, acc);
  float* st = (float*)lds;
  stage_f32(st, acc);
  __syncthreads();
  const int kb_ = m0 / SEQ, ks0_ = m0 % SEQ;
#pragma unroll
  for (int i = 0; i < 4; ++i) {
    const int u = tid + 256 * i;
    const int row = u >> 3, dg = u & 7;
    const float sc = ssm[row];
    const float* sr = st + row * 132 + dg * 8;
    float o[8];
    {
      const float4 a = *(const float4*)(sr), bq = *(const float4*)(sr + 4);
      o[0] = a.x * sc; o[1] = a.y * sc; o[2] = a.z * sc; o[3] = a.w * sc;
      o[4] = bq.x * sc; o[5] = bq.y * sc; o[6] = bq.z * sc; o[7] = bq.w * sc;
    }
    *(uint4*)(p->K + ((size_t)(kb_ * 6 + hd) * SEQ + ks0_ + row) * 96 + dg * 8) = pack8(o);
  }
  if (hd == 0) {
#pragma unroll
    for (int i = 0; i < 2; ++i) {
      const int u = tid + 256 * i;
      const int row = u >> 2, dq = u & 3;
      const int i0 = (dq & 1) * 8;
      const u16* kr = p->proj + (size_t)(m0 + row) * DINP + C_KR;
      float x1[8], x2[8], o[8];
      unpack8(*(const uint4*)(kr + i0), x1);
      unpack8(*(const uint4*)(kr + 16 + i0), x2);
      const float2* tb = p->tab + (size_t)(m0 + row) * 16 + i0;
      if (dq < 2) {
#pragma unroll
        for (int j = 0; j < 8; ++j) { float2 cs = tb[j]; o[j] = x1[j] * cs.x - x2[j] * cs.y; }
      } else {
#pragma unroll
        for (int j = 0; j < 8; ++j) { float2 cs = tb[j]; o[j] = x2[j] * cs.x + x1[j] * cs.y; }
      }
      const uint4 ov = pack8(o);
#pragma unroll
      for (int hh2 = 0; hh2 < 6; ++hh2)
        *(uint4*)(p->K + ((size_t)(kb_ * 6 + hh2) * SEQ + ks0_ + row) * 96 + 64 + dq * 8) = ov;
    }
  }
  const int b = m0 / SEQ, s0 = m0 % SEQ;
#pragma unroll
  for (int i = 0; i < 4; ++i) {
    const int u = tid + 256 * i;
    const int dv = u & 63, tg = u >> 6;
    float o[8];
#pragma unroll
    for (int j = 0; j < 8; ++j) o[j] = st[(tg * 8 + j) * 132 + 64 + dv] * ssm[tg * 8 + j];
    u16* vdst = p->VT + (((size_t)(b * 6 + hd) * 128 + (s0 >> 6) + (tg >> 3)) * 64 + dv) * 64 + ((tg & 7) >> 1) * 16 + (tg & 1) * 4;
    uint2 lo2, hi2;
    lo2.x = pack2(o[0], o[1]); lo2.y = pack2(o[2], o[3]);
    hi2.x = pack2(o[4], o[5]); hi2.y = pack2(o[6], o[7]);
    *(uint2*)(vdst) = lo2;
    *(uint2*)(vdst + 8) = hi2;
  }
  __syncthreads();
}

__device__ void item_lru(PP p, int l, int tt, int hd, u16* lds, float* ssm) {
  p = launder(p);
  const int tid = opaque_tid(), lane = tid & 63, w = tid >> 6, r = lane & 31, h = lane >> 5;
  const int t0 = tt * 64;
  const int s0 = t0 % SEQ;
  float* xaf = (float*)lds;
  u16* xcb = lds + 8576;
  float* aarr = (float*)(lds + 8576 + 4608);
  float* barr = aarr + 4096;
  const int c = tid & 63;
  const int cg = hd * 64 + c;
  bf16x8 wfa[4], wfx[4];
  {
    const int cbk_ = w & 1;
    const u16* wa_ = p->waT + (size_t)(l * 6 + hd) * 4096 + (cbk_ * 32 + r) * 64 + h * 8;
    const u16* wx_ = p->wxT + (size_t)(l * 6 + hd) * 4096 + (cbk_ * 32 + r) * 64 + h * 8;
#pragma unroll
    for (int ks = 0; ks < 4; ++ks) { wfa[ks] = *(const bf16x8*)(wa_ + ks * 16); wfx[ks] = *(const bf16x8*)(wx_ + ks * 16); }
  }
  for (int u = tid; u < 67 * 8; u += 256) {
    const int row = u >> 3, c8 = u & 7;
    float v[8];
    if (s0 + row - 3 >= 0) {
      unpack8(*(const uint4*)(p->proj + (size_t)(t0 + row - 3) * DINP + C_XA + hd * 64 + c8 * 8), v);
    } else {
#pragma unroll
      for (int j = 0; j < 8; ++j) v[j] = 0.f;
    }
    *(float4*)(xaf + row * 64 + c8 * 8) = make_float4(v[0], v[1], v[2], v[3]);
    *(float4*)(xaf + row * 64 + c8 * 8 + 4) = make_float4(v[4], v[5], v[6], v[7]);
  }
  __syncthreads();
  const float cw0 = p->conv_w[(l * 4 + 0) * 384 + cg], cw1 = p->conv_w[(l * 4 + 1) * 384 + cg];
  const float cw2 = p->conv_w[(l * 4 + 2) * 384 + cg], cw3 = p->conv_w[(l * 4 + 3) * 384 + cg];
  const float cbias = p->conv_b[l * 384 + cg];
  {
    const int tq = tid >> 6;
    for (int t = tq * 16; t < tq * 16 + 16; ++t) {
      const float xc = cbias + cw0 * xaf[t * 64 + c] + cw1 * xaf[(t + 1) * 64 + c] + cw2 * xaf[(t + 2) * 64 + c] + cw3 * xaf[(t + 3) * 64 + c];
      xcb[t * LDT + c] = f2bf(xc);
    }
  }
  __syncthreads();
  {
    const int tb = w >> 1, cbk = w & 1;
    f32x16 aa, ax;
#pragma unroll
    for (int i = 0; i < 16; ++i) { aa[i] = 0.f; ax[i] = 0.f; }
    const u16* xr = xcb + (tb * 32 + r) * LDT + h * 8;
#pragma unroll
    for (int ks = 0; ks < 4; ++ks) {
      bf16x8 af = *(const bf16x8*)(xr + ks * 16);
      aa = mfma32(af, wfa[ks], aa);
      ax = mfma32(af, wfx[ks], ax);
    }
    const int cc = cbk * 32 + r;
    const int cgl = hd * 64 + cc;
    const float ba = p->lru_ba[l * 384 + cgl], bx = p->lru_bx[l * 384 + cgl];
    const float lam = p->lru_lam[l * 384 + cgl];
    const float nl = -lam;
    const float sp = fmaxf(nl, 0.f) + log1pf(expf(-fabsf(nl)));
#pragma unroll
    for (int reg = 0; reg < 16; ++reg) {
      const int t = tb * 32 + (reg & 3) + 8 * (reg >> 2) + 4 * h;
      const float xc = bf2f(xcb[t * LDT + cc]);
      const float ga = sigmoidf_(aa[reg] + ba);
      const float gx = sigmoidf_(ax[reg] + bx);
      const float la = -8.f * ga * sp;
      const float a = __expf(la);
      const float om = (la > -5e-4f) ? (-2.f * la) * (1.f + la) : (1.f - a * a);
      const float mult = sqrtf(fmaxf(om, 0.f));
      aarr[t * 64 + cc] = a;
      barr[t * 64 + cc] = mult * gx * xc;
    }
  }
  __syncthreads();
  const int seg = tid >> 6;
  u16* h16 = (u16*)aarr;
  u16* c16 = (u16*)barr;
  float pr[16], hr[16];
#pragma unroll
  for (int j = 0; j < 16; ++j) { pr[j] = aarr[(seg * 16 + j) * 64 + c]; hr[j] = barr[(seg * 16 + j) * 64 + c]; }
  {
    float hh = 0.f, P = 1.f;
#pragma unroll
    for (int j = 0; j < 16; ++j) { hh = pr[j] * hh + hr[j]; P *= pr[j]; hr[j] = hh; pr[j] = P; }
    ssm[seg * 64 + c] = P;
    ssm[256 + seg * 64 + c] = hh;
  }
  __syncthreads();
  {
    float Hc = 0.f, Pc = 1.f;
    for (int s2 = 0; s2 < seg; ++s2) {
      const float Ps = ssm[s2 * 64 + c], Hs = ssm[256 + s2 * 64 + c];
      Hc = Ps * Hc + Hs; Pc *= Ps;
    }
    float hl = 0.f, cm = 1.f;
#pragma unroll
    for (int j = 0; j < 16; ++j) {
      hl = hr[j] + pr[j] * Hc;
      cm = pr[j] * Pc;
      h16[(seg * 16 + j) * 64 + c] = f2bf(hl);
      c16[(seg * 16 + j) * 64 + c] = f2bf(cm);
    }
    if (seg == 3) {
      p->Htile[(size_t)tt * 384 + cg] = hl;
      p->Ptile[(size_t)tt * 384 + cg] = cm;
    }
  }
  __syncthreads();
#pragma unroll
  for (int i = 0; i < 2; ++i) {
    const int id = tid + 256 * i;
    const int row = id >> 3, c8 = id & 7;
    const uint4 hv = *(const uint4*)(h16 + row * 64 + c8 * 8);
    const uint4 cv = *(const uint4*)(c16 + row * 64 + c8 * 8);
    *(uint4*)(p->hloc + (size_t)(t0 + row) * 384 + hd * 64 + c8 * 8) = hv;
    *(uint4*)(p->cum + (size_t)(t0 + row) * 384 + hd * 64 + c8 * 8) = cv;
  }
  __syncthreads();
}

__device__ void item_sgu(PP p, int l, int nbk, u16* lds, float* ssm) {
  p = launder(p);
  const int tid = opaque_tid(), lane = tid & 63, w = tid >> 6, r = lane & 31, h = lane >> 5;
  const int m0 = nbk * 128;
  {
    const int row = tid >> 1, half = tid & 1;
    const u16* src = p->proj + (size_t)(m0 + row) * DINP + C_V + half * 128;
    float s1 = 0.f, s2 = 0.f;
#pragma unroll
    for (int i = 0; i < 16; ++i) {
      float v[8]; unpack8(*(const uint4*)(src + i * 8), v);
#pragma unroll
      for (int j = 0; j < 8; ++j) { const float gq = geluf_(v[j]); s1 += gq; s2 += gq * gq; }
    }
    s1 += __shfl_xor(s1, 1); s2 += __shfl_xor(s2, 1);
    if (half == 0) {
      const float mu = s1 * (1.f / 256.f);
      const float var = fmaxf(s2 * (1.f / 256.f) - mu * mu, 0.f);
      ssm[row] = mu; ssm[128 + row] = rsqrtf(var + EPSF);
    }
  }
  u16* vbT = lds;
  for (int g = 0; g < 4; ++g) {
    __syncthreads();
    {
      const int j = tid & 127, chalf = tid >> 7;
      const float mu = ssm[j], rs = ssm[128 + j];
      const u16* src = p->proj + (size_t)(m0 + j) * DINP + C_V + g * 64 + chalf * 32;
      const float* lg = p->sgu_g + l * 256 + g * 64 + chalf * 32;
      const float* lb = p->sgu_bn + l * 256 + g * 64 + chalf * 32;
#pragma unroll
      for (int i = 0; i < 4; ++i) {
        float v[8]; unpack8(*(const uint4*)(src + i * 8), v);
#pragma unroll
        for (int q = 0; q < 8; ++q) {
          const int cc = chalf * 32 + i * 8 + q;
          const float val = (geluf_(v[q]) - mu) * rs * lg[i * 8 + q] + lb[i * 8 + q];
          vbT[cc * 136 + j] = f2bf(val);
        }
      }
    }
    __syncthreads();
    f32x16 a0, a1;
#pragma unroll
    for (int i = 0; i < 16; ++i) { a0[i] = 0.f; a1[i] = 0.f; }
    const u16* wr = p->sguW + ((size_t)(l * 4 + g) * 128 + w * 32 + r) * 128 + h * 8;
    const u16* v0 = vbT + r * 136 + h * 8;
    const u16* v1 = vbT + (32 + r) * 136 + h * 8;
    const int nks = (w < 2) ? 4 : 8;
    for (int ks = 0; ks < nks; ++ks) {
      bf16x8 af = *(const bf16x8*)(wr + ks * 16);
      bf16x8 b0 = *(const bf16x8*)(v0 + ks * 16);
      bf16x8 b1 = *(const bf16x8*)(v1 + ks * 16);
      a0 = mfma32(af, b0, a0);
      a1 = mfma32(af, b1, a1);
    }
    float* stg = (float*)(lds + 8704);
#pragma unroll
    for (int reg = 0; reg < 16; ++reg) {
      const int i = w * 32 + (reg & 3) + 8 * (reg >> 2) + 4 * h;
      const float bsv = p->sgu_b[(l * 4 + g) * 128 + i];
      stg[i * 68 + r] = a0[reg] + bsv;
      stg[i * 68 + 32 + r] = a1[reg] + bsv;
    }
    __syncthreads();
#pragma unroll
    for (int k = 0; k < 4; ++k) {
      const int u = tid + 256 * k;
      const int i = u >> 3, c8 = u & 7;
      const size_t tok = (size_t)(m0 + i);
      const int ch = g * 64 + c8 * 8;
      const float4 m0v = *(const float4*)(stg + i * 68 + c8 * 8), m1v = *(const float4*)(stg + i * 68 + c8 * 8 + 4);
      const float mx[8] = {m0v.x, m0v.y, m0v.z, m0v.w, m1v.x, m1v.y, m1v.z, m1v.w};
      float uu[8], gcv[8], o[8];
      unpack8(*(const uint4*)(p->proj + tok * DINP + C_U + ch), uu);
      unpack8(*(const uint4*)(p->proj + tok * DINP + C_GC + ch), gcv);
#pragma unroll
      for (int q = 0; q < 8; ++q) o[q] = geluf_(uu[q]) * mx[q] * siluf_(gcv[q]);
      *(uint4*)(p->ycpre + tok * 256 + ch) = pack8(o);
    }
  }
  __syncthreads();
}

__device__ void item_carry(PP p, int ci) {
  p = launder(p);
  const int idx = ci * 256 + opaque_tid();
  const int b = idx / 384, c = idx % 384;
  float carry = 0.f;
  for (int tt = 0; tt < 128; ++tt) {
    const size_t o = (size_t)(b * 128 + tt) * 384 + c;
    p->carry[o] = carry;
    carry = p->Ptile[o] * carry + p->Htile[o];
  }
}

#define KLD 104
#define VLD 72
#define ATT_STAGE (64 * KLD + 64 * VLD)
struct AStage { u32x4 k0, k1, k2, v0, v1; };
__device__ __forceinline__ void as_load(AStage& g, const u16* kg, const u16* vg, int kt) {
  const u16* kp = kg + (size_t)kt * 6144;
  g.k0 = *(const u32x4*)(kp); g.k1 = *(const u32x4*)(kp + 2048); g.k2 = *(const u32x4*)(kp + 4096);
  const u16* vp = vg + (size_t)kt * 4096;
  g.v0 = *(const u32x4*)(vp); g.v1 = *(const u32x4*)(vp + 2048);
#ifdef DUP_LOADS
  {
    u32x4 t0 = *(const volatile u32x4*)(kp), t1 = *(const volatile u32x4*)(kp + 2048), t2 = *(const volatile u32x4*)(kp + 4096);
    u32x4 t3 = *(const volatile u32x4*)(vp), t4 = *(const volatile u32x4*)(vp + 2048);
    asm volatile("" :: "v"(t0), "v"(t1), "v"(t2), "v"(t3), "v"(t4));
  }
#endif
}
__device__ __forceinline__ void as_store(const AStage& g, u16* db, int kl0, int kl1, int kl2, int vl) {
  *(u32x4*)(db + kl0) = g.k0; *(u32x4*)(db + kl1) = g.k1; *(u32x4*)(db + kl2) = g.k2;
  *(u32x4*)(db + vl) = g.v0; *(u32x4*)(db + vl + 32 * VLD) = g.v1;
}
__device__ __forceinline__ float max3f(float a, float b, float c) {
  float d; asm("v_max3_f32 %0, %1, %2, %3" : "=v"(d) : "v"(a), "v"(b), "v"(c)); return d;
}
__device__ __forceinline__ bf16x8 pack_p(const f32x16& s, int o) {
  u32x4 pu;
  pu.x = pack2(s[o + 0], s[o + 1]); pu.y = pack2(s[o + 2], s[o + 3]);
  pu.z = pack2(s[o + 4], s[o + 5]); pu.w = pack2(s[o + 6], s[o + 7]);
  return __builtin_bit_cast(bf16x8, pu);
}
__device__ __forceinline__ void attn_qk(const u16* kp, const bf16x8 (&qa)[6], f32x16& s0, f32x16& s1) {
#pragma unroll
  for (int ks = 0; ks < 6; ++ks) {
    bf16x8 k0 = *(const bf16x8*)(kp + ks * 16);
    bf16x8 k1 = *(const bf16x8*)(kp + 32 * KLD + ks * 16);
    s0 = mfma32(k0, qa[ks], s0);
    s1 = mfma32(k1, qa[ks], s1);
  }
}
__device__ __forceinline__ void attn_tile(const u16* sb, const bf16x8 (&qa)[6], f32x16& o0, f32x16& o1, f32x16& lacc,
                                          float& m, bool& mz, int r, int h, bool first) {
  const u16* kp = sb + r * KLD + h * 8;
  f32x16 s0, s1;
  __builtin_amdgcn_s_setprio(1);
  if (mz) {
#pragma unroll
    for (int i = 0; i < 16; ++i) { s0[i] = 0.f; s1[i] = 0.f; }
    attn_qk(kp, qa, s0, s1);
  } else {
#pragma unroll
    for (int i = 0; i < 16; ++i) { s0[i] = -m; s1[i] = -m; }
    attn_qk(kp, qa, s0, s1);
  }
  __builtin_amdgcn_s_setprio(0);
  float mxa = max3f(s0[0], s0[1], s0[2]), mxb = max3f(s0[3], s0[4], s0[5]);
  float mxc = max3f(s0[6], s0[7], s0[8]), mxd = max3f(s0[9], s0[10], s0[11]);
  mxa = max3f(mxa, s0[12], s0[13]); mxb = max3f(mxb, s0[14], s0[15]);
  mxc = max3f(mxc, s1[0], s1[1]); mxd = max3f(mxd, s1[2], s1[3]);
  mxa = max3f(mxa, s1[4], s1[5]); mxb = max3f(mxb, s1[6], s1[7]);
  mxc = max3f(mxc, s1[8], s1[9]); mxd = max3f(mxd, s1[10], s1[11]);
  mxa = max3f(mxa, s1[12], s1[13]); mxb = max3f(mxb, s1[14], s1[15]);
  const float lm = max3f(mxa, mxb, fmaxf(mxc, mxd));
  bool slow;
  if (first) {
    const float mx = fmaxf(lm, __shfl_xor(lm, 32));
    slow = __any(mx > 30.f || mx < -30.f);
  } else {
    slow = __any(lm > 30.f);
  }
  if (slow) {
    const float mx = fmaxf(lm, __shfl_xor(lm, 32));
    const float d = first ? mx : fmaxf(mx, 0.f);
    const float alpha = first ? 1.f : __builtin_amdgcn_exp2f(-d);
    m += d;
    mz = false;
#pragma unroll
    for (int i = 0; i < 16; ++i) { s0[i] -= d; s1[i] -= d; o0[i] *= alpha; o1[i] *= alpha; }
    lacc[0] *= alpha;
  }
  float pa = 0.f, pb = 0.f, pc = 0.f, pd = 0.f;
#pragma unroll
  for (int i = 0; i < 16; ++i) {
    s0[i] = __builtin_amdgcn_exp2f(s0[i]); s1[i] = __builtin_amdgcn_exp2f(s1[i]);
    if ((i & 3) == 0) pa += s0[i] + s1[i];
    else if ((i & 3) == 1) pb += s0[i] + s1[i];
    else if ((i & 3) == 2) pc += s0[i] + s1[i];
    else pd += s0[i] + s1[i];
  }
  lacc[0] += (pa + pb) + (pc + pd);
  const u16* vp = sb + 64 * KLD + r * VLD + 8 * h;
  __builtin_amdgcn_s_setprio(1);
#pragma unroll
  for (int kb = 0; kb < 2; ++kb) {
#pragma unroll
    for (int s = 0; s < 2; ++s) {
      const bf16x8 pf = pack_p(kb == 0 ? s0 : s1, 8 * s);
      const int koff = kb * 32 + 16 * s;
      const bf16x8 v0 = *(const bf16x8*)(vp + koff);
      const bf16x8 v1 = *(const bf16x8*)(vp + 32 * VLD + koff);
      o0 = mfma32(v0, pf, o0);
      o1 = mfma32(v1, pf, o1);
    }
  }
  __builtin_amdgcn_s_setprio(0);
}
__device__ __forceinline__ void attn_write_o(u16* op, const f32x16& o0, const f32x16& o1, float inv) {
#pragma unroll
  for (int g = 0; g < 4; ++g) {
    uint2 v;
    v.x = pack2(o0[4 * g] * inv, o0[4 * g + 1] * inv); v.y = pack2(o0[4 * g + 2] * inv, o0[4 * g + 3] * inv);
    *(uint2*)(op + 8 * g) = v;
    v.x = pack2(o1[4 * g] * inv, o1[4 * g + 1] * inv); v.y = pack2(o1[4 * g + 2] * inv, o1[4 * g + 3] * inv);
    *(uint2*)(op + 32 + 8 * g) = v;
  }
}

__device__ void item_attn(PP p, int qb, int b, int hh, u16* lds) {
  p = launder(p);
  const int tid = opaque_tid(), lane = tid & 63, w = tid >> 6, r = lane & 31, h = lane >> 5;
  const size_t tokbase = (size_t)b * SEQ;
  const int q0 = qb * 128 + w * 32;
  bf16x8 qa[6];
  {
    const u16* qp = p->Q + ((tokbase + q0 + r) * 6 + hh) * 96 + h * 8;
#pragma unroll
    for (int ks = 0; ks < 6; ++ks) qa[ks] = *(const bf16x8*)(qp + ks * 16);
  }
  f32x16 oa0, oa1, lacc;
#pragma unroll
  for (int i = 0; i < 16; ++i) { oa0[i] = 0.f; oa1[i] = 0.f; lacc[i] = 0.f; }
  float ma = 0.f;
  bool mz = true;
  const int ntiles = 2 * qb + 2;
  const int my_ntiles = 2 * qb + 1 + (w >> 1);
  const u16* kg = p->K + (size_t)(b * 6 + hh) * SEQ * 96 + tid * 8;
  const u16* vg = p->VT + (size_t)(b * 6 + hh) * SEQ * 64 + tid * 8;
  const int id1 = tid + 256, id2 = tid + 512;
  const int kl0 = (tid / 12) * KLD + (tid % 12) * 8;
  const int kl1 = (id1 / 12) * KLD + (id1 % 12) * 8;
  const int kl2 = (id2 / 12) * KLD + (id2 % 12) * 8;
  const int vl = 64 * KLD + (tid >> 3) * VLD + (tid & 7) * 8;
  AStage A, B;
  as_load(B, kg, vg, 0);
  as_load(A, kg, vg, 1);
  as_store(B, lds, kl0, kl1, kl2, vl);
  __syncthreads();
  for (int kt = 0; kt < ntiles; kt += 2) {
    if (kt + 2 < ntiles) as_load(B, kg, vg, kt + 2);
    attn_tile(lds, qa, oa0, oa1, lacc, ma, mz, r, h, kt == 0);
    as_store(A, lds + ATT_STAGE, kl0, kl1, kl2, vl);
    __syncthreads();
    if (kt + 3 < ntiles) as_load(A, kg, vg, kt + 3);
    if (kt + 1 < my_ntiles) attn_tile(lds + ATT_STAGE, qa, oa0, oa1, lacc, ma, mz, r, h, false);
    if (kt + 2 < ntiles) as_store(B, lds, kl0, kl1, kl2, vl);
    __syncthreads();
  }
  const float lta = lacc[0] + __shfl_xor(lacc[0], 32);
  u16* op = p->obuf + (tokbase + q0 + r) * 384 + hh * 64 + 4 * h;
  attn_write_o(op, oa0, oa1, 1.f / lta);
}

__device__ void phase_y(PP p, int l) {
  p = launder(p);
  const int tid_ = opaque_tid();
  const int lane = tid_ & 63;
  const int gw = blockIdx.x * 4 + (tid_ >> 6), nw = gridDim.x * 4;
  const float* bg = p->br_g + l * DM + lane * 16;
  const int seg = (lane < 24) ? 0 : (lane < 48) ? 1 : 2;
  const u16* xbase; const u16* gbase; size_t xs, gs;
  if (seg == 0) { xbase = p->hloc + lane * 16; xs = 384; gbase = p->proj + C_GA + lane * 16; gs = DINP; }
  else if (seg == 1) { xbase = p->obuf + (lane - 24) * 16; xs = 384; gbase = p->proj + C_GB + (lane - 24) * 16; gs = DINP; }
  else { xbase = p->ycpre + (lane - 48) * 16; xs = 256; gbase = xbase; gs = 256; }
  for (int tok0 = gw; tok0 < T_TOK; tok0 += 2 * nw) {
    const int tok1 = (tok0 + nw < T_TOK) ? tok0 + nw : tok0;
    uint4 xr[2][2], gr[2][2], cr_[2][2];
    float4 cy[2][4];
#pragma unroll
    for (int t = 0; t < 2; ++t) {
      const size_t tok = (size_t)(t ? tok1 : tok0);
      xr[t][0] = *(const uint4*)(xbase + tok * xs); xr[t][1] = *(const uint4*)(xbase + tok * xs + 8);
      gr[t][0] = *(const uint4*)(gbase + tok * gs); gr[t][1] = *(const uint4*)(gbase + tok * gs + 8);
    }
    if (seg == 0) {
#pragma unroll
      for (int t = 0; t < 2; ++t) {
        const size_t tok = (size_t)(t ? tok1 : tok0);
        cr_[t][0] = *(const uint4*)(p->cum + tok * 384 + lane * 16); cr_[t][1] = *(const uint4*)(p->cum + tok * 384 + lane * 16 + 8);
        const float* cp = p->carry + (tok >> 6) * 384 + lane * 16;
#pragma unroll
        for (int i = 0; i < 4; ++i) cy[t][i] = *(const float4*)(cp + 4 * i);
      }
    }
#pragma unroll
    for (int t = 0; t < 2; ++t) {
      const size_t tok = (size_t)(t ? tok1 : tok0);
      float v[16], g[16];
      unpack8(xr[t][0], v); unpack8(xr[t][1], v + 8);
      unpack8(gr[t][0], g); unpack8(gr[t][1], g + 8);
      if (seg == 0) {
        float cm[16];
        unpack8(cr_[t][0], cm); unpack8(cr_[t][1], cm + 8);
#pragma unroll
        for (int i = 0; i < 4; ++i) {
          v[4 * i] += cm[4 * i] * cy[t][i].x; v[4 * i + 1] += cm[4 * i + 1] * cy[t][i].y;
          v[4 * i + 2] += cm[4 * i + 2] * cy[t][i].z; v[4 * i + 3] += cm[4 * i + 3] * cy[t][i].w;
        }
      }
      if (seg < 2) {
#pragma unroll
        for (int j = 0; j < 16; ++j) v[j] *= siluf_(g[j]);
      }
      float ss = 0.f;
#pragma unroll
      for (int j = 0; j < 16; ++j) ss += v[j] * v[j];
      const float sa = wave_sum(seg == 0 ? ss : 0.f);
      const float sb = wave_sum(seg == 1 ? ss : 0.f);
      const float sc = wave_sum(seg == 2 ? ss : 0.f);
      const float rs = (seg == 0) ? rsqrtf(sa * (1.f / 384.f) + EPSF)
                     : (seg == 1) ? rsqrtf(sb * (1.f / 384.f) + EPSF) : rsqrtf(sc * (1.f / 256.f) + EPSF);
      float o[16];
#pragma unroll
      for (int j = 0; j < 16; ++j) o[j] = v[j] * rs * bg[j];
      *(uint4*)(p->hbuf + tok * DM + lane * 16) = pack8(o);
      *(uint4*)(p->hbuf + tok * DM + lane * 16 + 8) = pack8(o + 8);
    }
  }
}

__device__ __forceinline__ int next_item(int* counter, int* slot) {
  __syncthreads();
  if (threadIdx.x == 0) *slot = atomicAdd(counter, 1);
  __syncthreads();
  return *slot;
}


#define XB_TMO      128
#define XB_XCNT(j)  (256  + 64 * (j))
#define XB_XSUB(j)  (1280 + 64 * (j))
#define XB_XGEN(j)  (2304 + 64 * (j))
#define XB_TOP      3328
#define XB_TOPGEN   3392
#define XCD_BAR_WORDS 3456
#define XB_SPIN_CAP (1u << 18)
#define LAS __attribute__((address_space(3)))
__device__ __forceinline__ unsigned xb_ld(unsigned* p)              { return __hip_atomic_load(p, __ATOMIC_RELAXED, __HIP_MEMORY_SCOPE_AGENT); }
__device__ __forceinline__ unsigned xb_add(unsigned* p, unsigned v) { return __hip_atomic_fetch_add(p, v, __ATOMIC_RELAXED, __HIP_MEMORY_SCOPE_AGENT); }
__device__ __forceinline__ unsigned xb_xcc_id() { return (unsigned)__builtin_amdgcn_s_getreg((3 << 11) | 20) & 0xFu; }
#define XB_SPIN(cond, bar) do { unsigned _sp = 0; while (cond) { __builtin_amdgcn_s_sleep(1); \
    if ((++_sp & 255u) == 0u) { if (xb_ld(&(bar)[XB_TMO])) break; if (_sp > XB_SPIN_CAP) { atomicAdd(&(bar)[XB_TMO], 1u); break; } } } } while (0)
struct XcdBarrier { unsigned* bar; unsigned x; volatile LAS unsigned* st; };
__device__ __forceinline__ XcdBarrier xcd_barrier_post(unsigned* bar, volatile LAS unsigned* st) {
    XcdBarrier b; b.bar = bar; b.x = xb_xcc_id(); b.st = st;
    if (threadIdx.x == 0) (void)xb_add(&bar[XB_XCNT(b.x)], 1u);
    return b;
}
__device__ __forceinline__ void xcd_barrier_complete(unsigned* bar, unsigned x, unsigned& nloc, unsigned& nx) {
    const unsigned G = gridDim.x * gridDim.y * gridDim.z;
    unsigned sum, cnt, mine, sp = 0u;
    for (;;) {
        sum = 0u; cnt = 0u; mine = 0u;
#pragma unroll
        for (unsigned j = 0; j < 16; ++j) { const unsigned c = xb_ld(&bar[XB_XCNT(j)]); sum += c; cnt += (c > 0u) ? 1u : 0u; mine = (j == x) ? c : mine; }
        if (sum == G) break;
        __builtin_amdgcn_s_sleep(1);
        if ((++sp & 255u) == 0u) { if (xb_ld(&bar[XB_TMO])) break; if (sp > XB_SPIN_CAP) { atomicAdd(&bar[XB_TMO], 1u); break; } }
    }
    nloc = mine > 0u ? mine : 1u; nx = cnt > 0u ? cnt : 1u;
}
__device__ __forceinline__ void xcd_barrier(const XcdBarrier& b) {
    asm volatile("s_waitcnt vmcnt(0)" ::: "memory");
    __syncthreads();
    if (threadIdx.x == 0) {
        unsigned* bar = b.bar;
        __builtin_amdgcn_s_waitcnt(0);
        unsigned nloc = b.st[0], nx = b.st[1];
        if (nloc == 0u) { xcd_barrier_complete(bar, b.x, nloc, nx); b.st[0] = nloc; b.st[1] = nx; }
        const unsigned old = xb_add(&bar[XB_XSUB(b.x)], 1u);
        const unsigned gen = old / nloc;
        if (old + 1u == (gen + 1u) * nloc) {
            __builtin_amdgcn_fence(__ATOMIC_RELEASE, "agent");
            asm volatile("s_waitcnt vmcnt(0)" ::: "memory");
            const unsigned og = xb_add(&bar[XB_TOP], 1u);
            const unsigned tg = og / nx;
            if (og + 1u == (tg + 1u) * nx) xb_add(&bar[XB_TOPGEN], 1u);
            else XB_SPIN(xb_ld(&bar[XB_TOPGEN]) == tg, bar);
            __builtin_amdgcn_fence(__ATOMIC_ACQUIRE, "agent");
            xb_add(&bar[XB_XGEN(b.x)], 1u);
            asm volatile("s_waitcnt vmcnt(0)" ::: "memory");
        } else {
            XB_SPIN(xb_ld(&bar[XB_XGEN(b.x)]) == gen, bar);
            __builtin_amdgcn_fence(__ATOMIC_ACQUIRE, "agent");
            asm volatile("s_waitcnt vmcnt(0)" ::: "memory");
        }
    }
    __syncthreads();
}

#define N_PHASES (1 + 6 * NLAYER + 1)

__device__ void run_phase(PP p, int ph, u16* lds, float* ssm, int* slot, int rep) {
  int l = (ph - 1) / 6, sub = (ph - 1) % 6 + 1;
  if (ph == 0) { sub = 0; l = 0; }
  if (ph == N_PHASES - 1) { sub = 1; l = NLAYER; }
#ifdef ONLYSUB
  sub = ONLYSUB;
#endif
  const int bid = blockIdx.x, nb = gridDim.x;
  if (sub == 0) { phase_prep(p, (float*)lds); return; }
  if (sub == 1) { phase_norm(p, l); return; }
  if (sub == 2) {
    gemm_phase(p->wInT + (size_t)l * DINP * DM, DM, p->hbuf, DM, DM, p->proj, DINP, 18, 256 * 18, lds);
    return;
  }
  if (sub == 3) {
    int* ctr = p->counters + l * 16 + rep * 64;
    for (;;) {
      int it = next_item(ctr, slot);
      if (it >= 256 + 1536 + 1536 + 3072) break;
#ifdef ONLYITEM
      it = (ONLYITEM == 0) ? (it & 255) : (ONLYITEM == 1) ? 256 + (it & 1023) : (ONLYITEM == 2) ? 256 + 1536 + (it & 1023) : 256 + 3072 + (it & 2047);
#endif
#ifdef REPEAT_ITEM
      if (rep == 1) { const int ty = (it < 256) ? 0 : (it < 256 + 1536) ? 1 : (it < 256 + 3072) ? 2 : 3; if (ty != REPEAT_ITEM) continue; }
#endif
      if (it < 256) item_sgu(p, l, it, lds, ssm);
      else if (it < 256 + 1536) { const int k = it - 256; item_q(p, l, k / 6, k % 6, lds, ssm); }
      else if (it < 256 + 3072) { const int k = it - 256 - 1536; item_kv(p, l, k / 6, k % 6, lds, ssm); }
      else { const int k = it - 256 - 3072; item_lru(p, l, k / 6, k % 6, lds, ssm); }
    }
    return;
  }
  if (sub == 4) {
    if (bid < 6) item_carry(p, bid);
    const int xq = (int)(xb_xcc_id() & 7u);
    int* cbase = p->counters + l * 16 + 8 + rep * 64;
    for (;;) {
      __syncthreads();
      if (threadIdx.x == 0) {
        int got = -1;
        for (int dq = 0; dq < 8 && got < 0; ++dq) {
          const int q = (xq + dq) & 7;
          if (__hip_atomic_load(cbase + q, __ATOMIC_RELAXED, __HIP_MEMORY_SCOPE_AGENT) < 192) {
            const int it = atomicAdd(cbase + q, 1);
            if (it < 192) got = q * 256 + it;
          }
        }
        *slot = got;
      }
      __syncthreads();
      const int got = *slot;
      if (got < 0) break;
      const int q = got >> 8, it = got & 255;
      int qb, bh;
      if (it < 64) { qb = 63 - it; bh = q * 3; }
      else { const int j = it - 64; qb = 63 - (j >> 1); bh = q * 3 + 1 + (j & 1); }
      item_attn(p, qb, bh / 6, bh % 6, lds);
    }
    return;
  }
  if (sub == 5) { phase_y(p, l); return; }
  gemm_phase(p->wOutT + (size_t)l * DM * DM, DM, p->hbuf, DM, DM, p->y2, DM, 8, 256 * 8, lds);
}

__global__ void __launch_bounds__(256, 2) mega_kernel(Params p, int ph_begin, int ph_end) {
  __shared__ __attribute__((aligned(16))) unsigned char lds_raw[LDS_BYTES];
  __shared__ float ssm[512];
  __shared__ int slot;
  u16* lds = (u16*)lds_raw;
  PP pp = (PP)__builtin_amdgcn_kernarg_segment_ptr();
#if COOP
  cg::grid_group grid = cg::this_grid();
  __shared__ uint4 xb_words;
  if (threadIdx.x == 0) xb_words = make_uint4(0u, 0u, 0u, 0u);
  __syncthreads();
  XcdBarrier xb = xcd_barrier_post(pp->bar, (volatile LAS unsigned*)&xb_words);
#endif
  int rep = 0;
  for (int ph = ph_begin; ph < ph_end;) {
    run_phase(launder(pp), ph, lds, ssm, &slot, rep);
    bool again = false;
#if COOP
#ifdef REPEAT_SUB
    if (ph > 0 && ph < N_PHASES - 1) {
      if (REPEAT_SUB == 99) { xcd_barrier(xb); xcd_barrier(xb); xcd_barrier(xb); xcd_barrier(xb); }
      else if (((ph - 1) % 6 + 1) == REPEAT_SUB && rep == 0) again = true;
    }
#endif
    if (again || ph + 1 < ph_end) {
      if (ph_end > 1000) grid.sync();
      xcd_barrier(xb);
    }
#endif
    if (again) rep = 1; else { rep = 0; ++ph; }
  }
}

extern "C" void kernel_launch(void* const* d_in, const int* in_sizes, int n_in, void* d_out, int out_size, void* d_ws,
                              size_t ws_size, hipStream_t stream) {
  Params p{};
  p.x = (const float*)d_in[0]; p.pos = (const int*)d_in[1]; p.pre_g = (const float*)d_in[2]; p.w_in = (const float*)d_in[3];
  p.conv_w = (const float*)d_in[4]; p.conv_b = (const float*)d_in[5]; p.lru_wa = (const float*)d_in[6]; p.lru_ba = (const float*)d_in[7];
  p.lru_wx = (const float*)d_in[8]; p.lru_bx = (const float*)d_in[9]; p.lru_lam = (const float*)d_in[10]; p.q_g = (const float*)d_in[11];
  p.w_uq = (const float*)d_in[12]; p.kv_g = (const float*)d_in[13]; p.w_ukv = (const float*)d_in[14]; p.sgu_g = (const float*)d_in[15];
  p.sgu_bn = (const float*)d_in[16]; p.sgu_w = (const float*)d_in[17]; p.sgu_b = (const float*)d_in[18]; p.br_g = (const float*)d_in[19];
  p.w_out = (const float*)d_in[20]; p.post_g = (const float*)d_in[21];
  p.out = (float*)d_out;
  unsigned char* ws = (unsigned char*)d_ws;
  size_t off = 0;
  auto take = [&](size_t bytes) { unsigned char* q = ws + off; off += (bytes + 255) & ~(size_t)255; return q; };
  p.counters = (int*)take(1024);
  p.bar = (unsigned*)take(XCD_BAR_WORDS * 4);
  p.wInT = (u16*)take((size_t)NLAYER * DINP * DM * 2);
  p.wOutT = (u16*)take((size_t)NLAYER * DM * DM * 2);
  p.wUqT = (u16*)take((size_t)NLAYER * 768 * 192 * 2);
  p.wUkvT = (u16*)take((size_t)NLAYER * 768 * 128 * 2);
  p.waT = (u16*)take((size_t)NLAYER * 6 * 4096 * 2);
  p.wxT = (u16*)take((size_t)NLAYER * 6 * 4096 * 2);
  p.sguW = (u16*)take((size_t)NLAYER * 4 * 128 * 128 * 2);
  p.tab = (float2*)take((size_t)T_TOK * 16 * 8);
  p.hbuf = (u16*)take((size_t)T_TOK * DM * 2);
  p.proj = (u16*)take((size_t)T_TOK * DINP * 2);
  p.y2 = (u16*)take((size_t)T_TOK * DM * 2);
  p.Q = (u16*)take((size_t)T_TOK * 576 * 2);
  p.K = (u16*)take((size_t)T_TOK * 576 * 2);
  p.VT = (u16*)take((size_t)T_TOK * 384 * 2);
  p.hloc = (u16*)take((size_t)T_TOK * 384 * 2);
  p.cum = (u16*)take((size_t)T_TOK * 384 * 2);
  p.Ptile = (float*)take((size_t)512 * 384 * 4);
  p.Htile = (float*)take((size_t)512 * 384 * 4);
  p.carry = (float*)take((size_t)512 * 384 * 4);
  p.obuf = (u16*)take((size_t)T_TOK * 384 * 2);
  p.ycpre = (u16*)take((size_t)T_TOK * 256 * 2);
  if (off > ws_size) { fprintf(stderr, "workspace too small: need %zu have %zu\n", off, ws_size); return; }

  static int grid_blocks = 0;
  if (!grid_blocks) {
    int dev = 0, cus = 0, per_cu = 0;
    hipGetDevice(&dev);
    hipDeviceGetAttribute(&cus, hipDeviceAttributeMultiprocessorCount, dev);
    hipOccupancyMaxActiveBlocksPerMultiprocessor(&per_cu, mega_kernel, 256, 0);
    if (per_cu > 2) per_cu = 2;
    if (per_cu < 1) per_cu = 1;
    grid_blocks = cus * per_cu;
  }
#if COOP
  (void)hipMemsetAsync(d_ws, 0, 1024 + ((XCD_BAR_WORDS * 4 + 255) & ~255), stream);
  int pb = 0, pe = N_PHASES;
  void* args[] = {&p, &pb, &pe};
  hipError_t e = hipLaunchCooperativeKernel((void*)mega_kernel, dim3(grid_blocks), dim3(256), args, 0, stream);
  if (e != hipSuccess) fprintf(stderr, "cooperative launch failed: %s (grid %d)\n", hipGetErrorString(e), grid_blocks);
#else
  for (int ph = 0; ph < N_PHASES; ++ph) mega_kernel<<<grid_blocks, 256, 0, stream>>>(p, ph, ph + 1);
#endif
}
```

```cpp
#include <hip/hip_runtime.h>
#include <hip/hip_cooperative_groups.h>
#include <stdint.h>
#include <stdio.h>
namespace cg = cooperative_groups;

typedef unsigned short u16;
typedef __attribute__((ext_vector_type(8))) short bf16x8;
typedef __attribute__((ext_vector_type(16))) float f32x16;
typedef __attribute__((ext_vector_type(4))) unsigned u32x4;
typedef __attribute__((ext_vector_type(2))) unsigned u32x2;

#ifndef COOP
#define COOP 1
#endif

#define T_TOK 32768
#define SEQ 8192
#define DM 1024
#define DIN 2272
#define DINP 2304
#define NLAYER 4
#define EPSF 1e-6f
#define C_XA 0
#define C_GA 384
#define C_QL 768
#define C_KVL 960
#define C_KR 1088
#define C_GB 1120
#define C_U 1504
#define C_V 1760
#define C_GC 2016

#define LDT 72
#define TILE_U16 (128 * LDT)
#define LDS_BYTES 73728

struct Params {
  const float* x; const int* pos; const float* pre_g; const float* w_in; const float* conv_w; const float* conv_b;
  const float* lru_wa; const float* lru_ba; const float* lru_wx; const float* lru_bx; const float* lru_lam;
  const float* q_g; const float* w_uq; const float* kv_g; const float* w_ukv; const float* sgu_g; const float* sgu_bn;
  const float* sgu_w; const float* sgu_b; const float* br_g; const float* w_out; const float* post_g;
  float* out;
  u16* wInT; u16* wOutT; u16* wUqT; u16* wUkvT; u16* waT; u16* wxT; u16* sguW;
  float2* tab; int* counters; unsigned* bar;
  u16* hbuf;
  u16* proj;
  u16* y2;
  u16* Q; u16* K; u16* VT;
  u16* hloc; u16* cum; float* Ptile; float* Htile; float* carry;
  u16* obuf; u16* ycpre;
};

__device__ const double c_invfreq_rev[16] = {1.59154943091895345608e-01, 8.94994016088910132600e-02, 5.03292121044870352509e-02, 2.83021958306233986646e-02, 1.59154943091895338669e-02, 8.94994016088910236684e-03, 5.03292121044870369856e-03, 2.83021958306233986646e-03, 1.59154943091895356017e-03, 8.94994016088910236684e-04, 5.03292121044870326488e-04, 2.83021958306233954120e-04, 1.59154943091895350596e-04, 8.94994016088910182474e-05, 5.03292121044870353593e-05, 2.83021958306233960897e-05};
typedef const __attribute__((address_space(4))) Params* PP;
__device__ __forceinline__ PP launder(PP q) { asm volatile("" : "+s"(q)); return q; }
__device__ __forceinline__ float bf2f(u16 b) { return __uint_as_float(((unsigned)b) << 16); }
typedef __attribute__((ext_vector_type(2))) __bf16 bf16x2_t;
__device__ __forceinline__ u16 f2bf(float f) { return __builtin_bit_cast(u16, (__bf16)f); }
__device__ __forceinline__ unsigned pack2(float a, float b) { bf16x2_t v = {(__bf16)a, (__bf16)b}; return __builtin_bit_cast(unsigned, v); }
__device__ __forceinline__ float lo16(unsigned u) { return __uint_as_float(u << 16); }
__device__ __forceinline__ float hi16(unsigned u) { return __uint_as_float(u & 0xffff0000u); }
__device__ __forceinline__ void unpack8(uint4 a, float* v) {
  v[0] = lo16(a.x); v[1] = hi16(a.x); v[2] = lo16(a.y); v[3] = hi16(a.y);
  v[4] = lo16(a.z); v[5] = hi16(a.z); v[6] = lo16(a.w); v[7] = hi16(a.w);
}
__device__ __forceinline__ uint4 pack8(const float* v) {
  uint4 a; a.x = pack2(v[0], v[1]); a.y = pack2(v[2], v[3]); a.z = pack2(v[4], v[5]); a.w = pack2(v[6], v[7]); return a;
}
__device__ __forceinline__ float sigmoidf_(float x) { return __builtin_amdgcn_rcpf(1.f + __expf(-x)); }
__device__ __forceinline__ float siluf_(float x) { return x * __builtin_amdgcn_rcpf(1.f + __expf(-x)); }
__device__ __forceinline__ float geluf_(float x) {
  float u = 1.5957691216057308f * (x + 0.044715f * x * x * x);
  return x * __builtin_amdgcn_rcpf(1.f + __expf(-u));
}
__device__ __forceinline__ float wave_sum(float v) {
#pragma unroll
  for (int o = 32; o >= 1; o >>= 1) v += __shfl_xor(v, o);
  return v;
}
__device__ __forceinline__ int opaque_tid() { int t = threadIdx.x; asm volatile("" : "+v"(t)); return t; }
__device__ __forceinline__ f32x16 mfma32(bf16x8 a, bf16x8 b, f32x16 c) {
  return __builtin_amdgcn_mfma_f32_32x32x16_bf16(a, b, c, 0, 0, 0);
}

struct GStage { u32x4 w0, w1, w2, w3, x0, x1, x2, x3; };
__device__ __forceinline__ void gs_load(GStage& g, const u16* gw, int ldw, const u16* gx, int ldx, int k0) {
  g.w0 = *(const u32x4*)(gw + k0);
  g.w1 = *(const u32x4*)(gw + (size_t)32 * ldw + k0);
  g.w2 = *(const u32x4*)(gw + (size_t)64 * ldw + k0);
  g.w3 = *(const u32x4*)(gw + (size_t)96 * ldw + k0);
  g.x0 = *(const u32x4*)(gx + k0);
  g.x1 = *(const u32x4*)(gx + (size_t)32 * ldx + k0);
  g.x2 = *(const u32x4*)(gx + (size_t)64 * ldx + k0);
  g.x3 = *(const u32x4*)(gx + (size_t)96 * ldx + k0);
}
__device__ __forceinline__ void gs_store(const GStage& g, u16* db, int lo) {
  *(u32x4*)(db + lo) = g.w0;
  *(u32x4*)(db + lo + 32 * LDT) = g.w1;
  *(u32x4*)(db + lo + 64 * LDT) = g.w2;
  *(u32x4*)(db + lo + 96 * LDT) = g.w3;
  *(u32x4*)(db + TILE_U16 + lo) = g.x0;
  *(u32x4*)(db + TILE_U16 + lo + 32 * LDT) = g.x1;
  *(u32x4*)(db + TILE_U16 + lo + 64 * LDT) = g.x2;
  *(u32x4*)(db + TILE_U16 + lo + 96 * LDT) = g.x3;
}
__device__ __forceinline__ void gemm_kstep(const u16* sb, int wn, int wt, int r, int h, f32x16 (&acc)[2][2]) {
  const u16* bw = sb + (wn * 64 + r) * LDT + h * 8;
  const u16* bx = sb + TILE_U16 + (wt * 64 + r) * LDT + h * 8;
  __builtin_amdgcn_s_setprio(1);
#pragma unroll
  for (int ks = 0; ks < 4; ++ks) {
    bf16x8 a0 = *(const bf16x8*)(bw + ks * 16);
    bf16x8 a1 = *(const bf16x8*)(bw + 32 * LDT + ks * 16);
    bf16x8 b0 = *(const bf16x8*)(bx + ks * 16);
    bf16x8 b1 = *(const bf16x8*)(bx + 32 * LDT + ks * 16);
    acc[0][0] = mfma32(a0, b0, acc[0][0]);
    acc[0][1] = mfma32(a0, b1, acc[0][1]);
    acc[1][0] = mfma32(a1, b0, acc[1][0]);
    acc[1][1] = mfma32(a1, b1, acc[1][1]);
  }
  __builtin_amdgcn_s_setprio(0);
}
__device__ __forceinline__ void gemm_tile(const u16* __restrict__ W, int ldw, const u16* __restrict__ X, int ldx,
                                          int K, u16* lds, f32x16 (&acc)[2][2]) {
  const int tid = opaque_tid(), lane = tid & 63, w = tid >> 6, r = lane & 31, h = lane >> 5;
  const int wn = w >> 1, wt = w & 1;
#pragma unroll
  for (int a = 0; a < 2; ++a)
#pragma unroll
    for (int b = 0; b < 2; ++b)
#pragma unroll
      for (int i = 0; i < 16; ++i) acc[a][b][i] = 0.f;
  const int lrow = tid >> 3, lc = tid & 7;
  const u16* gw = W + (size_t)lrow * ldw + lc * 8;
  const u16* gx = X + (size_t)lrow * ldx + lc * 8;
  const int lo = lrow * LDT + lc * 8;
  const int nk = K >> 6;
  GStage A, B;
  gs_load(B, gw, ldw, gx, ldx, 0);
  if (nk > 1) gs_load(A, gw, ldw, gx, ldx, 64);
  gs_store(B, lds, lo);
  __syncthreads();
  for (int kt = 0; kt < nk; kt += 2) {
    if (kt + 2 < nk) gs_load(B, gw, ldw, gx, ldx, (kt + 2) * 64);
    gemm_kstep(lds, wn, wt, r, h, acc);
    if (kt + 1 < nk) gs_store(A, lds + 2 * TILE_U16, lo);
    __syncthreads();
    if (kt + 1 < nk) {
      if (kt + 3 < nk) gs_load(A, gw, ldw, gx, ldx, (kt + 3) * 64);
      gemm_kstep(lds + 2 * TILE_U16, wn, wt, r, h, acc);
      if (kt + 2 < nk) gs_store(B, lds, lo);
      __syncthreads();
    }
  }
}

__device__ __forceinline__ void stage_f32(float* st, f32x16 (&acc)[2][2]) {
  const int tid = opaque_tid(), lane = tid & 63, w = tid >> 6, r = lane & 31, h = lane >> 5;
  const int wn = w >> 1, wt = w & 1;
#pragma unroll
  for (int nb = 0; nb < 2; ++nb)
#pragma unroll
    for (int tb = 0; tb < 2; ++tb) {
      const int token = wt * 64 + tb * 32 + r;
#pragma unroll
      for (int g = 0; g < 4; ++g) {
        const int n0 = wn * 64 + nb * 32 + 8 * g + 4 * h;
        float4 v = make_float4(acc[nb][tb][4 * g], acc[nb][tb][4 * g + 1], acc[nb][tb][4 * g + 2], acc[nb][tb][4 * g + 3]);
        *(float4*)(st + token * 132 + n0) = v;
      }
    }
}
__device__ __forceinline__ void stage_bf16(u16* st, f32x16 (&acc)[2][2]) {
  const int tid = opaque_tid(), lane = tid & 63, w = tid >> 6, r = lane & 31, h = lane >> 5;
  const int wn = w >> 1, wt = w & 1;
#pragma unroll
  for (int nb = 0; nb < 2; ++nb)
#pragma unroll
    for (int tb = 0; tb < 2; ++tb) {
      const int token = wt * 64 + tb * 32 + r;
#pragma unroll
      for (int g = 0; g < 4; ++g) {
        const int n0 = wn * 64 + nb * 32 + 8 * g + 4 * h;
        uint2 v;
        v.x = pack2(acc[nb][tb][4 * g], acc[nb][tb][4 * g + 1]);
        v.y = pack2(acc[nb][tb][4 * g + 2], acc[nb][tb][4 * g + 3]);
        *(uint2*)(st + token * 136 + n0) = v;
      }
    }
}

__device__ void gemm_store_tile(const u16* W, int ldw, const u16* X, int ldx, int K, u16* out, int ldo, u16* lds) {
  f32x16 acc[2][2];
  gemm_tile(W, ldw, X, ldx, K, lds, acc);
  stage_bf16(lds, acc);
  __syncthreads();
  const int tid = opaque_tid();
#pragma unroll
  for (int i = 0; i < 8; ++i) {
    const int id = tid + 256 * i;
    const int row = id >> 4, c = id & 15;
    uint4 v = *(const uint4*)(lds + row * 136 + c * 8);
    *(uint4*)(out + (size_t)row * ldo + c * 8) = v;
  }
  __syncthreads();
}

__device__ void gemm_phase(const u16* __restrict__ Wb, int ldw, const u16* __restrict__ Xb, int ldx, int K,
                           u16* __restrict__ outb, int ldo, int ntn, int ntiles, u16* lds) {
  const int tid = opaque_tid(), lane = tid & 63, w = tid >> 6, r = lane & 31, h = lane >> 5;
  const int wn = w >> 1, wt = w & 1;
  const int lrow = tid >> 3, lc = tid & 7;
  const int lo = lrow * LDT + lc * 8;
  const int nk = K >> 6;
  const int nbl = gridDim.x >> 3;
  const int xl = blockIdx.x & 7, jl = blockIdx.x >> 3;
  const int mt_per = (ntiles / ntn) >> 3;
  const int L = mt_per * ntn;
  int q = jl;
  if (q >= L) return;
#define GP_MT(qq) (xl * mt_per + ((qq) / (8 * ntn)) * 8 + ((qq) % (8 * ntn)) % 8)
#define GP_NT(qq) (((qq) % (8 * ntn)) / 8)
  const u16* gw = Wb + (size_t)(GP_NT(q) * 128 + lrow) * ldw + lc * 8;
  const u16* gx = Xb + (size_t)(GP_MT(q) * 128 + lrow) * ldx + lc * 8;
  GStage A, B;
  gs_load(B, gw, ldw, gx, ldx, 0);
  gs_load(A, gw, ldw, gx, ldx, 64);
  for (; q < L; q += nbl) {
    const int qn = q + nbl;
    const bool has_next = qn < L;
    const int qq = has_next ? qn : q;
    const u16* gwn = Wb + (size_t)(GP_NT(qq) * 128 + lrow) * ldw + lc * 8;
    const u16* gxn = Xb + (size_t)(GP_MT(qq) * 128 + lrow) * ldx + lc * 8;
    f32x16 acc[2][2];
#pragma unroll
    for (int a = 0; a < 2; ++a)
#pragma unroll
      for (int b = 0; b < 2; ++b)
#pragma unroll
        for (int i = 0; i < 16; ++i) acc[a][b][i] = 0.f;
    gs_store(B, lds, lo);
    __syncthreads();
    for (int kt = 0; kt < nk; kt += 2) {
      if (kt + 2 < nk) gs_load(B, gw, ldw, gx, ldx, (kt + 2) * 64);
      else if (has_next) gs_load(B, gwn, ldw, gxn, ldx, 0);
      gemm_kstep(lds, wn, wt, r, h, acc);
      gs_store(A, lds + 2 * TILE_U16, lo);
      __syncthreads();
      if (kt + 3 < nk) gs_load(A, gw, ldw, gx, ldx, (kt + 3) * 64);
      else if (has_next) gs_load(A, gwn, ldw, gxn, ldx, 64);
      gemm_kstep(lds + 2 * TILE_U16, wn, wt, r, h, acc);
      if (kt + 2 < nk) gs_store(B, lds, lo);
      __syncthreads();
    }
    stage_bf16(lds, acc);
    __syncthreads();
    u16* out = outb + (size_t)GP_MT(q) * 128 * ldo + GP_NT(q) * 128;
#pragma unroll
    for (int i = 0; i < 8; ++i) {
      const int id = tid + 256 * i;
      const int row = id >> 4, c = id & 15;
      uint4 v = *(const uint4*)(lds + row * 136 + c * 8);
      *(uint4*)(out + (size_t)row * ldo + c * 8) = v;
    }
    __syncthreads();
    gw = gwn; gx = gxn;
  }
#undef GP_MT
#undef GP_NT
}

__device__ void prep_transpose(const float* __restrict__ src, size_t sstride, int nmat, int R, int C, u16* __restrict__ dst,
                               size_t dstride, int dld, const float* __restrict__ gk, int mode, float* tile, int bid, int nb) {
  const int tid = opaque_tid();
  const int tr = R >> 6, tc = (C + 63) >> 6;
  const int per = tr * tc;
  for (int t = bid; t < per * nmat; t += nb) {
    const int m = t / per, tt = t % per;
    const int r0 = (tt / tc) * 64, c0 = (tt % tc) * 64;
    const float* sm = src + (size_t)m * sstride;
    u16* dm = dst + (size_t)m * dstride;
    __syncthreads();
#pragma unroll
    for (int i = 0; i < 16; ++i) {
      const int rr = i * 4 + (tid >> 6), cc = tid & 63;
      float v = 0.f;
      if (c0 + cc < C) {
        v = sm[(size_t)(r0 + rr) * C + c0 + cc];
        if (gk) v *= gk[m * R + r0 + rr];
      }
      tile[rr * 65 + cc] = v;
    }
    __syncthreads();
#pragma unroll
    for (int i = 0; i < 16; ++i) {
      const int cc = i * 4 + (tid >> 6), rr = tid & 63;
      const int c = c0 + cc;
      if (c < C) {
        const int n = (mode == 1) ? (c / 96) * 128 + (c % 96) : c;
        dm[(size_t)n * dld + r0 + rr] = f2bf(tile[rr * 65 + cc]);
      }
    }
  }
}
__device__ void phase_prep(PP p, float* ldsf) {
  p = launder(p);
  const int bid = blockIdx.x, nb = gridDim.x, tid = opaque_tid();
  const int gtid = bid * 256 + tid, gn = nb * 256;
  if (bid == 0) p->counters[tid] = 0;
  prep_transpose(p->w_in, (size_t)DM * DIN, NLAYER, DM, DIN, p->wInT, (size_t)DINP * DM, DM, nullptr, 0, ldsf, bid, nb);
  prep_transpose(p->w_out, (size_t)DM * DM, NLAYER, DM, DM, p->wOutT, (size_t)DM * DM, DM, nullptr, 0, ldsf, (bid + 256) % nb, nb);
  prep_transpose(p->w_uq, (size_t)192 * 576, NLAYER, 192, 576, p->wUqT, (size_t)768 * 192, 192, p->q_g, 1, ldsf, (bid + 128) % nb, nb);
  prep_transpose(p->w_ukv, (size_t)128 * 768, NLAYER, 128, 768, p->wUkvT, (size_t)768 * 128, 128, p->kv_g, 0, ldsf, (bid + 384) % nb, nb);
  prep_transpose(p->lru_wa, 4096, NLAYER * 6, 64, 64, p->waT, 4096, 64, nullptr, 0, ldsf, (bid + 64) % nb, nb);
  prep_transpose(p->lru_wx, 4096, NLAYER * 6, 64, 64, p->wxT, 4096, 64, nullptr, 0, ldsf, (bid + 192) % nb, nb);
  for (int i = gtid; i < NLAYER * 32 * DM; i += gn) {
    const int l = i / (32 * DM), rem = i % (32 * DM);
    p->wInT[(size_t)l * DINP * DM + (size_t)DIN * DM + rem] = 0;
  }
  for (int i = gtid; i < NLAYER * 6 * 32 * 192; i += gn) {
    const int l = i / (6 * 32 * 192), rem = i % (6 * 32 * 192);
    const int hd = rem / (32 * 192), rem2 = rem % (32 * 192);
    p->wUqT[(size_t)l * 768 * 192 + (size_t)(hd * 128 + 96) * 192 + rem2] = 0;
  }
  for (int i = gtid; i < NLAYER * 4 * 128 * 128; i += gn) {
    const int ii = (i >> 7) & 127, jj = i & 127;
    const float v = (ii >= 64 || jj < 64) ? p->sgu_w[i] : 0.f;
    p->sguW[i] = f2bf(v);
  }
  for (int i = gtid; i < T_TOK * 16; i += gn) {
    const int t = i >> 4, k = i & 15;
    const double rev = (double)p->pos[t] * c_invfreq_rev[k];
    const double fr = rev - __builtin_rint(rev);
    const float f = (float)fr;
    p->tab[i] = make_float2(__builtin_amdgcn_cosf(f), __builtin_amdgcn_sinf(f));
  }
}

typedef __attribute__((ext_vector_type(4))) float f32x4;
__device__ void phase_norm(PP p, int l) {
  p = launder(p);
  const int tid_ = opaque_tid();
  const int lane = tid_ & 63;
  const int gw = blockIdx.x * 4 + (tid_ >> 6), nw = gridDim.x * 4;
  const float* xin = (l <= 1) ? p->x : p->out;
  const float* gpost = p->post_g + (l > 0 ? l - 1 : 0) * DM;
  const float* gpre = p->pre_g + (l < NLAYER ? l : 0) * DM;
  constexpr int NTK = 4;
  for (int tok0 = gw; tok0 < T_TOK; tok0 += NTK * nw) {
    f32x4 xv[NTK][4];
    u32x2 yu[NTK][4];
#pragma unroll
    for (int t = 0; t < NTK; ++t) {
      const int tok = (tok0 + t * nw < T_TOK) ? tok0 + t * nw : tok0;
#pragma unroll
      for (int i = 0; i < 4; ++i) xv[t][i] = __builtin_nontemporal_load((const f32x4*)(xin + (size_t)tok * DM + i * 256 + lane * 4));
    }
    if (l > 0) {
#pragma unroll
      for (int t = 0; t < NTK; ++t) {
        const int tok = (tok0 + t * nw < T_TOK) ? tok0 + t * nw : tok0;
#pragma unroll
        for (int i = 0; i < 4; ++i) yu[t][i] = __builtin_nontemporal_load((const u32x2*)(p->y2 + (size_t)tok * DM + i * 256 + lane * 4));
      }
    }
#pragma unroll
    for (int t = 0; t < NTK; ++t) {
      const int tok = (tok0 + t * nw < T_TOK) ? tok0 + t * nw : tok0;
      if (l > 0) {
        float yv[16];
        float ss = 0.f;
#pragma unroll
        for (int i = 0; i < 4; ++i) {
          yv[4 * i] = lo16(yu[t][i].x); yv[4 * i + 1] = hi16(yu[t][i].x); yv[4 * i + 2] = lo16(yu[t][i].y); yv[4 * i + 3] = hi16(yu[t][i].y);
          ss += yv[4 * i] * yv[4 * i] + yv[4 * i + 1] * yv[4 * i + 1] + yv[4 * i + 2] * yv[4 * i + 2] + yv[4 * i + 3] * yv[4 * i + 3];
        }
        ss = wave_sum(ss);
        const float rs = rsqrtf(ss * (1.f / 1024.f) + EPSF);
#pragma unroll
        for (int i = 0; i < 4; ++i) {
          float4 gv = *(const float4*)(gpost + i * 256 + lane * 4);
          xv[t][i].x += yv[4 * i] * rs * gv.x; xv[t][i].y += yv[4 * i + 1] * rs * gv.y;
          xv[t][i].z += yv[4 * i + 2] * rs * gv.z; xv[t][i].w += yv[4 * i + 3] * rs * gv.w;
        }
      }
      if (l > 0) {
#pragma unroll
        for (int i = 0; i < 4; ++i) __builtin_nontemporal_store(xv[t][i], (f32x4*)(p->out + (size_t)tok * DM + i * 256 + lane * 4));
      }
      if (l < NLAYER) {
        float ss = 0.f;
#pragma unroll
        for (int i = 0; i < 4; ++i) ss += xv[t][i].x * xv[t][i].x + xv[t][i].y * xv[t][i].y + xv[t][i].z * xv[t][i].z + xv[t][i].w * xv[t][i].w;
        ss = wave_sum(ss);
        const float rs = rsqrtf(ss * (1.f / 1024.f) + EPSF);
#pragma unroll
        for (int i = 0; i < 4; ++i) {
          float4 gv = *(const float4*)(gpre + i * 256 + lane * 4);
          uint2 u;
          u.x = pack2(xv[t][i].x * rs * gv.x, xv[t][i].y * rs * gv.y);
          u.y = pack2(xv[t][i].z * rs * gv.z, xv[t][i].w * rs * gv.w);
          *(uint2*)(p->hbuf + (size_t)tok * DM + i * 256 + lane * 4) = u;
        }
      }
    }
  }
}

__device__ void item_q(PP p, int l, int rt, int hd, u16* lds, float* ssm, bool do_rstd) {
  p = launder(p);
  const int tid = opaque_tid();
  const int m0 = rt * 128;
  if (do_rstd) {
    const int row = tid >> 1, half = tid & 1;
    const u16* src = p->proj + (size_t)(m0 + row) * DINP + C_QL + half * 96;
    float ss = 0.f;
#pragma unroll
    for (int i = 0; i < 12; ++i) {
      float v[8]; unpack8(*(const uint4*)(src + i * 8), v);
#pragma unroll
      for (int j = 0; j < 8; ++j) ss += v[j] * v[j];
    }
    ss += __shfl_xor(ss, 1);
    if (half == 0) ssm[row] = rsqrtf(ss * (1.f / 192.f) + EPSF);
  }
  f32x16 acc[2][2];
  gemm_tile(p->wUqT + (size_t)l * 768 * 192 + (size_t)hd * 128 * 192, 192, p->proj + (size_t)m0 * DINP + C_QL, DINP, 192, lds, acc);
  float* st = (float*)lds;
  stage_f32(st, acc);
  __syncthreads();
  const float qscale = 0.10206207261596577f * 1.4426950408889634f;
#pragma unroll
  for (int i = 0; i < 6; ++i) {
    const int u = tid + 256 * i;
    const int row = u / 12, dg = u % 12;
    const float sc = ssm[row] * qscale;
    const float* sr = st + row * 132;
    float o[8];
    if (dg < 8) {
      const float4 a = *(const float4*)(sr + dg * 8), bq = *(const float4*)(sr + dg * 8 + 4);
      o[0] = a.x * sc; o[1] = a.y * sc; o[2] = a.z * sc; o[3] = a.w * sc;
      o[4] = bq.x * sc; o[5] = bq.y * sc; o[6] = bq.z * sc; o[7] = bq.w * sc;
    } else {
      const int i0 = (dg & 1) * 8;
      const float2* tb = p->tab + (size_t)(m0 + row) * 16 + i0;
      const float4 a0 = *(const float4*)(sr + 64 + i0), a1 = *(const float4*)(sr + 68 + i0);
      const float4 b0 = *(const float4*)(sr + 80 + i0), b1 = *(const float4*)(sr + 84 + i0);
      const float x1[8] = {a0.x, a0.y, a0.z, a0.w, a1.x, a1.y, a1.z, a1.w};
      const float x2[8] = {b0.x, b0.y, b0.z, b0.w, b1.x, b1.y, b1.z, b1.w};
      const float4 t0 = *(const float4*)(tb), t1 = *(const float4*)(tb + 2), t2 = *(const float4*)(tb + 4), t3 = *(const float4*)(tb + 6);
      const float cc[8] = {t0.x, t0.z, t1.x, t1.z, t2.x, t2.z, t3.x, t3.z};
      const float sn[8] = {t0.y, t0.w, t1.y, t1.w, t2.y, t2.w, t3.y, t3.w};
      if (dg < 10) {
#pragma unroll
        for (int j = 0; j < 8; ++j) o[j] = (x1[j] * cc[j] - x2[j] * sn[j]) * sc;
      } else {
#pragma unroll
        for (int j = 0; j < 8; ++j) o[j] = (x2[j] * cc[j] + x1[j] * sn[j]) * sc;
      }
    }
    *(uint4*)(p->Q + ((size_t)(m0 + row) * 6 + hd) * 96 + dg * 8) = pack8(o);
  }
  __syncthreads();
}

__device__ void item_kv(PP p, int l, int rt, int hd, u16* lds, float* ssm, bool do_rstd) {
  p = launder(p);
  const int tid = opaque_tid();
  const int m0 = rt * 128;
  if (do_rstd) {
    const int row = tid >> 1, half = tid & 1;
    const u16* src = p->proj + (size_t)(m0 + row) * DINP + C_KVL + half * 64;
    float ss = 0.f;
#pragma unroll
    for (int i = 0; i < 8; ++i) {
      float v[8]; unpack8(*(const uint4*)(src + i * 8), v);
#pragma unroll
      for (int j = 0; j < 8; ++j) ss += v[j] * v[j];
    }
    ss += __shfl_xor(ss, 1);
    if (half == 0) ssm[row] = rsqrtf(ss * (1.f / 128.f) + EPSF);
  }
  f32x16 acc[2][2];
  gemm_tile(p->wUkvT + (size_t)l * 768 * 128 + (size_t)hd * 128 * 128, 128, p->proj + (size_t)m0 * DINP + C_KVL, DINP, 128, lds, acc);
  float* st = (float*)lds;
  stage_f32(st, acc);
  __syncthreads();
  const int kb_ = m0 / SEQ, ks0_ = m0 % SEQ;
#pragma unroll
  for (int i = 0; i < 4; ++i) {
    const int u = tid + 256 * i;
    const int row = u >> 3, dg = u & 7;
    const float sc = ssm[row];
    const float* sr = st + row * 132 + dg * 8;
    float o[8];
    {
      const float4 a = *(const float4*)(sr), bq = *(const float4*)(sr + 4);
      o[0] = a.x * sc; o[1] = a.y * sc; o[2] = a.z * sc; o[3] = a.w * sc;
      o[4] = bq.x * sc; o[5] = bq.y * sc; o[6] = bq.z * sc; o[7] = bq.w * sc;
    }
    *(uint4*)(p->K + ((size_t)(kb_ * 6 + hd) * SEQ + ks0_ + row) * 96 + dg * 8) = pack8(o);
  }
  if (hd == 0) {
#pragma unroll
    for (int i = 0; i < 2; ++i) {
      const int u = tid + 256 * i;
      const int row = u >> 2, dq = u & 3;
      const int i0 = (dq & 1) * 8;
      const u16* kr = p->proj + (size_t)(m0 + row) * DINP + C_KR;
      float x1[8], x2[8], o[8];
      unpack8(*(const uint4*)(kr + i0), x1);
      unpack8(*(const uint4*)(kr + 16 + i0), x2);
      const float2* tb = p->tab + (size_t)(m0 + row) * 16 + i0;
      if (dq < 2) {
#pragma unroll
        for (int j = 0; j < 8; ++j) { float2 cs = tb[j]; o[j] = x1[j] * cs.x - x2[j] * cs.y; }
      } else {
#pragma unroll
        for (int j = 0; j < 8; ++j) { float2 cs = tb[j]; o[j] = x2[j] * cs.x + x1[j] * cs.y; }
      }
      const uint4 ov = pack8(o);
#pragma unroll
      for (int hh2 = 0; hh2 < 6; ++hh2)
        *(uint4*)(p->K + ((size_t)(kb_ * 6 + hh2) * SEQ + ks0_ + row) * 96 + 64 + dq * 8) = ov;
    }
  }
  const int b = m0 / SEQ, s0 = m0 % SEQ;
#pragma unroll
  for (int i = 0; i < 4; ++i) {
    const int u = tid + 256 * i;
    const int dv = u & 63, tg = u >> 6;
    float o[8];
#pragma unroll
    for (int j = 0; j < 8; ++j) o[j] = st[(tg * 8 + j) * 132 + 64 + dv] * ssm[tg * 8 + j];
    u16* vdst = p->VT + (((size_t)(b * 6 + hd) * 128 + (s0 >> 6) + (tg >> 3)) * 64 + dv) * 64 + ((tg & 7) >> 1) * 16 + (tg & 1) * 4;
    uint2 lo2, hi2;
    lo2.x = pack2(o[0], o[1]); lo2.y = pack2(o[2], o[3]);
    hi2.x = pack2(o[4], o[5]); hi2.y = pack2(o[6], o[7]);
    *(uint2*)(vdst) = lo2;
    *(uint2*)(vdst + 8) = hi2;
  }
  __syncthreads();
}

__device__ void item_lru(PP p, int l, int tt, int hd, u16* lds, float* ssm) {
  p = launder(p);
  const int tid = opaque_tid(), lane = tid & 63, w = tid >> 6, r = lane & 31, h = lane >> 5;
  const int t0 = tt * 64;
  const int s0 = t0 % SEQ;
  float* xaf = (float*)lds;
  u16* xcb = lds + 8576;
  float* aarr = (float*)(lds + 8576 + 4608);
  float* barr = aarr + 4096;
  const int c = tid & 63;
  const int cg = hd * 64 + c;
  bf16x8 wfa[4], wfx[4];
  {
    const int cbk_ = w & 1;
    const u16* wa_ = p->waT + (size_t)(l * 6 + hd) * 4096 + (cbk_ * 32 + r) * 64 + h * 8;
    const u16* wx_ = p->wxT + (size_t)(l * 6 + hd) * 4096 + (cbk_ * 32 + r) * 64 + h * 8;
#pragma unroll
    for (int ks = 0; ks < 4; ++ks) { wfa[ks] = *(const bf16x8*)(wa_ + ks * 16); wfx[ks] = *(const bf16x8*)(wx_ + ks * 16); }
  }
  for (int u = tid; u < 67 * 8; u += 256) {
    const int row = u >> 3, c8 = u & 7;
    float v[8];
    if (s0 + row - 3 >= 0) {
      unpack8(*(const uint4*)(p->proj + (size_t)(t0 + row - 3) * DINP + C_XA + hd * 64 + c8 * 8), v);
    } else {
#pragma unroll
      for (int j = 0; j < 8; ++j) v[j] = 0.f;
    }
    *(float4*)(xaf + row * 64 + c8 * 8) = make_float4(v[0], v[1], v[2], v[3]);
    *(float4*)(xaf + row * 64 + c8 * 8 + 4) = make_float4(v[4], v[5], v[6], v[7]);
  }
  __syncthreads();
  const float cw0 = p->conv_w[(l * 4 + 0) * 384 + cg], cw1 = p->conv_w[(l * 4 + 1) * 384 + cg];
  const float cw2 = p->conv_w[(l * 4 + 2) * 384 + cg], cw3 = p->conv_w[(l * 4 + 3) * 384 + cg];
  const float cbias = p->conv_b[l * 384 + cg];
  {
    const int tq = tid >> 6;
    for (int t = tq * 16; t < tq * 16 + 16; ++t) {
      const float xc = cbias + cw0 * xaf[t * 64 + c] + cw1 * xaf[(t + 1) * 64 + c] + cw2 * xaf[(t + 2) * 64 + c] + cw3 * xaf[(t + 3) * 64 + c];
      xcb[t * LDT + c] = f2bf(xc);
    }
  }
  __syncthreads();
  {
    const int tb = w >> 1, cbk = w & 1;
    f32x16 aa, ax;
#pragma unroll
    for (int i = 0; i < 16; ++i) { aa[i] = 0.f; ax[i] = 0.f; }
    const u16* xr = xcb + (tb * 32 + r) * LDT + h * 8;
#pragma unroll
    for (int ks = 0; ks < 4; ++ks) {
      bf16x8 af = *(const bf16x8*)(xr + ks * 16);
      aa = mfma32(af, wfa[ks], aa);
      ax = mfma32(af, wfx[ks], ax);
    }
    const int cc = cbk * 32 + r;
    const int cgl = hd * 64 + cc;
    const float ba = p->lru_ba[l * 384 + cgl], bx = p->lru_bx[l * 384 + cgl];
    const float lam = p->lru_lam[l * 384 + cgl];
    const float nl = -lam;
    const float sp = fmaxf(nl, 0.f) + log1pf(expf(-fabsf(nl)));
#pragma unroll
    for (int reg = 0; reg < 16; ++reg) {
      const int t = tb * 32 + (reg & 3) + 8 * (reg >> 2) + 4 * h;
      const float xc = bf2f(xcb[t * LDT + cc]);
      const float ga = sigmoidf_(aa[reg] + ba);
      const float gx = sigmoidf_(ax[reg] + bx);
      const float la = -8.f * ga * sp;
      const float a = __expf(la);
      const float om = (la > -5e-4f) ? (-2.f * la) * (1.f + la) : (1.f - a * a);
      const float mult = sqrtf(fmaxf(om, 0.f));
      aarr[t * 64 + cc] = a;
      barr[t * 64 + cc] = mult * gx * xc;
    }
  }
  __syncthreads();
  const int seg = tid >> 6;
  u16* h16 = (u16*)aarr;
  u16* c16 = (u16*)barr;
  float pr[16], hr[16];
#pragma unroll
  for (int j = 0; j < 16; ++j) { pr[j] = aarr[(seg * 16 + j) * 64 + c]; hr[j] = barr[(seg * 16 + j) * 64 + c]; }
  {
    float hh = 0.f, P = 1.f;
#pragma unroll
    for (int j = 0; j < 16; ++j) { hh = pr[j] * hh + hr[j]; P *= pr[j]; hr[j] = hh; pr[j] = P; }
    ssm[seg * 64 + c] = P;
    ssm[256 + seg * 64 + c] = hh;
  }
  __syncthreads();
  {
    float Hc = 0.f, Pc = 1.f;
    for (int s2 = 0; s2 < seg; ++s2) {
      const float Ps = ssm[s2 * 64 + c], Hs = ssm[256 + s2 * 64 + c];
      Hc = Ps * Hc + Hs; Pc *= Ps;
    }
    float hl = 0.f, cm = 1.f;
#pragma unroll
    for (int j = 0; j < 16; ++j) {
      hl = hr[j] + pr[j] * Hc;
      cm = pr[j] * Pc;
      h16[(seg * 16 + j) * 64 + c] = f2bf(hl);
      c16[(seg * 16 + j) * 64 + c] = f2bf(cm);
    }
    if (seg == 3) {
      p->Htile[(size_t)tt * 384 + cg] = hl;
      p->Ptile[(size_t)tt * 384 + cg] = cm;
    }
  }
  __syncthreads();
#pragma unroll
  for (int i = 0; i < 2; ++i) {
    const int id = tid + 256 * i;
    const int row = id >> 3, c8 = id & 7;
    const uint4 hv = *(const uint4*)(h16 + row * 64 + c8 * 8);
    const uint4 cv = *(const uint4*)(c16 + row * 64 + c8 * 8);
    *(uint4*)(p->hloc + (size_t)(t0 + row) * 384 + hd * 64 + c8 * 8) = hv;
    *(uint4*)(p->cum + (size_t)(t0 + row) * 384 + hd * 64 + c8 * 8) = cv;
  }
  __syncthreads();
}

__device__ void item_sgu(PP p, int l, int nbk, u16* lds, float* ssm) {
  p = launder(p);
  const int tid = opaque_tid(), lane = tid & 63, w = tid >> 6, r = lane & 31, h = lane >> 5;
  const int m0 = nbk * 128;
  {
    const int row = tid >> 1, half = tid & 1;
    const u16* src = p->proj + (size_t)(m0 + row) * DINP + C_V + half * 128;
    float s1 = 0.f, s2 = 0.f;
#pragma unroll
    for (int i = 0; i < 16; ++i) {
      float v[8]; unpack8(*(const uint4*)(src + i * 8), v);
#pragma unroll
      for (int j = 0; j < 8; ++j) { const float gq = geluf_(v[j]); s1 += gq; s2 += gq * gq; }
    }
    s1 += __shfl_xor(s1, 1); s2 += __shfl_xor(s2, 1);
    if (half == 0) {
      const float mu = s1 * (1.f / 256.f);
      const float var = fmaxf(s2 * (1.f / 256.f) - mu * mu, 0.f);
      ssm[row] = mu; ssm[128 + row] = rsqrtf(var + EPSF);
    }
  }
  u16* vbT = lds;
  for (int g = 0; g < 4; ++g) {
    __syncthreads();
    {
      const int j = tid & 127, chalf = tid >> 7;
      const float mu = ssm[j], rs = ssm[128 + j];
      const u16* src = p->proj + (size_t)(m0 + j) * DINP + C_V + g * 64 + chalf * 32;
      const float* lg = p->sgu_g + l * 256 + g * 64 + chalf * 32;
      const float* lb = p->sgu_bn + l * 256 + g * 64 + chalf * 32;
#pragma unroll
      for (int i = 0; i < 4; ++i) {
        float v[8]; unpack8(*(const uint4*)(src + i * 8), v);
#pragma unroll
        for (int q = 0; q < 8; ++q) {
          const int cc = chalf * 32 + i * 8 + q;
          const float val = (geluf_(v[q]) - mu) * rs * lg[i * 8 + q] + lb[i * 8 + q];
          vbT[cc * 136 + j] = f2bf(val);
        }
      }
    }
    __syncthreads();
    f32x16 a0, a1;
#pragma unroll
    for (int i = 0; i < 16; ++i) { a0[i] = 0.f; a1[i] = 0.f; }
    const u16* wr = p->sguW + ((size_t)(l * 4 + g) * 128 + w * 32 + r) * 128 + h * 8;
    const u16* v0 = vbT + r * 136 + h * 8;
    const u16* v1 = vbT + (32 + r) * 136 + h * 8;
    const int nks = (w < 2) ? 4 : 8;
    for (int ks = 0; ks < nks; ++ks) {
      bf16x8 af = *(const bf16x8*)(wr + ks * 16);
      bf16x8 b0 = *(const bf16x8*)(v0 + ks * 16);
      bf16x8 b1 = *(const bf16x8*)(v1 + ks * 16);
      a0 = mfma32(af, b0, a0);
      a1 = mfma32(af, b1, a1);
    }
    float* stg = (float*)(lds + 8704);
#pragma unroll
    for (int reg = 0; reg < 16; ++reg) {
      const int i = w * 32 + (reg & 3) + 8 * (reg >> 2) + 4 * h;
      const float bsv = p->sgu_b[(l * 4 + g) * 128 + i];
      stg[i * 68 + r] = a0[reg] + bsv;
      stg[i * 68 + 32 + r] = a1[reg] + bsv;
    }
    __syncthreads();
#pragma unroll
    for (int k = 0; k < 4; ++k) {
      const int u = tid + 256 * k;
      const int i = u >> 3, c8 = u & 7;
      const size_t tok = (size_t)(m0 + i);
      const int ch = g * 64 + c8 * 8;
      const float4 m0v = *(const float4*)(stg + i * 68 + c8 * 8), m1v = *(const float4*)(stg + i * 68 + c8 * 8 + 4);
      const float mx[8] = {m0v.x, m0v.y, m0v.z, m0v.w, m1v.x, m1v.y, m1v.z, m1v.w};
      float uu[8], gcv[8], o[8];
      unpack8(*(const uint4*)(p->proj + tok * DINP + C_U + ch), uu);
      unpack8(*(const uint4*)(p->proj + tok * DINP + C_GC + ch), gcv);
#pragma unroll
      for (int q = 0; q < 8; ++q) o[q] = geluf_(uu[q]) * mx[q] * siluf_(gcv[q]);
      *(uint4*)(p->ycpre + tok * 256 + ch) = pack8(o);
    }
  }
  __syncthreads();
}

__device__ void item_carry(PP p, int ci) {
  p = launder(p);
  const int idx = ci * 256 + opaque_tid();
  const int b = idx / 384, c = idx % 384;
  float carry = 0.f;
  for (int tt = 0; tt < 128; ++tt) {
    const size_t o = (size_t)(b * 128 + tt) * 384 + c;
    p->carry[o] = carry;
    carry = p->Ptile[o] * carry + p->Htile[o];
  }
}

#define KLD 104
#define VLD 72
#define ATT_STAGE (64 * KLD + 64 * VLD)
struct AStage { u32x4 k0, k1, k2, v0, v1; };
__device__ __forceinline__ void as_load(AStage& g, const u16* kg, const u16* vg, int kt) {
  const u16* kp = kg + (size_t)kt * 6144;
  g.k0 = *(const u32x4*)(kp); g.k1 = *(const u32x4*)(kp + 2048); g.k2 = *(const u32x4*)(kp + 4096);
  const u16* vp = vg + (size_t)kt * 4096;
  g.v0 = *(const u32x4*)(vp); g.v1 = *(const u32x4*)(vp + 2048);
#ifdef DUP_LOADS
  {
    u32x4 t0 = *(const volatile u32x4*)(kp), t1 = *(const volatile u32x4*)(kp + 2048), t2 = *(const volatile u32x4*)(kp + 4096);
    u32x4 t3 = *(const volatile u32x4*)(vp), t4 = *(const volatile u32x4*)(vp + 2048);
    asm volatile("" :: "v"(t0), "v"(t1), "v"(t2), "v"(t3), "v"(t4));
  }
#endif
}
__device__ __forceinline__ void as_store(const AStage& g, u16* db, int kl0, int kl1, int kl2, int vl) {
  *(u32x4*)(db + kl0) = g.k0; *(u32x4*)(db + kl1) = g.k1; *(u32x4*)(db + kl2) = g.k2;
  *(u32x4*)(db + vl) = g.v0; *(u32x4*)(db + vl + 32 * VLD) = g.v1;
}
__device__ __forceinline__ float max3f(float a, float b, float c) {
  float d; asm("v_max3_f32 %0, %1, %2, %3" : "=v"(d) : "v"(a), "v"(b), "v"(c)); return d;
}
__device__ __forceinline__ bf16x8 pack_p(const f32x16& s, int o) {
  u32x4 pu;
  pu.x = pack2(s[o + 0], s[o + 1]); pu.y = pack2(s[o + 2], s[o + 3]);
  pu.z = pack2(s[o + 4], s[o + 5]); pu.w = pack2(s[o + 6], s[o + 7]);
  return __builtin_bit_cast(bf16x8, pu);
}
__device__ __forceinline__ void attn_qk(const u16* kp, const bf16x8 (&qa)[6], f32x16& s0, f32x16& s1) {
#pragma unroll
  for (int ks = 0; ks < 6; ++ks) {
    bf16x8 k0 = *(const bf16x8*)(kp + ks * 16);
    bf16x8 k1 = *(const bf16x8*)(kp + 32 * KLD + ks * 16);
    s0 = mfma32(k0, qa[ks], s0);
    s1 = mfma32(k1, qa[ks], s1);
  }
}
__device__ __forceinline__ void attn_tile(const u16* sb, const bf16x8 (&qa)[6], f32x16& o0, f32x16& o1, f32x16& lacc,
                                          float& m, bool& mz, int r, int h, bool first) {
  const u16* kp = sb + r * KLD + h * 8;
  f32x16 s0, s1;
  __builtin_amdgcn_s_setprio(1);
  if (mz) {
#pragma unroll
    for (int i = 0; i < 16; ++i) { s0[i] = 0.f; s1[i] = 0.f; }
    attn_qk(kp, qa, s0, s1);
  } else {
#pragma unroll
    for (int i = 0; i < 16; ++i) { s0[i] = -m; s1[i] = -m; }
    attn_qk(kp, qa, s0, s1);
  }
  __builtin_amdgcn_s_setprio(0);
  float mxa = max3f(s0[0], s0[1], s0[2]), mxb = max3f(s0[3], s0[4], s0[5]);
  float mxc = max3f(s0[6], s0[7], s0[8]), mxd = max3f(s0[9], s0[10], s0[11]);
  mxa = max3f(mxa, s0[12], s0[13]); mxb = max3f(mxb, s0[14], s0[15]);
  mxc = max3f(mxc, s1[0], s1[1]); mxd = max3f(mxd, s1[2], s1[3]);
  mxa = max3f(mxa, s1[4], s1[5]); mxb = max3f(mxb, s1[6], s1[7]);
  mxc = max3f(mxc, s1[8], s1[9]); mxd = max3f(mxd, s1[10], s1[11]);
  mxa = max3f(mxa, s1[12], s1[13]); mxb = max3f(mxb, s1[14], s1[15]);
  const float lm = max3f(mxa, mxb, fmaxf(mxc, mxd));
  bool slow;
  if (first) {
    const float mx = fmaxf(lm, __shfl_xor(lm, 32));
    slow = __any(mx > 30.f || mx < -30.f);
  } else {
    slow = __any(lm > 30.f);
  }
  if (slow) {
    const float mx = fmaxf(lm, __shfl_xor(lm, 32));
    const float d = first ? mx : fmaxf(mx, 0.f);
    const float alpha = first ? 1.f : __builtin_amdgcn_exp2f(-d);
    m += d;
    mz = false;
#pragma unroll
    for (int i = 0; i < 16; ++i) { s0[i] -= d; s1[i] -= d; o0[i] *= alpha; o1[i] *= alpha; }
    lacc[0] *= alpha;
  }
  float pa = 0.f, pb = 0.f, pc = 0.f, pd = 0.f;
#pragma unroll
  for (int i = 0; i < 16; ++i) {
    s0[i] = __builtin_amdgcn_exp2f(s0[i]); s1[i] = __builtin_amdgcn_exp2f(s1[i]);
    if ((i & 3) == 0) pa += s0[i] + s1[i];
    else if ((i & 3) == 1) pb += s0[i] + s1[i];
    else if ((i & 3) == 2) pc += s0[i] + s1[i];
    else pd += s0[i] + s1[i];
  }
  lacc[0] += (pa + pb) + (pc + pd);
  const u16* vp = sb + 64 * KLD + r * VLD + 8 * h;
  __builtin_amdgcn_s_setprio(1);
#pragma unroll
  for (int kb = 0; kb < 2; ++kb) {
#pragma unroll
    for (int s = 0; s < 2; ++s) {
      const bf16x8 pf = pack_p(kb == 0 ? s0 : s1, 8 * s);
      const int koff = kb * 32 + 16 * s;
      const bf16x8 v0 = *(const bf16x8*)(vp + koff);
      const bf16x8 v1 = *(const bf16x8*)(vp + 32 * VLD + koff);
      o0 = mfma32(v0, pf, o0);
      o1 = mfma32(v1, pf, o1);
    }
  }
  __builtin_amdgcn_s_setprio(0);
}
__device__ __forceinline__ void attn_write_o(u16* op, const f32x16& o0, const f32x16& o1, float inv) {
#pragma unroll
  for (int g = 0; g < 4; ++g) {
    uint2 v;
    v.x = pack2(o0[4 * g] * inv, o0[4 * g + 1] * inv); v.y = pack2(o0[4 * g + 2] * inv, o0[4 * g + 3] * inv);
    *(uint2*)(op + 8 * g) = v;
    v.x = pack2(o1[4 * g] * inv, o1[4 * g + 1] * inv); v.y = pack2(o1[4 * g + 2] * inv, o1[4 * g + 3] * inv);
    *(uint2*)(op + 32 + 8 * g) = v;
  }
}

__device__ void item_attn(PP p, int qb, int b, int hh, u16* lds) {
  p = launder(p);
  const int tid = opaque_tid(), lane = tid & 63, w = tid >> 6, r = lane & 31, h = lane >> 5;
  const size_t tokbase = (size_t)b * SEQ;
  const int q0 = qb * 128 + w * 32;
  bf16x8 qa[6];
  {
    const u16* qp = p->Q + ((tokbase + q0 + r) * 6 + hh) * 96 + h * 8;
#pragma unroll
    for (int ks = 0; ks < 6; ++ks) qa[ks] = *(const bf16x8*)(qp + ks * 16);
  }
  f32x16 oa0, oa1, lacc;
#pragma unroll
  for (int i = 0; i < 16; ++i) { oa0[i] = 0.f; oa1[i] = 0.f; lacc[i] = 0.f; }
  float ma = 0.f;
  bool mz = true;
  const int ntiles = 2 * qb + 2;
  const int my_ntiles = 2 * qb + 1 + (w >> 1);
  const u16* kg = p->K + (size_t)(b * 6 + hh) * SEQ * 96 + tid * 8;
  const u16* vg = p->VT + (size_t)(b * 6 + hh) * SEQ * 64 + tid * 8;
  const int id1 = tid + 256, id2 = tid + 512;
  const int kl0 = (tid / 12) * KLD + (tid % 12) * 8;
  const int kl1 = (id1 / 12) * KLD + (id1 % 12) * 8;
  const int kl2 = (id2 / 12) * KLD + (id2 % 12) * 8;
  const int vl = 64 * KLD + (tid >> 3) * VLD + (tid & 7) * 8;
  AStage A, B;
  as_load(B, kg, vg, 0);
  as_load(A, kg, vg, 1);
  as_store(B, lds, kl0, kl1, kl2, vl);
  __syncthreads();
  for (int kt = 0; kt < ntiles; kt += 2) {
    if (kt + 2 < ntiles) as_load(B, kg, vg, kt + 2);
    attn_tile(lds, qa, oa0, oa1, lacc, ma, mz, r, h, kt == 0);
    as_store(A, lds + ATT_STAGE, kl0, kl1, kl2, vl);
    __syncthreads();
    if (kt + 3 < ntiles) as_load(A, kg, vg, kt + 3);
    if (kt + 1 < my_ntiles) attn_tile(lds + ATT_STAGE, qa, oa0, oa1, lacc, ma, mz, r, h, false);
    if (kt + 2 < ntiles) as_store(B, lds, kl0, kl1, kl2, vl);
    __syncthreads();
  }
  const float lta = lacc[0] + __shfl_xor(lacc[0], 32);
  u16* op = p->obuf + (tokbase + q0 + r) * 384 + hh * 64 + 4 * h;
  attn_write_o(op, oa0, oa1, 1.f / lta);
}

__device__ void phase_y(PP p, int l) {
  p = launder(p);
  const int tid_ = opaque_tid();
  const int lane = tid_ & 63;
  const int gw = blockIdx.x * 4 + (tid_ >> 6), nw = gridDim.x * 4;
  const float* bg = p->br_g + l * DM + lane * 16;
  const int seg = (lane < 24) ? 0 : (lane < 48) ? 1 : 2;
  const u16* xbase; const u16* gbase; size_t xs, gs;
  if (seg == 0) { xbase = p->hloc + lane * 16; xs = 384; gbase = p->proj + C_GA + lane * 16; gs = DINP; }
  else if (seg == 1) { xbase = p->obuf + (lane - 24) * 16; xs = 384; gbase = p->proj + C_GB + (lane - 24) * 16; gs = DINP; }
  else { xbase = p->ycpre + (lane - 48) * 16; xs = 256; gbase = xbase; gs = 256; }
  for (int tok0 = gw; tok0 < T_TOK; tok0 += 2 * nw) {
    const int tok1 = (tok0 + nw < T_TOK) ? tok0 + nw : tok0;
    uint4 xr[2][2], gr[2][2], cr_[2][2];
    float4 cy[2][4];
#pragma unroll
    for (int t = 0; t < 2; ++t) {
      const size_t tok = (size_t)(t ? tok1 : tok0);
      xr[t][0] = *(const uint4*)(xbase + tok * xs); xr[t][1] = *(const uint4*)(xbase + tok * xs + 8);
      gr[t][0] = *(const uint4*)(gbase + tok * gs); gr[t][1] = *(const uint4*)(gbase + tok * gs + 8);
    }
    if (seg == 0) {
#pragma unroll
      for (int t = 0; t < 2; ++t) {
        const size_t tok = (size_t)(t ? tok1 : tok0);
        cr_[t][0] = *(const uint4*)(p->cum + tok * 384 + lane * 16); cr_[t][1] = *(const uint4*)(p->cum + tok * 384 + lane * 16 + 8);
        const float* cp = p->carry + (tok >> 6) * 384 + lane * 16;
#pragma unroll
        for (int i = 0; i < 4; ++i) cy[t][i] = *(const float4*)(cp + 4 * i);
      }
    }
#pragma unroll
    for (int t = 0; t < 2; ++t) {
      const size_t tok = (size_t)(t ? tok1 : tok0);
      float v[16], g[16];
      unpack8(xr[t][0], v); unpack8(xr[t][1], v + 8);
      unpack8(gr[t][0], g); unpack8(gr[t][1], g + 8);
      if (seg == 0) {
        float cm[16];
        unpack8(cr_[t][0], cm); unpack8(cr_[t][1], cm + 8);
#pragma unroll
        for (int i = 0; i < 4; ++i) {
          v[4 * i] += cm[4 * i] * cy[t][i].x; v[4 * i + 1] += cm[4 * i + 1] * cy[t][i].y;
          v[4 * i + 2] += cm[4 * i + 2] * cy[t][i].z; v[4 * i + 3] += cm[4 * i + 3] * cy[t][i].w;
        }
      }
      if (seg < 2) {
#pragma unroll
        for (int j = 0; j < 16; ++j) v[j] *= siluf_(g[j]);
      }
      float ss = 0.f;
#pragma unroll
      for (int j = 0; j < 16; ++j) ss += v[j] * v[j];
      const float sa = wave_sum(seg == 0 ? ss : 0.f);
      const float sb = wave_sum(seg == 1 ? ss : 0.f);
      const float sc = wave_sum(seg == 2 ? ss : 0.f);
      const float rs = (seg == 0) ? rsqrtf(sa * (1.f / 384.f) + EPSF)
                     : (seg == 1) ? rsqrtf(sb * (1.f / 384.f) + EPSF) : rsqrtf(sc * (1.f / 256.f) + EPSF);
      float o[16];
#pragma unroll
      for (int j = 0; j < 16; ++j) o[j] = v[j] * rs * bg[j];
      *(uint4*)(p->hbuf + tok * DM + lane * 16) = pack8(o);
      *(uint4*)(p->hbuf + tok * DM + lane * 16 + 8) = pack8(o + 8);
    }
  }
}

__device__ __forceinline__ int next_item(int* counter, int* slot) {
  __syncthreads();
  if (threadIdx.x == 0) *slot = atomicAdd(counter, 1);
  __syncthreads();
  return *slot;
}


#define XB_TMO      128
#define XB_XCNT(j)  (256  + 64 * (j))
#define XB_XSUB(j)  (1280 + 64 * (j))
#define XB_XGEN(j)  (2304 + 64 * (j))
#define XB_TOP      3328
#define XB_TOPGEN   3392
#define XCD_BAR_WORDS 3456
#define XB_SPIN_CAP (1u << 18)
#define LAS __attribute__((address_space(3)))
__device__ __forceinline__ unsigned xb_ld(unsigned* p)              { return __hip_atomic_load(p, __ATOMIC_RELAXED, __HIP_MEMORY_SCOPE_AGENT); }
__device__ __forceinline__ unsigned xb_add(unsigned* p, unsigned v) { return __hip_atomic_fetch_add(p, v, __ATOMIC_RELAXED, __HIP_MEMORY_SCOPE_AGENT); }
__device__ __forceinline__ unsigned xb_xcc_id() { return (unsigned)__builtin_amdgcn_s_getreg((3 << 11) | 20) & 0xFu; }
#define XB_SPIN(cond, bar) do { unsigned _sp = 0; while (cond) { __builtin_amdgcn_s_sleep(1); \
    if ((++_sp & 255u) == 0u) { if (xb_ld(&(bar)[XB_TMO])) break; if (_sp > XB_SPIN_CAP) { atomicAdd(&(bar)[XB_TMO], 1u); break; } } } } while (0)
struct XcdBarrier { unsigned* bar; unsigned x; volatile LAS unsigned* st; };
__device__ __forceinline__ XcdBarrier xcd_barrier_post(unsigned* bar, volatile LAS unsigned* st) {
    XcdBarrier b; b.bar = bar; b.x = xb_xcc_id(); b.st = st;
    if (threadIdx.x == 0) (void)xb_add(&bar[XB_XCNT(b.x)], 1u);
    return b;
}
__device__ __forceinline__ void xcd_barrier_complete(unsigned* bar, unsigned x, unsigned& nloc, unsigned& nx) {
    const unsigned G = gridDim.x * gridDim.y * gridDim.z;
    unsigned sum, cnt, mine, sp = 0u;
    for (;;) {
        sum = 0u; cnt = 0u; mine = 0u;
#pragma unroll
        for (unsigned j = 0; j < 16; ++j) { const unsigned c = xb_ld(&bar[XB_XCNT(j)]); sum += c; cnt += (c > 0u) ? 1u : 0u; mine = (j == x) ? c : mine; }
        if (sum == G) break;
        __builtin_amdgcn_s_sleep(1);
        if ((++sp & 255u) == 0u) { if (xb_ld(&bar[XB_TMO])) break; if (sp > XB_SPIN_CAP) { atomicAdd(&bar[XB_TMO], 1u); break; } }
    }
    nloc = mine > 0u ? mine : 1u; nx = cnt > 0u ? cnt : 1u;
}
__device__ __forceinline__ void xcd_barrier(const XcdBarrier& b) {
    asm volatile("s_waitcnt vmcnt(0)" ::: "memory");
    __syncthreads();
    if (threadIdx.x == 0) {
        unsigned* bar = b.bar;
        __builtin_amdgcn_s_waitcnt(0);
        unsigned nloc = b.st[0], nx = b.st[1];
        if (nloc == 0u) { xcd_barrier_complete(bar, b.x, nloc, nx); b.st[0] = nloc; b.st[1] = nx; }
        const unsigned old = xb_add(&bar[XB_XSUB(b.x)], 1u);
        const unsigned gen = old / nloc;
        if (old + 1u == (gen + 1u) * nloc) {
            __builtin_amdgcn_fence(__ATOMIC_RELEASE, "agent");
            asm volatile("s_waitcnt vmcnt(0)" ::: "memory");
            const unsigned og = xb_add(&bar[XB_TOP], 1u);
            const unsigned tg = og / nx;
            if (og + 1u == (tg + 1u) * nx) xb_add(&bar[XB_TOPGEN], 1u);
            else XB_SPIN(xb_ld(&bar[XB_TOPGEN]) == tg, bar);
            __builtin_amdgcn_fence(__ATOMIC_ACQUIRE, "agent");
            xb_add(&bar[XB_XGEN(b.x)], 1u);
            asm volatile("s_waitcnt vmcnt(0)" ::: "memory");
        } else {
            XB_SPIN(xb_ld(&bar[XB_XGEN(b.x)]) == gen, bar);
            __builtin_amdgcn_fence(__ATOMIC_ACQUIRE, "agent");
            asm volatile("s_waitcnt vmcnt(0)" ::: "memory");
        }
    }
    __syncthreads();
}

#define N_PHASES (1 + 6 * NLAYER + 1)

__device__ void run_phase(PP p, int ph, u16* lds, float* ssm, int* slot, int rep) {
  int l = (ph - 1) / 6, sub = (ph - 1) % 6 + 1;
  if (ph == 0) { sub = 0; l = 0; }
  if (ph == N_PHASES - 1) { sub = 1; l = NLAYER; }
#ifdef ONLYSUB
  sub = ONLYSUB;
#endif
  const int bid = blockIdx.x, nb = gridDim.x;
  if (sub == 0) { phase_prep(p, (float*)lds); return; }
  if (sub == 1) { phase_norm(p, l); return; }
  if (sub == 2) {
    gemm_phase(p->wInT + (size_t)l * DINP * DM, DM, p->hbuf, DM, DM, p->proj, DINP, 18, 256 * 18, lds);
    return;
  }
  if (sub == 3) {
    int* ctr = p->counters + l * 16 + rep * 64;
    for (;;) {
      int it = next_item(ctr, slot);
      if (it >= 256 + 512 + 512 + 3072) break;
      if (it < 256) item_sgu(p, l, it, lds, ssm);
      else if (it < 256 + 512) {
        const int k = it - 256; const int rt = k >> 1, hp = (k & 1) * 3;
#pragma unroll 1
        for (int h2 = 0; h2 < 3; ++h2) item_q(p, l, rt, hp + h2, lds, ssm, h2 == 0);
      } else if (it < 256 + 1024) {
        const int k = it - 256 - 512; const int rt = k >> 1, hp = (k & 1) * 3;
#pragma unroll 1
        for (int h2 = 0; h2 < 3; ++h2) item_kv(p, l, rt, hp + h2, lds, ssm, h2 == 0);
      } else { const int k = it - 256 - 1024; item_lru(p, l, k / 6, k % 6, lds, ssm); }
    }
    return;
  }
  if (sub == 4) {
    if (bid < 6) item_carry(p, bid);
    const int xq = (int)(xb_xcc_id() & 7u);
    int* cbase = p->counters + l * 16 + 8 + rep * 64;
    for (;;) {
      __syncthreads();
      if (threadIdx.x == 0) {
        int got = -1;
        for (int dq = 0; dq < 8 && got < 0; ++dq) {
          const int q = (xq + dq) & 7;
          if (__hip_atomic_load(cbase + q, __ATOMIC_RELAXED, __HIP_MEMORY_SCOPE_AGENT) < 192) {
            const int it = atomicAdd(cbase + q, 1);
            if (it < 192) got = q * 256 + it;
          }
        }
        *slot = got;
      }
      __syncthreads();
      const int got = *slot;
      if (got < 0) break;
      const int q = got >> 8, it = got & 255;
      int qb, bh;
      if (it < 64) { qb = 63 - it; bh = q * 3; }
      else { const int j = it - 64; qb = 63 - (j >> 1); bh = q * 3 + 1 + (j & 1); }
      item_attn(p, qb, bh / 6, bh % 6, lds);
    }
    return;
  }
  if (sub == 5) { phase_y(p, l); return; }
  gemm_phase(p->wOutT + (size_t)l * DM * DM, DM, p->hbuf, DM, DM, p->y2, DM, 8, 256 * 8, lds);
}

__global__ void __launch_bounds__(256, 2) mega_kernel(Params p, int ph_begin, int ph_end) {
  __shared__ __attribute__((aligned(16))) unsigned char lds_raw[LDS_BYTES];
  __shared__ float ssm[512];
  __shared__ int slot;
  u16* lds = (u16*)lds_raw;
  PP pp = (PP)__builtin_amdgcn_kernarg_segment_ptr();
#if COOP
  cg::grid_group grid = cg::this_grid();
  __shared__ uint4 xb_words;
  if (threadIdx.x == 0) xb_words = make_uint4(0u, 0u, 0u, 0u);
  __syncthreads();
  XcdBarrier xb = xcd_barrier_post(pp->bar, (volatile LAS unsigned*)&xb_words);
#endif
  int rep = 0;
  for (int ph = ph_begin; ph < ph_end;) {
    run_phase(launder(pp), ph, lds, ssm, &slot, rep);
    bool again = false;
#if COOP
#ifdef REPEAT_SUB
    if (ph > 0 && ph < N_PHASES - 1) {
      if (REPEAT_SUB == 99) { xcd_barrier(xb); xcd_barrier(xb); xcd_barrier(xb); xcd_barrier(xb); }
      else if (((ph - 1) % 6 + 1) == REPEAT_SUB && rep == 0) again = true;
    }
#endif
    if (again || ph + 1 < ph_end) {
      if (ph_end > 1000) grid.sync();
      xcd_barrier(xb);
    }
#endif
    if (again) rep = 1; else { rep = 0; ++ph; }
  }
}

extern "C" void kernel_launch(void* const* d_in, const int* in_sizes, int n_in, void* d_out, int out_size, void* d_ws,
                              size_t ws_size, hipStream_t stream) {
  Params p{};
  p.x = (const float*)d_in[0]; p.pos = (const int*)d_in[1]; p.pre_g = (const float*)d_in[2]; p.w_in = (const float*)d_in[3];
  p.conv_w = (const float*)d_in[4]; p.conv_b = (const float*)d_in[5]; p.lru_wa = (const float*)d_in[6]; p.lru_ba = (const float*)d_in[7];
  p.lru_wx = (const float*)d_in[8]; p.lru_bx = (const float*)d_in[9]; p.lru_lam = (const float*)d_in[10]; p.q_g = (const float*)d_in[11];
  p.w_uq = (const float*)d_in[12]; p.kv_g = (const float*)d_in[13]; p.w_ukv = (const float*)d_in[14]; p.sgu_g = (const float*)d_in[15];
  p.sgu_bn = (const float*)d_in[16]; p.sgu_w = (const float*)d_in[17]; p.sgu_b = (const float*)d_in[18]; p.br_g = (const float*)d_in[19];
  p.w_out = (const float*)d_in[20]; p.post_g = (const float*)d_in[21];
  p.out = (float*)d_out;
  unsigned char* ws = (unsigned char*)d_ws;
  size_t off = 0;
  auto take = [&](size_t bytes) { unsigned char* q = ws + off; off += (bytes + 255) & ~(size_t)255; return q; };
  p.counters = (int*)take(1024);
  p.bar = (unsigned*)take(XCD_BAR_WORDS * 4);
  p.wInT = (u16*)take((size_t)NLAYER * DINP * DM * 2);
  p.wOutT = (u16*)take((size_t)NLAYER * DM * DM * 2);
  p.wUqT = (u16*)take((size_t)NLAYER * 768 * 192 * 2);
  p.wUkvT = (u16*)take((size_t)NLAYER * 768 * 128 * 2);
  p.waT = (u16*)take((size_t)NLAYER * 6 * 4096 * 2);
  p.wxT = (u16*)take((size_t)NLAYER * 6 * 4096 * 2);
  p.sguW = (u16*)take((size_t)NLAYER * 4 * 128 * 128 * 2);
  p.tab = (float2*)take((size_t)T_TOK * 16 * 8);
  p.hbuf = (u16*)take((size_t)T_TOK * DM * 2);
  p.proj = (u16*)take((size_t)T_TOK * DINP * 2);
  p.y2 = (u16*)take((size_t)T_TOK * DM * 2);
  p.Q = (u16*)take((size_t)T_TOK * 576 * 2);
  p.K = (u16*)take((size_t)T_TOK * 576 * 2);
  p.VT = (u16*)take((size_t)T_TOK * 384 * 2);
  p.hloc = (u16*)take((size_t)T_TOK * 384 * 2);
  p.cum = (u16*)take((size_t)T_TOK * 384 * 2);
  p.Ptile = (float*)take((size_t)512 * 384 * 4);
  p.Htile = (float*)take((size_t)512 * 384 * 4);
  p.carry = (float*)take((size_t)512 * 384 * 4);
  p.obuf = (u16*)take((size_t)T_TOK * 384 * 2);
  p.ycpre = (u16*)take((size_t)T_TOK * 256 * 2);
  if (off > ws_size) { fprintf(stderr, "workspace too small: need %zu have %zu\n", off, ws_size); return; }

  static int grid_blocks = 0;
  if (!grid_blocks) {
    int dev = 0, cus = 0, per_cu = 0;
    hipGetDevice(&dev);
    hipDeviceGetAttribute(&cus, hipDeviceAttributeMultiprocessorCount, dev);
    hipOccupancyMaxActiveBlocksPerMultiprocessor(&per_cu, mega_kernel, 256, 0);
    if (per_cu > 2) per_cu = 2;
    if (per_cu < 1) per_cu = 1;
    grid_blocks = cus * per_cu;
  }
#if COOP
  (void)hipMemsetAsync(d_ws, 0, 1024 + ((XCD_BAR_WORDS * 4 + 255) & ~255), stream);
  int pb = 0, pe = N_PHASES;
  void* args[] = {&p, &pb, &pe};
  hipError_t e = hipLaunchCooperativeKernel((void*)mega_kernel, dim3(grid_blocks), dim3(256), args, 0, stream);
  if (e != hipSuccess) fprintf(stderr, "cooperative launch failed: %s (grid %d)\n", hipGetErrorString(e), grid_blocks);
#else
  for (int ph = 0; ph < N_PHASES; ++ph) mega_kernel<<<grid_blocks, 256, 0, stream>>>(p, ph, ph + 1);
#endif
}
```

```cpp
#include <hip/hip_runtime.h>
#include <hip/hip_cooperative_groups.h>
#include <stdint.h>
#include <stdio.h>
namespace cg = cooperative_groups;

typedef unsigned short u16;
typedef __attribute__((ext_vector_type(8))) short bf16x8;
typedef __attribute__((ext_vector_type(16))) float f32x16;
typedef __attribute__((ext_vector_type(4))) unsigned u32x4;
typedef __attribute__((ext_vector_type(2))) unsigned u32x2;

#ifndef COOP
#define COOP 1
#endif

#define T_TOK 32768
#define SEQ 8192
#define DM 1024
#define DIN 2272
#define DINP 2304
#define NLAYER 4
#define EPSF 1e-6f
#define C_XA 0
#define C_GA 384
#define C_QL 768
#define C_KVL 960
#define C_KR 1088
#define C_GB 1120
#define C_U 1504
#define C_V 1760
#define C_GC 2016

#define LDT 72
#define TILE_U16 (128 * LDT)
#define LDS_BYTES 73728

struct Params {
  const float* x; const int* pos; const float* pre_g; const float* w_in; const float* conv_w; const float* conv_b;
  const float* lru_wa; const float* lru_ba; const float* lru_wx; const float* lru_bx; const float* lru_lam;
  const float* q_g; const float* w_uq; const float* kv_g; const float* w_ukv; const float* sgu_g; const float* sgu_bn;
  const float* sgu_w; const float* sgu_b; const float* br_g; const float* w_out; const float* post_g;
  float* out;
  u16* wInT; u16* wOutT; u16* wUqT; u16* wUkvT; u16* waT; u16* wxT; u16* sguW;
  float2* tab; int* counters; unsigned* bar;
  u16* hbuf;
  u16* proj;
  u16* y2;
  u16* Q; u16* K; u16* VT;
  u16* hloc; u16* cum; float* Ptile; float* Htile; float* carry;
  u16* obuf; u16* ycpre;
};

__device__ const double c_invfreq_rev[16] = {1.59154943091895345608e-01, 8.94994016088910132600e-02, 5.03292121044870352509e-02, 2.83021958306233986646e-02, 1.59154943091895338669e-02, 8.94994016088910236684e-03, 5.03292121044870369856e-03, 2.83021958306233986646e-03, 1.59154943091895356017e-03, 8.94994016088910236684e-04, 5.03292121044870326488e-04, 2.83021958306233954120e-04, 1.59154943091895350596e-04, 8.94994016088910182474e-05, 5.03292121044870353593e-05, 2.83021958306233960897e-05};
typedef const __attribute__((address_space(4))) Params* PP;
__device__ __forceinline__ PP launder(PP q) { asm volatile("" : "+s"(q)); return q; }
__device__ __forceinline__ float bf2f(u16 b) { return __uint_as_float(((unsigned)b) << 16); }
typedef __attribute__((ext_vector_type(2))) __bf16 bf16x2_t;
__device__ __forceinline__ u16 f2bf(float f) { return __builtin_bit_cast(u16, (__bf16)f); }
__device__ __forceinline__ unsigned pack2(float a, float b) { bf16x2_t v = {(__bf16)a, (__bf16)b}; return __builtin_bit_cast(unsigned, v); }
__device__ __forceinline__ float lo16(unsigned u) { return __uint_as_float(u << 16); }
__device__ __forceinline__ float hi16(unsigned u) { return __uint_as_float(u & 0xffff0000u); }
__device__ __forceinline__ void unpack8(uint4 a, float* v) {
  v[0] = lo16(a.x); v[1] = hi16(a.x); v[2] = lo16(a.y); v[3] = hi16(a.y);
  v[4] = lo16(a.z); v[5] = hi16(a.z); v[6] = lo16(a.w); v[7] = hi16(a.w);
}
__device__ __forceinline__ uint4 pack8(const float* v) {
  uint4 a; a.x = pack2(v[0], v[1]); a.y = pack2(v[2], v[3]); a.z = pack2(v[4], v[5]); a.w = pack2(v[6], v[7]); return a;
}
__device__ __forceinline__ float sigmoidf_(float x) { return __builtin_amdgcn_rcpf(1.f + __expf(-x)); }
__device__ __forceinline__ float siluf_(float x) { return x * __builtin_amdgcn_rcpf(1.f + __expf(-x)); }
__device__ __forceinline__ float geluf_(float x) {
  float u = 1.5957691216057308f * (x + 0.044715f * x * x * x);
  return x * __builtin_amdgcn_rcpf(1.f + __expf(-u));
}
__device__ __forceinline__ float wave_sum(float v) {
#pragma unroll
  for (int o = 32; o >= 1; o >>= 1) v += __shfl_xor(v, o);
  return v;
}
__device__ __forceinline__ int opaque_tid() { int t = threadIdx.x; asm volatile("" : "+v"(t)); return t; }
__device__ __forceinline__ f32x16 mfma32(bf16x8 a, bf16x8 b, f32x16 c) {
  return __builtin_amdgcn_mfma_f32_32x32x16_bf16(a, b, c, 0, 0, 0);
}

struct GStage { u32x4 w0, w1, w2, w3, x0, x1, x2, x3; };
__device__ __forceinline__ void gs_load(GStage& g, const u16* gw, int ldw, const u16* gx, int ldx, int k0) {
  g.w0 = *(const u32x4*)(gw + k0);
  g.w1 = *(const u32x4*)(gw + (size_t)32 * ldw + k0);
  g.w2 = *(const u32x4*)(gw + (size_t)64 * ldw + k0);
  g.w3 = *(const u32x4*)(gw + (size_t)96 * ldw + k0);
  g.x0 = *(const u32x4*)(gx + k0);
  g.x1 = *(const u32x4*)(gx + (size_t)32 * ldx + k0);
  g.x2 = *(const u32x4*)(gx + (size_t)64 * ldx + k0);
  g.x3 = *(const u32x4*)(gx + (size_t)96 * ldx + k0);
}
__device__ __forceinline__ void gs_store(const GStage& g, u16* db, int lo) {
  *(u32x4*)(db + lo) = g.w0;
  *(u32x4*)(db + lo + 32 * LDT) = g.w1;
  *(u32x4*)(db + lo + 64 * LDT) = g.w2;
  *(u32x4*)(db + lo + 96 * LDT) = g.w3;
  *(u32x4*)(db + TILE_U16 + lo) = g.x0;
  *(u32x4*)(db + TILE_U16 + lo + 32 * LDT) = g.x1;
  *(u32x4*)(db + TILE_U16 + lo + 64 * LDT) = g.x2;
  *(u32x4*)(db + TILE_U16 + lo + 96 * LDT) = g.x3;
}
__device__ __forceinline__ void gemm_kstep(const u16* sb, int wn, int wt, int r, int h, f32x16 (&acc)[2][2]) {
  const u16* bw = sb + (wn * 64 + r) * LDT + h * 8;
  const u16* bx = sb + TILE_U16 + (wt * 64 + r) * LDT + h * 8;
  __builtin_amdgcn_s_setprio(1);
#pragma unroll
  for (int ks = 0; ks < 4; ++ks) {
    bf16x8 a0 = *(const bf16x8*)(bw + ks * 16);
    bf16x8 a1 = *(const bf16x8*)(bw + 32 * LDT + ks * 16);
    bf16x8 b0 = *(const bf16x8*)(bx + ks * 16);
    bf16x8 b1 = *(const bf16x8*)(bx + 32 * LDT + ks * 16);
    acc[0][0] = mfma32(a0, b0, acc[0][0]);
    acc[0][1] = mfma32(a0, b1, acc[0][1]);
    acc[1][0] = mfma32(a1, b0, acc[1][0]);
    acc[1][1] = mfma32(a1, b1, acc[1][1]);
  }
  __builtin_amdgcn_s_setprio(0);
}
__device__ __forceinline__ void gemm_tile(const u16* __restrict__ W, int ldw, const u16* __restrict__ X, int ldx,
                                          int K, u16* lds, f32x16 (&acc)[2][2]) {
  const int tid = opaque_tid(), lane = tid & 63, w = tid >> 6, r = lane & 31, h = lane >> 5;
  const int wn = w >> 1, wt = w & 1;
#pragma unroll
  for (int a = 0; a < 2; ++a)
#pragma unroll
    for (int b = 0; b < 2; ++b)
#pragma unroll
      for (int i = 0; i < 16; ++i) acc[a][b][i] = 0.f;
  const int lrow = tid >> 3, lc = tid & 7;
  const u16* gw = W + (size_t)lrow * ldw + lc * 8;
  const u16* gx = X + (size_t)lrow * ldx + lc * 8;
  const int lo = lrow * LDT + lc * 8;
  const int nk = K >> 6;
  GStage A, B;
  gs_load(B, gw, ldw, gx, ldx, 0);
  if (nk > 1) gs_load(A, gw, ldw, gx, ldx, 64);
  gs_store(B, lds, lo);
  __syncthreads();
  for (int kt = 0; kt < nk; kt += 2) {
    if (kt + 2 < nk) gs_load(B, gw, ldw, gx, ldx, (kt + 2) * 64);
    gemm_kstep(lds, wn, wt, r, h, acc);
    if (kt + 1 < nk) gs_store(A, lds + 2 * TILE_U16, lo);
    __syncthreads();
    if (kt + 1 < nk) {
      if (kt + 3 < nk) gs_load(A, gw, ldw, gx, ldx, (kt + 3) * 64);
      gemm_kstep(lds + 2 * TILE_U16, wn, wt, r, h, acc);
      if (kt + 2 < nk) gs_store(B, lds, lo);
      __syncthreads();
    }
  }
}

__device__ __forceinline__ void stage_f32(float* st, f32x16 (&acc)[2][2]) {
  const int tid = opaque_tid(), lane = tid & 63, w = tid >> 6, r = lane & 31, h = lane >> 5;
  const int wn = w >> 1, wt = w & 1;
#pragma unroll
  for (int nb = 0; nb < 2; ++nb)
#pragma unroll
    for (int tb = 0; tb < 2; ++tb) {
      const int token = wt * 64 + tb * 32 + r;
#pragma unroll
      for (int g = 0; g < 4; ++g) {
        const int n0 = wn * 64 + nb * 32 + 8 * g + 4 * h;
        float4 v = make_float4(acc[nb][tb][4 * g], acc[nb][tb][4 * g + 1], acc[nb][tb][4 * g + 2], acc[nb][tb][4 * g + 3]);
        *(float4*)(st + token * 132 + n0) = v;
      }
    }
}
__device__ __forceinline__ void stage_bf16(u16* st, f32x16 (&acc)[2][2]) {
  const int tid = opaque_tid(), lane = tid & 63, w = tid >> 6, r = lane & 31, h = lane >> 5;
  const int wn = w >> 1, wt = w & 1;
#pragma unroll
  for (int nb = 0; nb < 2; ++nb)
#pragma unroll
    for (int tb = 0; tb < 2; ++tb) {
      const int token = wt * 64 + tb * 32 + r;
#pragma unroll
      for (int g = 0; g < 4; ++g) {
        const int n0 = wn * 64 + nb * 32 + 8 * g + 4 * h;
        uint2 v;
        v.x = pack2(acc[nb][tb][4 * g], acc[nb][tb][4 * g + 1]);
        v.y = pack2(acc[nb][tb][4 * g + 2], acc[nb][tb][4 * g + 3]);
        *(uint2*)(st + token * 136 + n0) = v;
      }
    }
}

__device__ void gemm_store_tile(const u16* W, int ldw, const u16* X, int ldx, int K, u16* out, int ldo, u16* lds) {
  f32x16 acc[2][2];
  gemm_tile(W, ldw, X, ldx, K, lds, acc);
  stage_bf16(lds, acc);
  __syncthreads();
  const int tid = opaque_tid();
#pragma unroll
  for (int i = 0; i < 8; ++i) {
    const int id = tid + 256 * i;
    const int row = id >> 4, c = id & 15;
    uint4 v = *(const uint4*)(lds + row * 136 + c * 8);
    *(uint4*)(out + (size_t)row * ldo + c * 8) = v;
  }
  __syncthreads();
}

__device__ void gemm_phase(const u16* __restrict__ Wb, int ldw, const u16* __restrict__ Xb, int ldx, int K,
                           u16* __restrict__ outb, int ldo, int ntn, int ntiles, u16* lds) {
  const int tid = opaque_tid(), lane = tid & 63, w = tid >> 6, r = lane & 31, h = lane >> 5;
  const int wn = w >> 1, wt = w & 1;
  const int lrow = tid >> 3, lc = tid & 7;
  const int lo = lrow * LDT + lc * 8;
  const int nk = K >> 6;
  const int nbl = gridDim.x >> 3;
  const int xl = blockIdx.x & 7, jl = blockIdx.x >> 3;
  const int mt_per = (ntiles / ntn) >> 3;
  const int L = mt_per * ntn;
  int q = jl;
  if (q >= L) return;
#define GP_MT(qq) (xl * mt_per + ((qq) / (8 * ntn)) * 8 + ((qq) % (8 * ntn)) % 8)
#define GP_NT(qq) (((qq) % (8 * ntn)) / 8)
  const u16* gw = Wb + (size_t)(GP_NT(q) * 128 + lrow) * ldw + lc * 8;
  const u16* gx = Xb + (size_t)(GP_MT(q) * 128 + lrow) * ldx + lc * 8;
  GStage A, B;
  gs_load(B, gw, ldw, gx, ldx, 0);
  gs_load(A, gw, ldw, gx, ldx, 64);
  for (; q < L; q += nbl) {
    const int qn = q + nbl;
    const bool has_next = qn < L;
    const int qq = has_next ? qn : q;
    const u16* gwn = Wb + (size_t)(GP_NT(qq) * 128 + lrow) * ldw + lc * 8;
    const u16* gxn = Xb + (size_t)(GP_MT(qq) * 128 + lrow) * ldx + lc * 8;
    f32x16 acc[2][2];
#pragma unroll
    for (int a = 0; a < 2; ++a)
#pragma unroll
      for (int b = 0; b < 2; ++b)
#pragma unroll
        for (int i = 0; i < 16; ++i) acc[a][b][i] = 0.f;
    gs_store(B, lds, lo);
    __syncthreads();
    for (int kt = 0; kt < nk; kt += 2) {
      if (kt + 2 < nk) gs_load(B, gw, ldw, gx, ldx, (kt + 2) * 64);
      else if (has_next) gs_load(B, gwn, ldw, gxn, ldx, 0);
      gemm_kstep(lds, wn, wt, r, h, acc);
      gs_store(A, lds + 2 * TILE_U16, lo);
      __syncthreads();
      if (kt + 3 < nk) gs_load(A, gw, ldw, gx, ldx, (kt + 3) * 64);
      else if (has_next) gs_load(A, gwn, ldw, gxn, ldx, 64);
      gemm_kstep(lds + 2 * TILE_U16, wn, wt, r, h, acc);
      if (kt + 2 < nk) gs_store(B, lds, lo);
      __syncthreads();
    }
    stage_bf16(lds, acc);
    __syncthreads();
    u16* out = outb + (size_t)GP_MT(q) * 128 * ldo + GP_NT(q) * 128;
#pragma unroll
    for (int i = 0; i < 8; ++i) {
      const int id = tid + 256 * i;
      const int row = id >> 4, c = id & 15;
      uint4 v = *(const uint4*)(lds + row * 136 + c * 8);
      *(uint4*)(out + (size_t)row * ldo + c * 8) = v;
    }
    __syncthreads();
    gw = gwn; gx = gxn;
  }
#undef GP_MT
#undef GP_NT
}

__device__ void prep_transpose(const float* __restrict__ src, size_t sstride, int nmat, int R, int C, u16* __restrict__ dst,
                               size_t dstride, int dld, const float* __restrict__ gk, int mode, float* tile, int bid, int nb) {
  const int tid = opaque_tid();
  const int tr = R >> 6, tc = (C + 63) >> 6;
  const int per = tr * tc;
  for (int t = bid; t < per * nmat; t += nb) {
    const int m = t / per, tt = t % per;
    const int r0 = (tt / tc) * 64, c0 = (tt % tc) * 64;
    const float* sm = src + (size_t)m * sstride;
    u16* dm = dst + (size_t)m * dstride;
    __syncthreads();
#pragma unroll
    for (int i = 0; i < 16; ++i) {
      const int rr = i * 4 + (tid >> 6), cc = tid & 63;
      float v = 0.f;
      if (c0 + cc < C) {
        v = sm[(size_t)(r0 + rr) * C + c0 + cc];
        if (gk) v *= gk[m * R + r0 + rr];
      }
      tile[rr * 65 + cc] = v;
    }
    __syncthreads();
#pragma unroll
    for (int i = 0; i < 16; ++i) {
      const int cc = i * 4 + (tid >> 6), rr = tid & 63;
      const int c = c0 + cc;
      if (c < C) {
        const int n = (mode == 1) ? (c / 96) * 128 + (c % 96) : c;
        dm[(size_t)n * dld + r0 + rr] = f2bf(tile[rr * 65 + cc]);
      }
    }
  }
}
__device__ void phase_prep(PP p, float* ldsf) {
  p = launder(p);
  const int bid = blockIdx.x, nb = gridDim.x, tid = opaque_tid();
  const int gtid = bid * 256 + tid, gn = nb * 256;
  if (bid == 0) p->counters[tid] = 0;
  prep_transpose(p->w_in, (size_t)DM * DIN, NLAYER, DM, DIN, p->wInT, (size_t)DINP * DM, DM, nullptr, 0, ldsf, bid, nb);
  prep_transpose(p->w_out, (size_t)DM * DM, NLAYER, DM, DM, p->wOutT, (size_t)DM * DM, DM, nullptr, 0, ldsf, (bid + 256) % nb, nb);
  prep_transpose(p->w_uq, (size_t)192 * 576, NLAYER, 192, 576, p->wUqT, (size_t)768 * 192, 192, p->q_g, 1, ldsf, (bid + 128) % nb, nb);
  prep_transpose(p->w_ukv, (size_t)128 * 768, NLAYER, 128, 768, p->wUkvT, (size_t)768 * 128, 128, p->kv_g, 0, ldsf, (bid + 384) % nb, nb);
  prep_transpose(p->lru_wa, 4096, NLAYER * 6, 64, 64, p->waT, 4096, 64, nullptr, 0, ldsf, (bid + 64) % nb, nb);
  prep_transpose(p->lru_wx, 4096, NLAYER * 6, 64, 64, p->wxT, 4096, 64, nullptr, 0, ldsf, (bid + 192) % nb, nb);
  for (int i = gtid; i < NLAYER * 32 * DM; i += gn) {
    const int l = i / (32 * DM), rem = i % (32 * DM);
    p->wInT[(size_t)l * DINP * DM + (size_t)DIN * DM + rem] = 0;
  }
  for (int i = gtid; i < NLAYER * 6 * 32 * 192; i += gn) {
    const int l = i / (6 * 32 * 192), rem = i % (6 * 32 * 192);
    const int hd = rem / (32 * 192), rem2 = rem % (32 * 192);
    p->wUqT[(size_t)l * 768 * 192 + (size_t)(hd * 128 + 96) * 192 + rem2] = 0;
  }
  for (int i = gtid; i < NLAYER * 4 * 128 * 128; i += gn) {
    const int ii = (i >> 7) & 127, jj = i & 127;
    const float v = (ii >= 64 || jj < 64) ? p->sgu_w[i] : 0.f;
    p->sguW[i] = f2bf(v);
  }
  for (int i = gtid; i < T_TOK * 16; i += gn) {
    const int t = i >> 4, k = i & 15;
    const double rev = (double)p->pos[t] * c_invfreq_rev[k];
    const double fr = rev - __builtin_rint(rev);
    const float f = (float)fr;
    p->tab[i] = make_float2(__builtin_amdgcn_cosf(f), __builtin_amdgcn_sinf(f));
  }
}

typedef __attribute__((ext_vector_type(4))) float f32x4;
__device__ void phase_norm(PP p, int l) {
  p = launder(p);
  const int tid_ = opaque_tid();
  const int lane = tid_ & 63;
  const int gw = blockIdx.x * 4 + (tid_ >> 6), nw = gridDim.x * 4;
  const float* xin = (l <= 1) ? p->x : p->out;
  const float* gpost = p->post_g + (l > 0 ? l - 1 : 0) * DM;
  const float* gpre = p->pre_g + (l < NLAYER ? l : 0) * DM;
  constexpr int NTK = 4;
  for (int tok0 = gw; tok0 < T_TOK; tok0 += NTK * nw) {
    f32x4 xv[NTK][4];
    u32x2 yu[NTK][4];
#pragma unroll
    for (int t = 0; t < NTK; ++t) {
      const int tok = (tok0 + t * nw < T_TOK) ? tok0 + t * nw : tok0;
#pragma unroll
      for (int i = 0; i < 4; ++i) xv[t][i] = __builtin_nontemporal_load((const f32x4*)(xin + (size_t)tok * DM + i * 256 + lane * 4));
    }
    if (l > 0) {
#pragma unroll
      for (int t = 0; t < NTK; ++t) {
        const int tok = (tok0 + t * nw < T_TOK) ? tok0 + t * nw : tok0;
#pragma unroll
        for (int i = 0; i < 4; ++i) yu[t][i] = __builtin_nontemporal_load((const u32x2*)(p->y2 + (size_t)tok * DM + i * 256 + lane * 4));
      }
    }
#pragma unroll
    for (int t = 0; t < NTK; ++t) {
      const int tok = (tok0 + t * nw < T_TOK) ? tok0 + t * nw : tok0;
      if (l > 0) {
        float yv[16];
        float ss = 0.f;
#pragma unroll
        for (int i = 0; i < 4; ++i) {
          yv[4 * i] = lo16(yu[t][i].x); yv[4 * i + 1] = hi16(yu[t][i].x); yv[4 * i + 2] = lo16(yu[t][i].y); yv[4 * i + 3] = hi16(yu[t][i].y);
          ss += yv[4 * i] * yv[4 * i] + yv[4 * i + 1] * yv[4 * i + 1] + yv[4 * i + 2] * yv[4 * i + 2] + yv[4 * i + 3] * yv[4 * i + 3];
        }
        ss = wave_sum(ss);
        const float rs = rsqrtf(ss * (1.f / 1024.f) + EPSF);
#pragma unroll
        for (int i = 0; i < 4; ++i) {
          float4 gv = *(const float4*)(gpost + i * 256 + lane * 4);
          xv[t][i].x += yv[4 * i] * rs * gv.x; xv[t][i].y += yv[4 * i + 1] * rs * gv.y;
          xv[t][i].z += yv[4 * i + 2] * rs * gv.z; xv[t][i].w += yv[4 * i + 3] * rs * gv.w;
        }
      }
      if (l > 0) {
#pragma unroll
        for (int i = 0; i < 4; ++i) __builtin_nontemporal_store(xv[t][i], (f32x4*)(p->out + (size_t)tok * DM + i * 256 + lane * 4));
      }
      if (l < NLAYER) {
        float ss = 0.f;
#pragma unroll
        for (int i = 0; i < 4; ++i) ss += xv[t][i].x * xv[t][i].x + xv[t][i].y * xv[t][i].y + xv[t][i].z * xv[t][i].z + xv[t][i].w * xv[t][i].w;
        ss = wave_sum(ss);
        const float rs = rsqrtf(ss * (1.f / 1024.f) + EPSF);
#pragma unroll
        for (int i = 0; i < 4; ++i) {
          float4 gv = *(const float4*)(gpre + i * 256 + lane * 4);
          uint2 u;
          u.x = pack2(xv[t][i].x * rs * gv.x, xv[t][i].y * rs * gv.y);
          u.y = pack2(xv[t][i].z * rs * gv.z, xv[t][i].w * rs * gv.w);
          *(uint2*)(p->hbuf + (size_t)tok * DM + i * 256 + lane * 4) = u;
        }
      }
    }
  }
}

__device__ void item_q(PP p, int l, int rt, int hd, u16* lds, float* ssm, bool do_rstd) {
  p = launder(p);
  const int tid = opaque_tid();
  const int m0 = rt * 128;
  if (do_rstd) {
    const int row = tid >> 1, half = tid & 1;
    const u16* src = p->proj + (size_t)(m0 + row) * DINP + C_QL + half * 96;
    float ss = 0.f;
#pragma unroll
    for (int i = 0; i < 12; ++i) {
      float v[8]; unpack8(*(const uint4*)(src + i * 8), v);
#pragma unroll
      for (int j = 0; j < 8; ++j) ss += v[j] * v[j];
    }
    ss += __shfl_xor(ss, 1);
    if (half == 0) ssm[row] = rsqrtf(ss * (1.f / 192.f) + EPSF);
  }
  f32x16 acc[2][2];
  gemm_tile(p->wUqT + (size_t)l * 768 * 192 + (size_t)hd * 128 * 192, 192, p->proj + (size_t)m0 * DINP + C_QL, DINP, 192, lds, acc);
  float* st = (float*)lds;
  stage_f32(st, acc);
  __syncthreads();
  const float qscale = 0.10206207261596577f * 1.4426950408889634f;
#pragma unroll
  for (int i = 0; i < 6; ++i) {
    const int u = tid + 256 * i;
    const int row = u / 12, dg = u % 12;
    const float sc = ssm[row] * qscale;
    const float* sr = st + row * 132;
    float o[8];
    if (dg < 8) {
      const float4 a = *(const float4*)(sr + dg * 8), bq = *(const float4*)(sr + dg * 8 + 4);
      o[0] = a.x * sc; o[1] = a.y * sc; o[2] = a.z * sc; o[3] = a.w * sc;
      o[4] = bq.x * sc; o[5] = bq.y * sc; o[6] = bq.z * sc; o[7] = bq.w * sc;
    } else {
      const int i0 = (dg & 1) * 8;
      const float2* tb = p->tab + (size_t)(m0 + row) * 16 + i0;
      const float4 a0 = *(const float4*)(sr + 64 + i0), a1 = *(const float4*)(sr + 68 + i0);
      const float4 b0 = *(const float4*)(sr + 80 + i0), b1 = *(const float4*)(sr + 84 + i0);
      const float x1[8] = {a0.x, a0.y, a0.z, a0.w, a1.x, a1.y, a1.z, a1.w};
      const float x2[8] = {b0.x, b0.y, b0.z, b0.w, b1.x, b1.y, b1.z, b1.w};
      const float4 t0 = *(const float4*)(tb), t1 = *(const float4*)(tb + 2), t2 = *(const float4*)(tb + 4), t3 = *(const float4*)(tb + 6);
      const float cc[8] = {t0.x, t0.z, t1.x, t1.z, t2.x, t2.z, t3.x, t3.z};
      const float sn[8] = {t0.y, t0.w, t1.y, t1.w, t2.y, t2.w, t3.y, t3.w};
      if (dg < 10) {
#pragma unroll
        for (int j = 0; j < 8; ++j) o[j] = (x1[j] * cc[j] - x2[j] * sn[j]) * sc;
      } else {
#pragma unroll
        for (int j = 0; j < 8; ++j) o[j] = (x2[j] * cc[j] + x1[j] * sn[j]) * sc;
      }
    }
    *(uint4*)(p->Q + ((size_t)(m0 + row) * 6 + hd) * 96 + dg * 8) = pack8(o);
  }
  __syncthreads();
}

__device__ void item_kv(PP p, int l, int rt, int hd, u16* lds, float* ssm, bool do_rstd) {
  p = launder(p);
  const int tid = opaque_tid();
  const int m0 = rt * 128;
  if (do_rstd) {
    const int row = tid >> 1, half = tid & 1;
    const u16* src = p->proj + (size_t)(m0 + row) * DINP + C_KVL + half * 64;
    float ss = 0.f;
#pragma unroll
    for (int i = 0; i < 8; ++i) {
      float v[8]; unpack8(*(const uint4*)(src + i * 8), v);
#pragma unroll
      for (int j = 0; j < 8; ++j) ss += v[j] * v[j];
    }
    ss += __shfl_xor(ss, 1);
    if (half == 0) ssm[row] = rsqrtf(ss * (1.f / 128.f) + EPSF);
  }
  f32x16 acc[2][2];
  gemm_tile(p->wUkvT + (size_t)l * 768 * 128 + (size_t)hd * 128 * 128, 128, p->proj + (size_t)m0 * DINP + C_KVL, DINP, 128, lds, acc);
  float* st = (float*)lds;
  stage_f32(st, acc);
  __syncthreads();
  const int kb_ = m0 / SEQ, ks0_ = m0 % SEQ;
#pragma unroll
  for (int i = 0; i < 4; ++i) {
    const int u = tid + 256 * i;
    const int row = u >> 3, dg = u & 7;
    const float sc = ssm[row];
    const float* sr = st + row * 132 + dg * 8;
    float o[8];
    {
      const float4 a = *(const float4*)(sr), bq = *(const float4*)(sr + 4);
      o[0] = a.x * sc; o[1] = a.y * sc; o[2] = a.z * sc; o[3] = a.w * sc;
      o[4] = bq.x * sc; o[5] = bq.y * sc; o[6] = bq.z * sc; o[7] = bq.w * sc;
    }
    *(uint4*)(p->K + ((size_t)(kb_ * 6 + hd) * SEQ + ks0_ + row) * 96 + dg * 8) = pack8(o);
  }
  if (hd == 0) {
#pragma unroll
    for (int i = 0; i < 2; ++i) {
      const int u = tid + 256 * i;
      const int row = u >> 2, dq = u & 3;
      const int i0 = (dq & 1) * 8;
      const u16* kr = p->proj + (size_t)(m0 + row) * DINP + C_KR;
      float x1[8], x2[8], o[8];
      unpack8(*(const uint4*)(kr + i0), x1);
      unpack8(*(const uint4*)(kr + 16 + i0), x2);
      const float2* tb = p->tab + (size_t)(m0 + row) * 16 + i0;
      if (dq < 2) {
#pragma unroll
        for (int j = 0; j < 8; ++j) { float2 cs = tb[j]; o[j] = x1[j] * cs.x - x2[j] * cs.y; }
      } else {
#pragma unroll
        for (int j = 0; j < 8; ++j) { float2 cs = tb[j]; o[j] = x2[j] * cs.x + x1[j] * cs.y; }
      }
      const uint4 ov = pack8(o);
#pragma unroll
      for (int hh2 = 0; hh2 < 6; ++hh2)
        *(uint4*)(p->K + ((size_t)(kb_ * 6 + hh2) * SEQ + ks0_ + row) * 96 + 64 + dq * 8) = ov;
    }
  }
  const int b = m0 / SEQ, s0 = m0 % SEQ;
#pragma unroll
  for (int i = 0; i < 4; ++i) {
    const int u = tid + 256 * i;
    const int dv = u & 63, tg = u >> 6;
    float o[8];
#pragma unroll
    for (int j = 0; j < 8; ++j) o[j] = st[(tg * 8 + j) * 132 + 64 + dv] * ssm[tg * 8 + j];
    u16* vdst = p->VT + (((size_t)(b * 6 + hd) * 128 + (s0 >> 6) + (tg >> 3)) * 64 + dv) * 64 + ((tg & 7) >> 1) * 16 + (tg & 1) * 4;
    uint2 lo2, hi2;
    lo2.x = pack2(o[0], o[1]); lo2.y = pack2(o[2], o[3]);
    hi2.x = pack2(o[4], o[5]); hi2.y = pack2(o[6], o[7]);
    *(uint2*)(vdst) = lo2;
    *(uint2*)(vdst + 8) = hi2;
  }
  __syncthreads();
}

__device__ void item_lru(PP p, int l, int tt, int hd, u16* lds, float* ssm) {
  p = launder(p);
  const int tid = opaque_tid(), lane = tid & 63, w = tid >> 6, r = lane & 31, h = lane >> 5;
  const int t0 = tt * 64;
  const int s0 = t0 % SEQ;
  float* xaf = (float*)lds;
  u16* xcb = lds + 8576;
  float* aarr = (float*)(lds + 8576 + 4608);
  float* barr = aarr + 4096;
  const int c = tid & 63;
  const int cg = hd * 64 + c;
  bf16x8 wfa[4], wfx[4];
  {
    const int cbk_ = w & 1;
    const u16* wa_ = p->waT + (size_t)(l * 6 + hd) * 4096 + (cbk_ * 32 + r) * 64 + h * 8;
    const u16* wx_ = p->wxT + (size_t)(l * 6 + hd) * 4096 + (cbk_ * 32 + r) * 64 + h * 8;
#pragma unroll
    for (int ks = 0; ks < 4; ++ks) { wfa[ks] = *(const bf16x8*)(wa_ + ks * 16); wfx[ks] = *(const bf16x8*)(wx_ + ks * 16); }
  }
  for (int u = tid; u < 67 * 8; u += 256) {
    const int row = u >> 3, c8 = u & 7;
    float v[8];
    if (s0 + row - 3 >= 0) {
      unpack8(*(const uint4*)(p->proj + (size_t)(t0 + row - 3) * DINP + C_XA + hd * 64 + c8 * 8), v);
    } else {
#pragma unroll
      for (int j = 0; j < 8; ++j) v[j] = 0.f;
    }
    *(float4*)(xaf + row * 64 + c8 * 8) = make_float4(v[0], v[1], v[2], v[3]);
    *(float4*)(xaf + row * 64 + c8 * 8 + 4) = make_float4(v[4], v[5], v[6], v[7]);
  }
  __syncthreads();
  const float cw0 = p->conv_w[(l * 4 + 0) * 384 + cg], cw1 = p->conv_w[(l * 4 + 1) * 384 + cg];
  const float cw2 = p->conv_w[(l * 4 + 2) * 384 + cg], cw3 = p->conv_w[(l * 4 + 3) * 384 + cg];
  const float cbias = p->conv_b[l * 384 + cg];
  {
    const int tq = tid >> 6;
    for (int t = tq * 16; t < tq * 16 + 16; ++t) {
      const float xc = cbias + cw0 * xaf[t * 64 + c] + cw1 * xaf[(t + 1) * 64 + c] + cw2 * xaf[(t + 2) * 64 + c] + cw3 * xaf[(t + 3) * 64 + c];
      xcb[t * LDT + c] = f2bf(xc);
    }
  }
  __syncthreads();
  {
    const int tb = w >> 1, cbk = w & 1;
    f32x16 aa, ax;
#pragma unroll
    for (int i = 0; i < 16; ++i) { aa[i] = 0.f; ax[i] = 0.f; }
    const u16* xr = xcb + (tb * 32 + r) * LDT + h * 8;
#pragma unroll
    for (int ks = 0; ks < 4; ++ks) {
      bf16x8 af = *(const bf16x8*)(xr + ks * 16);
      aa = mfma32(af, wfa[ks], aa);
      ax = mfma32(af, wfx[ks], ax);
    }
    const int cc = cbk * 32 + r;
    const int cgl = hd * 64 + cc;
    const float ba = p->lru_ba[l * 384 + cgl], bx = p->lru_bx[l * 384 + cgl];
    const float lam = p->lru_lam[l * 384 + cgl];
    const float nl = -lam;
    const float sp = fmaxf(nl, 0.f) + log1pf(expf(-fabsf(nl)));
#pragma unroll
    for (int reg = 0; reg < 16; ++reg) {
      const int t = tb * 32 + (reg & 3) + 8 * (reg >> 2) + 4 * h;
      const float xc = bf2f(xcb[t * LDT + cc]);
      const float ga = sigmoidf_(aa[reg] + ba);
      const float gx = sigmoidf_(ax[reg] + bx);
      const float la = -8.f * ga * sp;
      const float a = __expf(la);
      const float om = (la > -5e-4f) ? (-2.f * la) * (1.f + la) : (1.f - a * a);
      const float mult = sqrtf(fmaxf(om, 0.f));
      aarr[t * 64 + cc] = a;
      barr[t * 64 + cc] = mult * gx * xc;
    }
  }
  __syncthreads();
  const int seg = tid >> 6;
  u16* h16 = (u16*)aarr;
  u16* c16 = (u16*)barr;
  float pr[16], hr[16];
#pragma unroll
  for (int j = 0; j < 16; ++j) { pr[j] = aarr[(seg * 16 + j) * 64 + c]; hr[j] = barr[(seg * 16 + j) * 64 + c]; }
  {
    float hh = 0.f, P = 1.f;
#pragma unroll
    for (int j = 0; j < 16; ++j) { hh = pr[j] * hh + hr[j]; P *= pr[j]; hr[j] = hh; pr[j] = P; }
    ssm[seg * 64 + c] = P;
    ssm[256 + seg * 64 + c] = hh;
  }
  __syncthreads();
  {
    float Hc = 0.f, Pc = 1.f;
    for (int s2 = 0; s2 < seg; ++s2) {
      const float Ps = ssm[s2 * 64 + c], Hs = ssm[256 + s2 * 64 + c];
      Hc = Ps * Hc + Hs; Pc *= Ps;
    }
    float hl = 0.f, cm = 1.f;
#pragma unroll
    for (int j = 0; j < 16; ++j) {
      hl = hr[j] + pr[j] * Hc;
      cm = pr[j] * Pc;
      h16[(seg * 16 + j) * 64 + c] = f2bf(hl);
      c16[(seg * 16 + j) * 64 + c] = f2bf(cm);
    }
    if (seg == 3) {
      p->Htile[(size_t)tt * 384 + cg] = hl;
      p->Ptile[(size_t)tt * 384 + cg] = cm;
    }
  }
  __syncthreads();
#pragma unroll
  for (int i = 0; i < 2; ++i) {
    const int id = tid + 256 * i;
    const int row = id >> 3, c8 = id & 7;
    const uint4 hv = *(const uint4*)(h16 + row * 64 + c8 * 8);
    const uint4 cv = *(const uint4*)(c16 + row * 64 + c8 * 8);
    *(uint4*)(p->hloc + (size_t)(t0 + row) * 384 + hd * 64 + c8 * 8) = hv;
    *(uint4*)(p->cum + (size_t)(t0 + row) * 384 + hd * 64 + c8 * 8) = cv;
  }
  __syncthreads();
}

__device__ void item_sgu(PP p, int l, int nbk, u16* lds, float* ssm) {
  p = launder(p);
  const int tid = opaque_tid(), lane = tid & 63, w = tid >> 6, r = lane & 31, h = lane >> 5;
  const int m0 = nbk * 128;
  {
    const int row = tid >> 1, half = tid & 1;
    const u16* src = p->proj + (size_t)(m0 + row) * DINP + C_V + half * 128;
    float s1 = 0.f, s2 = 0.f;
#pragma unroll
    for (int i = 0; i < 16; ++i) {
      float v[8]; unpack8(*(const uint4*)(src + i * 8), v);
#pragma unroll
      for (int j = 0; j < 8; ++j) { const float gq = geluf_(v[j]); s1 += gq; s2 += gq * gq; }
    }
    s1 += __shfl_xor(s1, 1); s2 += __shfl_xor(s2, 1);
    if (half == 0) {
      const float mu = s1 * (1.f / 256.f);
      const float var = fmaxf(s2 * (1.f / 256.f) - mu * mu, 0.f);
      ssm[row] = mu; ssm[128 + row] = rsqrtf(var + EPSF);
    }
  }
  u16* vbT = lds;
  for (int g = 0; g < 4; ++g) {
    __syncthreads();
    {
      const int j = tid & 127, chalf = tid >> 7;
      const float mu = ssm[j], rs = ssm[128 + j];
      const u16* src = p->proj + (size_t)(m0 + j) * DINP + C_V + g * 64 + chalf * 32;
      const float* lg = p->sgu_g + l * 256 + g * 64 + chalf * 32;
      const float* lb = p->sgu_bn + l * 256 + g * 64 + chalf * 32;
#pragma unroll
      for (int i = 0; i < 4; ++i) {
        float v[8]; unpack8(*(const uint4*)(src + i * 8), v);
#pragma unroll
        for (int q = 0; q < 8; ++q) {
          const int cc = chalf * 32 + i * 8 + q;
          const float val = (geluf_(v[q]) - mu) * rs * lg[i * 8 + q] + lb[i * 8 + q];
          vbT[cc * 136 + j] = f2bf(val);
        }
      }
    }
    __syncthreads();
    f32x16 a0, a1;
#pragma unroll
    for (int i = 0; i < 16; ++i) { a0[i] = 0.f; a1[i] = 0.f; }
    const u16* wr = p->sguW + ((size_t)(l * 4 + g) * 128 + w * 32 + r) * 128 + h * 8;
    const u16* v0 = vbT + r * 136 + h * 8;
    const u16* v1 = vbT + (32 + r) * 136 + h * 8;
    const int nks = (w < 2) ? 4 : 8;
    for (int ks = 0; ks < nks; ++ks) {
      bf16x8 af = *(const bf16x8*)(wr + ks * 16);
      bf16x8 b0 = *(const bf16x8*)(v0 + ks * 16);
      bf16x8 b1 = *(const bf16x8*)(v1 + ks * 16);
      a0 = mfma32(af, b0, a0);
      a1 = mfma32(af, b1, a1);
    }
    float* stg = (float*)(lds + 8704);
#pragma unroll
    for (int reg = 0; reg < 16; ++reg) {
      const int i = w * 32 + (reg & 3) + 8 * (reg >> 2) + 4 * h;
      const float bsv = p->sgu_b[(l * 4 + g) * 128 + i];
      stg[i * 68 + r] = a0[reg] + bsv;
      stg[i * 68 + 32 + r] = a1[reg] + bsv;
    }
    __syncthreads();
#pragma unroll
    for (int k = 0; k < 4; ++k) {
      const int u = tid + 256 * k;
      const int i = u >> 3, c8 = u & 7;
      const size_t tok = (size_t)(m0 + i);
      const int ch = g * 64 + c8 * 8;
      const float4 m0v = *(const float4*)(stg + i * 68 + c8 * 8), m1v = *(const float4*)(stg + i * 68 + c8 * 8 + 4);
      const float mx[8] = {m0v.x, m0v.y, m0v.z, m0v.w, m1v.x, m1v.y, m1v.z, m1v.w};
      float uu[8], gcv[8], o[8];
      unpack8(*(const uint4*)(p->proj + tok * DINP + C_U + ch), uu);
      unpack8(*(const uint4*)(p->proj + tok * DINP + C_GC + ch), gcv);
#pragma unroll
      for (int q = 0; q < 8; ++q) o[q] = geluf_(uu[q]) * mx[q] * siluf_(gcv[q]);
      *(uint4*)(p->ycpre + tok * 256 + ch) = pack8(o);
    }
  }
  __syncthreads();
}

__device__ void item_carry(PP p, int ci) {
  p = launder(p);
  const int idx = ci * 256 + opaque_tid();
  const int b = idx / 384, c = idx % 384;
  float carry = 0.f;
  for (int tt = 0; tt < 128; ++tt) {
    const size_t o = (size_t)(b * 128 + tt) * 384 + c;
    p->carry[o] = carry;
    carry = p->Ptile[o] * carry + p->Htile[o];
  }
}

#define KLD 104
#define VLD 72
#define ATT_STAGE (64 * KLD + 64 * VLD)
struct AStage { u32x4 k0, k1, k2, v0, v1; };
__device__ __forceinline__ void as_load(AStage& g, const u16* kg, const u16* vg, int kt) {
  const u16* kp = kg + (size_t)kt * 6144;
  g.k0 = *(const u32x4*)(kp); g.k1 = *(const u32x4*)(kp + 2048); g.k2 = *(const u32x4*)(kp + 4096);
  const u16* vp = vg + (size_t)kt * 4096;
  g.v0 = *(const u32x4*)(vp); g.v1 = *(const u32x4*)(vp + 2048);
#ifdef DUP_LOADS
  {
    u32x4 t0 = *(const volatile u32x4*)(kp), t1 = *(const volatile u32x4*)(kp + 2048), t2 = *(const volatile u32x4*)(kp + 4096);
    u32x4 t3 = *(const volatile u32x4*)(vp), t4 = *(const volatile u32x4*)(vp + 2048);
    asm volatile("" :: "v"(t0), "v"(t1), "v"(t2), "v"(t3), "v"(t4));
  }
#endif
}
__device__ __forceinline__ void as_store(const AStage& g, u16* db, int kl0, int kl1, int kl2, int vl) {
  *(u32x4*)(db + kl0) = g.k0; *(u32x4*)(db + kl1) = g.k1; *(u32x4*)(db + kl2) = g.k2;
  *(u32x4*)(db + vl) = g.v0; *(u32x4*)(db + vl + 32 * VLD) = g.v1;
}
__device__ __forceinline__ float max3f(float a, float b, float c) {
  float d; asm("v_max3_f32 %0, %1, %2, %3" : "=v"(d) : "v"(a), "v"(b), "v"(c)); return d;
}
__device__ __forceinline__ bf16x8 pack_p(const f32x16& s, int o) {
  u32x4 pu;
  pu.x = pack2(s[o + 0], s[o + 1]); pu.y = pack2(s[o + 2], s[o + 3]);
  pu.z = pack2(s[o + 4], s[o + 5]); pu.w = pack2(s[o + 6], s[o + 7]);
  return __builtin_bit_cast(bf16x8, pu);
}
__device__ __forceinline__ void attn_qk(const u16* kp, const bf16x8 (&qa)[6], f32x16& s0, f32x16& s1) {
#pragma unroll
  for (int ks = 0; ks < 6; ++ks) {
    bf16x8 k0 = *(const bf16x8*)(kp + ks * 16);
    bf16x8 k1 = *(const bf16x8*)(kp + 32 * KLD + ks * 16);
    s0 = mfma32(k0, qa[ks], s0);
    s1 = mfma32(k1, qa[ks], s1);
  }
}
__device__ __forceinline__ void attn_tile(const u16* sb, const bf16x8 (&qa)[6], f32x16& o0, f32x16& o1, f32x16& lacc,
                                          float& m, bool& mz, int r, int h, bool first) {
  const u16* kp = sb + r * KLD + h * 8;
  f32x16 s0, s1;
  __builtin_amdgcn_s_setprio(1);
  if (mz) {
#pragma unroll
    for (int i = 0; i < 16; ++i) { s0[i] = 0.f; s1[i] = 0.f; }
    attn_qk(kp, qa, s0, s1);
  } else {
#pragma unroll
    for (int i = 0; i < 16; ++i) { s0[i] = -m; s1[i] = -m; }
    attn_qk(kp, qa, s0, s1);
  }
  __builtin_amdgcn_s_setprio(0);
  float mxa = max3f(s0[0], s0[1], s0[2]), mxb = max3f(s0[3], s0[4], s0[5]);
  float mxc = max3f(s0[6], s0[7], s0[8]), mxd = max3f(s0[9], s0[10], s0[11]);
  mxa = max3f(mxa, s0[12], s0[13]); mxb = max3f(mxb, s0[14], s0[15]);
  mxc = max3f(mxc, s1[0], s1[1]); mxd = max3f(mxd, s1[2], s1[3]);
  mxa = max3f(mxa, s1[4], s1[5]); mxb = max3f(mxb, s1[6], s1[7]);
  mxc = max3f(mxc, s1[8], s1[9]); mxd = max3f(mxd, s1[10], s1[11]);
  mxa = max3f(mxa, s1[12], s1[13]); mxb = max3f(mxb, s1[14], s1[15]);
  const float lm = max3f(mxa, mxb, fmaxf(mxc, mxd));
  bool slow;
  if (first) {
    const float mx = fmaxf(lm, __shfl_xor(lm, 32));
    slow = __any(mx > 30.f || mx < -30.f);
  } else {
    slow = __any(lm > 30.f);
  }
  if (slow) {
    const float mx = fmaxf(lm, __shfl_xor(lm, 32));
    const float d = first ? mx : fmaxf(mx, 0.f);
    const float alpha = first ? 1.f : __builtin_amdgcn_exp2f(-d);
    m += d;
    mz = false;
#pragma unroll
    for (int i = 0; i < 16; ++i) { s0[i] -= d; s1[i] -= d; o0[i] *= alpha; o1[i] *= alpha; }
    lacc[0] *= alpha;
  }
  float pa = 0.f, pb = 0.f, pc = 0.f, pd = 0.f;
#pragma unroll
  for (int i = 0; i < 16; ++i) {
    s0[i] = __builtin_amdgcn_exp2f(s0[i]); s1[i] = __builtin_amdgcn_exp2f(s1[i]);
    if ((i & 3) == 0) pa += s0[i] + s1[i];
    else if ((i & 3) == 1) pb += s0[i] + s1[i];
    else if ((i & 3) == 2) pc += s0[i] + s1[i];
    else pd += s0[i] + s1[i];
  }
  lacc[0] += (pa + pb) + (pc + pd);
  const u16* vp = sb + 64 * KLD + r * VLD + 8 * h;
  __builtin_amdgcn_s_setprio(1);
#pragma unroll
  for (int kb = 0; kb < 2; ++kb) {
#pragma unroll
    for (int s = 0; s < 2; ++s) {
      const bf16x8 pf = pack_p(kb == 0 ? s0 : s1, 8 * s);
      const int koff = kb * 32 + 16 * s;
      const bf16x8 v0 = *(const bf16x8*)(vp + koff);
      const bf16x8 v1 = *(const bf16x8*)(vp + 32 * VLD + koff);
      o0 = mfma32(v0, pf, o0);
      o1 = mfma32(v1, pf, o1);
    }
  }
  __builtin_amdgcn_s_setprio(0);
}
__device__ __forceinline__ void attn_write_o(u16* op, const f32x16& o0, const f32x16& o1, float inv) {
#pragma unroll
  for (int g = 0; g < 4; ++g) {
    uint2 v;
    v.x = pack2(o0[4 * g] * inv, o0[4 * g + 1] * inv); v.y = pack2(o0[4 * g + 2] * inv, o0[4 * g + 3] * inv);
    *(uint2*)(op + 8 * g) = v;
    v.x = pack2(o1[4 * g] * inv, o1[4 * g + 1] * inv); v.y = pack2(o1[4 * g + 2] * inv, o1[4 * g + 3] * inv);
    *(uint2*)(op + 32 + 8 * g) = v;
  }
}

__device__ void item_attn(PP p, int qb, int b, int hh, u16* lds) {
  p = launder(p);
  const int tid = opaque_tid(), lane = tid & 63, w = tid >> 6, r = lane & 31, h = lane >> 5;
  const size_t tokbase = (size_t)b * SEQ;
  const int q0 = qb * 128 + w * 32;
  bf16x8 qa[6];
  {
    const u16* qp = p->Q + ((tokbase + q0 + r) * 6 + hh) * 96 + h * 8;
#pragma unroll
    for (int ks = 0; ks < 6; ++ks) qa[ks] = *(const bf16x8*)(qp + ks * 16);
  }
  f32x16 oa0, oa1, lacc;
#pragma unroll
  for (int i = 0; i < 16; ++i) { oa0[i] = 0.f; oa1[i] = 0.f; lacc[i] = 0.f; }
  float ma = 0.f;
  bool mz = true;
  const int ntiles = 2 * qb + 2;
  const int my_ntiles = 2 * qb + 1 + (w >> 1);
  const u16* kg = p->K + (size_t)(b * 6 + hh) * SEQ * 96 + tid * 8;
  const u16* vg = p->VT + (size_t)(b * 6 + hh) * SEQ * 64 + tid * 8;
  const int id1 = tid + 256, id2 = tid + 512;
  const int kl0 = (tid / 12) * KLD + (tid % 12) * 8;
  const int kl1 = (id1 / 12) * KLD + (id1 % 12) * 8;
  const int kl2 = (id2 / 12) * KLD + (id2 % 12) * 8;
  const int vl = 64 * KLD + (tid >> 3) * VLD + (tid & 7) * 8;
  AStage A, B;
  as_load(B, kg, vg, 0);
  as_load(A, kg, vg, 1);
  as_store(B, lds, kl0, kl1, kl2, vl);
  __syncthreads();
  for (int kt = 0; kt < ntiles; kt += 2) {
    if (kt + 2 < ntiles) as_load(B, kg, vg, kt + 2);
    attn_tile(lds, qa, oa0, oa1, lacc, ma, mz, r, h, kt == 0);
    as_store(A, lds + ATT_STAGE, kl0, kl1, kl2, vl);
    __syncthreads();
    if (kt + 3 < ntiles) as_load(A, kg, vg, kt + 3);
    if (kt + 1 < my_ntiles) attn_tile(lds + ATT_STAGE, qa, oa0, oa1, lacc, ma, mz, r, h, false);
    if (kt + 2 < ntiles) as_store(B, lds, kl0, kl1, kl2, vl);
    __syncthreads();
  }
  const float lta = lacc[0] + __shfl_xor(lacc[0], 32);
  u16* op = p->obuf + (tokbase + q0 + r) * 384 + hh * 64 + 4 * h;
  attn_write_o(op, oa0, oa1, 1.f / lta);
}

__device__ void phase_y(PP p, int l) {
  p = launder(p);
  const int tid_ = opaque_tid();
  const int lane = tid_ & 63;
  const int gw = blockIdx.x * 4 + (tid_ >> 6), nw = gridDim.x * 4;
  const float* bg = p->br_g + l * DM + lane * 16;
  const int seg = (lane < 24) ? 0 : (lane < 48) ? 1 : 2;
  const u16* xbase; const u16* gbase; size_t xs, gs;
  if (seg == 0) { xbase = p->hloc + lane * 16; xs = 384; gbase = p->proj + C_GA + lane * 16; gs = DINP; }
  else if (seg == 1) { xbase = p->obuf + (lane - 24) * 16; xs = 384; gbase = p->proj + C_GB + (lane - 24) * 16; gs = DINP; }
  else { xbase = p->ycpre + (lane - 48) * 16; xs = 256; gbase = xbase; gs = 256; }
  for (int tok0 = gw; tok0 < T_TOK; tok0 += 2 * nw) {
    const int tok1 = (tok0 + nw < T_TOK) ? tok0 + nw : tok0;
    uint4 xr[2][2], gr[2][2], cr_[2][2];
    float4 cy[2][4];
#pragma unroll
    for (int t = 0; t < 2; ++t) {
      const size_t tok = (size_t)(t ? tok1 : tok0);
      xr[t][0] = *(const uint4*)(xbase + tok * xs); xr[t][1] = *(const uint4*)(xbase + tok * xs + 8);
      gr[t][0] = *(const uint4*)(gbase + tok * gs); gr[t][1] = *(const uint4*)(gbase + tok * gs + 8);
    }
    if (seg == 0) {
#pragma unroll
      for (int t = 0; t < 2; ++t) {
        const size_t tok = (size_t)(t ? tok1 : tok0);
        cr_[t][0] = *(const uint4*)(p->cum + tok * 384 + lane * 16); cr_[t][1] = *(const uint4*)(p->cum + tok * 384 + lane * 16 + 8);
        const float* cp = p->carry + (tok >> 6) * 384 + lane * 16;
#pragma unroll
        for (int i = 0; i < 4; ++i) cy[t][i] = *(const float4*)(cp + 4 * i);
      }
    }
#pragma unroll
    for (int t = 0; t < 2; ++t) {
      const size_t tok = (size_t)(t ? tok1 : tok0);
      float v[16], g[16];
      unpack8(xr[t][0], v); unpack8(xr[t][1], v + 8);
      unpack8(gr[t][0], g); unpack8(gr[t][1], g + 8);
      if (seg == 0) {
        float cm[16];
        unpack8(cr_[t][0], cm); unpack8(cr_[t][1], cm + 8);
#pragma unroll
        for (int i = 0; i < 4; ++i) {
          v[4 * i] += cm[4 * i] * cy[t][i].x; v[4 * i + 1] += cm[4 * i + 1] * cy[t][i].y;
          v[4 * i + 2] += cm[4 * i + 2] * cy[t][i].z; v[4 * i + 3] += cm[4 * i + 3] * cy[t][i].w;
        }
      }
      if (seg < 2) {
#pragma unroll
        for (int j = 0; j < 16; ++j) v[j] *= siluf_(g[j]);
      }
      float ss = 0.f;
#pragma unroll
      for (int j = 0; j < 16; ++j) ss += v[j] * v[j];
      const float sa = wave_sum(seg == 0 ? ss : 0.f);
      const float sb = wave_sum(seg == 1 ? ss : 0.f);
      const float sc = wave_sum(seg == 2 ? ss : 0.f);
      const float rs = (seg == 0) ? rsqrtf(sa * (1.f / 384.f) + EPSF)
                     : (seg == 1) ? rsqrtf(sb * (1.f / 384.f) + EPSF) : rsqrtf(sc * (1.f / 256.f) + EPSF);
      float o[16];
#pragma unroll
      for (int j = 0; j < 16; ++j) o[j] = v[j] * rs * bg[j];
      *(uint4*)(p->hbuf + tok * DM + lane * 16) = pack8(o);
      *(uint4*)(p->hbuf + tok * DM + lane * 16 + 8) = pack8(o + 8);
    }
  }
}

__device__ __forceinline__ int next_item(int* counter, int* slot) {
  __syncthreads();
  if (threadIdx.x == 0) *slot = atomicAdd(counter, 1);
  __syncthreads();
  return *slot;
}


#define XB_TMO      128
#define XB_XCNT(j)  (256  + 64 * (j))
#define XB_XSUB(j)  (1280 + 64 * (j))
#define XB_XGEN(j)  (2304 + 64 * (j))
#define XB_TOP      3328
#define XB_TOPGEN   3392
#define XCD_BAR_WORDS 3456
#define XB_SPIN_CAP (1u << 18)
#define LAS __attribute__((address_space(3)))
__device__ __forceinline__ unsigned xb_ld(unsigned* p)              { return __hip_atomic_load(p, __ATOMIC_RELAXED, __HIP_MEMORY_SCOPE_AGENT); }
__device__ __forceinline__ unsigned xb_add(unsigned* p, unsigned v) { return __hip_atomic_fetch_add(p, v, __ATOMIC_RELAXED, __HIP_MEMORY_SCOPE_AGENT); }
__device__ __forceinline__ unsigned xb_xcc_id() { return (unsigned)__builtin_amdgcn_s_getreg((3 << 11) | 20) & 0xFu; }
#define XB_SPIN(cond, bar) do { unsigned _sp = 0; while (cond) { __builtin_amdgcn_s_sleep(1); \
    if ((++_sp & 255u) == 0u) { if (xb_ld(&(bar)[XB_TMO])) break; if (_sp > XB_SPIN_CAP) { atomicAdd(&(bar)[XB_TMO], 1u); break; } } } } while (0)
struct XcdBarrier { unsigned* bar; unsigned x; volatile LAS unsigned* st; };
__device__ __forceinline__ XcdBarrier xcd_barrier_post(unsigned* bar, volatile LAS unsigned* st) {
    XcdBarrier b; b.bar = bar; b.x = xb_xcc_id(); b.st = st;
    if (threadIdx.x == 0) (void)xb_add(&bar[XB_XCNT(b.x)], 1u);
    return b;
}
__device__ __forceinline__ void xcd_barrier_complete(unsigned* bar, unsigned x, unsigned& nloc, unsigned& nx) {
    const unsigned G = gridDim.x * gridDim.y * gridDim.z;
    unsigned sum, cnt, mine, sp = 0u;
    for (;;) {
        sum = 0u; cnt = 0u; mine = 0u;
#pragma unroll
        for (unsigned j = 0; j < 16; ++j) { const unsigned c = xb_ld(&bar[XB_XCNT(j)]); sum += c; cnt += (c > 0u) ? 1u : 0u; mine = (j == x) ? c : mine; }
        if (sum == G) break;
        __builtin_amdgcn_s_sleep(1);
        if ((++sp & 255u) == 0u) { if (xb_ld(&bar[XB_TMO])) break; if (sp > XB_SPIN_CAP) { atomicAdd(&bar[XB_TMO], 1u); break; } }
    }
    nloc = mine > 0u ? mine : 1u; nx = cnt > 0u ? cnt : 1u;
}
__device__ __forceinline__ void xcd_barrier(const XcdBarrier& b) {
    asm volatile("s_waitcnt vmcnt(0)" ::: "memory");
    __syncthreads();
    if (threadIdx.x == 0) {
        unsigned* bar = b.bar;
        __builtin_amdgcn_s_waitcnt(0);
        unsigned nloc = b.st[0], nx = b.st[1];
        if (nloc == 0u) { xcd_barrier_complete(bar, b.x, nloc, nx); b.st[0] = nloc; b.st[1] = nx; }
        const unsigned old = xb_add(&bar[XB_XSUB(b.x)], 1u);
        const unsigned gen = old / nloc;
        if (old + 1u == (gen + 1u) * nloc) {
            __builtin_amdgcn_fence(__ATOMIC_RELEASE, "agent");
            asm volatile("s_waitcnt vmcnt(0)" ::: "memory");
            const unsigned og = xb_add(&bar[XB_TOP], 1u);
            const unsigned tg = og / nx;
            if (og + 1u == (tg + 1u) * nx) xb_add(&bar[XB_TOPGEN], 1u);
            else XB_SPIN(xb_ld(&bar[XB_TOPGEN]) == tg, bar);
            __builtin_amdgcn_fence(__ATOMIC_ACQUIRE, "agent");
            xb_add(&bar[XB_XGEN(b.x)], 1u);
            asm volatile("s_waitcnt vmcnt(0)" ::: "memory");
        } else {
            XB_SPIN(xb_ld(&bar[XB_XGEN(b.x)]) == gen, bar);
            __builtin_amdgcn_fence(__ATOMIC_ACQUIRE, "agent");
            asm volatile("s_waitcnt vmcnt(0)" ::: "memory");
        }
    }
    __syncthreads();
}

#define N_PHASES (1 + 6 * NLAYER + 1)

__device__ void run_phase(PP p, int ph, u16* lds, float* ssm, int* slot, int rep) {
  int l = (ph - 1) / 6, sub = (ph - 1) % 6 + 1;
  if (ph == 0) { sub = 0; l = 0; }
  if (ph == N_PHASES - 1) { sub = 1; l = NLAYER; }
#ifdef ONLYSUB
  sub = ONLYSUB;
#endif
  const int bid = blockIdx.x, nb = gridDim.x;
  if (sub == 0) { phase_prep(p, (float*)lds); return; }
  if (sub == 1) { phase_norm(p, l); return; }
  if (sub == 2) {
    gemm_phase(p->wInT + (size_t)l * DINP * DM, DM, p->hbuf, DM, DM, p->proj, DINP, 18, 256 * 18, lds);
    return;
  }
  if (sub == 3) {
    int* ctr = p->counters + l * 16 + rep * 64;
    for (;;) {
      int it = next_item(ctr, slot);
      if (it >= 256 + 256 + 256 + 3072) break;
      if (it < 256) item_sgu(p, l, it, lds, ssm);
      else if (it < 512) {
        const int rt = it - 256;
#pragma unroll 1
        for (int h2 = 0; h2 < 6; ++h2) item_q(p, l, rt, h2, lds, ssm, h2 == 0);
      } else if (it < 768) {
        const int rt = it - 512;
#pragma unroll 1
        for (int h2 = 0; h2 < 6; ++h2) item_kv(p, l, rt, h2, lds, ssm, h2 == 0);
      } else { const int k = it - 768; item_lru(p, l, k / 6, k % 6, lds, ssm); }
    }
    return;
  }
  if (sub == 4) {
    if (bid < 6) item_carry(p, bid);
    const int xq = (int)(xb_xcc_id() & 7u);
    int* cbase = p->counters + l * 16 + 8 + rep * 64;
    for (;;) {
      __syncthreads();
      if (threadIdx.x == 0) {
        int got = -1;
        for (int dq = 0; dq < 8 && got < 0; ++dq) {
          const int q = (xq + dq) & 7;
          if (__hip_atomic_load(cbase + q, __ATOMIC_RELAXED, __HIP_MEMORY_SCOPE_AGENT) < 192) {
            const int it = atomicAdd(cbase + q, 1);
            if (it < 192) got = q * 256 + it;
          }
        }
        *slot = got;
      }
      __syncthreads();
      const int got = *slot;
      if (got < 0) break;
      const int q = got >> 8, it = got & 255;
      int qb, bh;
      if (it < 64) { qb = 63 - it; bh = q * 3; }
      else { const int j = it - 64; qb = 63 - (j >> 1); bh = q * 3 + 1 + (j & 1); }
      item_attn(p, qb, bh / 6, bh % 6, lds);
    }
    return;
  }
  if (sub == 5) { phase_y(p, l); return; }
  gemm_phase(p->wOutT + (size_t)l * DM * DM, DM, p->hbuf, DM, DM, p->y2, DM, 8, 256 * 8, lds);
}

__global__ void __launch_bounds__(256, 2) mega_kernel(Params p, int ph_begin, int ph_end) {
  __shared__ __attribute__((aligned(16))) unsigned char lds_raw[LDS_BYTES];
  __shared__ float ssm[512];
  __shared__ int slot;
  u16* lds = (u16*)lds_raw;
  PP pp = (PP)__builtin_amdgcn_kernarg_segment_ptr();
#if COOP
  cg::grid_group grid = cg::this_grid();
  __shared__ uint4 xb_words;
  if (threadIdx.x == 0) xb_words = make_uint4(0u, 0u, 0u, 0u);
  __syncthreads();
  XcdBarrier xb = xcd_barrier_post(pp->bar, (volatile LAS unsigned*)&xb_words);
#endif
  int rep = 0;
  for (int ph = ph_begin; ph < ph_end;) {
    run_phase(launder(pp), ph, lds, ssm, &slot, rep);
    bool again = false;
#if COOP
#ifdef REPEAT_SUB
    if (ph > 0 && ph < N_PHASES - 1) {
      if (REPEAT_SUB == 99) { xcd_barrier(xb); xcd_barrier(xb); xcd_barrier(xb); xcd_barrier(xb); }
      else if (((ph - 1) % 6 + 1) == REPEAT_SUB && rep == 0) again = true;
    }
#endif
    if (again || ph + 1 < ph_end) {
      if (ph_end > 1000) grid.sync();
      xcd_barrier(xb);
    }
#endif
    if (again) rep = 1; else { rep = 0; ++ph; }
  }
}

extern "C" void kernel_launch(void* const* d_in, const int* in_sizes, int n_in, void* d_out, int out_size, void* d_ws,
                              size_t ws_size, hipStream_t stream) {
  Params p{};
  p.x = (const float*)d_in[0]; p.pos = (const int*)d_in[1]; p.pre_g = (const float*)d_in[2]; p.w_in = (const float*)d_in[3];
  p.conv_w = (const float*)d_in[4]; p.conv_b = (const float*)d_in[5]; p.lru_wa = (const float*)d_in[6]; p.lru_ba = (const float*)d_in[7];
  p.lru_wx = (const float*)d_in[8]; p.lru_bx = (const float*)d_in[9]; p.lru_lam = (const float*)d_in[10]; p.q_g = (const float*)d_in[11];
  p.w_uq = (const float*)d_in[12]; p.kv_g = (const float*)d_in[13]; p.w_ukv = (const float*)d_in[14]; p.sgu_g = (const float*)d_in[15];
  p.sgu_bn = (const float*)d_in[16]; p.sgu_w = (const float*)d_in[17]; p.sgu_b = (const float*)d_in[18]; p.br_g = (const float*)d_in[19];
  p.w_out = (const float*)d_in[20]; p.post_g = (const float*)d_in[21];
  p.out = (float*)d_out;
  unsigned char* ws = (unsigned char*)d_ws;
  size_t off = 0;
  auto take = [&](size_t bytes) { unsigned char* q = ws + off; off += (bytes + 255) & ~(size_t)255; return q; };
  p.counters = (int*)take(1024);
  p.bar = (unsigned*)take(XCD_BAR_WORDS * 4);
  p.wInT = (u16*)take((size_t)NLAYER * DINP * DM * 2);
  p.wOutT = (u16*)take((size_t)NLAYER * DM * DM * 2);
  p.wUqT = (u16*)take((size_t)NLAYER * 768 * 192 * 2);
  p.wUkvT = (u16*)take((size_t)NLAYER * 768 * 128 * 2);
  p.waT = (u16*)take((size_t)NLAYER * 6 * 4096 * 2);
  p.wxT = (u16*)take((size_t)NLAYER * 6 * 4096 * 2);
  p.sguW = (u16*)take((size_t)NLAYER * 4 * 128 * 128 * 2);
  p.tab = (float2*)take((size_t)T_TOK * 16 * 8);
  p.hbuf = (u16*)take((size_t)T_TOK * DM * 2);
  p.proj = (u16*)take((size_t)T_TOK * DINP * 2);
  p.y2 = (u16*)take((size_t)T_TOK * DM * 2);
  p.Q = (u16*)take((size_t)T_TOK * 576 * 2);
  p.K = (u16*)take((size_t)T_TOK * 576 * 2);
  p.VT = (u16*)take((size_t)T_TOK * 384 * 2);
  p.hloc = (u16*)take((size_t)T_TOK * 384 * 2);
  p.cum = (u16*)take((size_t)T_TOK * 384 * 2);
  p.Ptile = (float*)take((size_t)512 * 384 * 4);
  p.Htile = (float*)take((size_t)512 * 384 * 4);
  p.carry = (float*)take((size_t)512 * 384 * 4);
  p.obuf = (u16*)take((size_t)T_TOK * 384 * 2);
  p.ycpre = (u16*)take((size_t)T_TOK * 256 * 2);
  if (off > ws_size) { fprintf(stderr, "workspace too small: need %zu have %zu\n", off, ws_size); return; }

  static int grid_blocks = 0;
  if (!grid_blocks) {
    int dev = 0, cus = 0, per_cu = 0;
    hipGetDevice(&dev);
    hipDeviceGetAttribute(&cus, hipDeviceAttributeMultiprocessorCount, dev);
    hipOccupancyMaxActiveBlocksPerMultiprocessor(&per_cu, mega_kernel, 256, 0);
    if (per_cu > 2) per_cu = 2;
    if (per_cu < 1) per_cu = 1;
    grid_blocks = cus * per_cu;
  }
#if COOP
  (void)hipMemsetAsync(d_ws, 0, 1024 + ((XCD_BAR_WORDS * 4 + 255) & ~255), stream);
  int pb = 0, pe = N_PHASES;
  void* args[] = {&p, &pb, &pe};
  hipError_t e = hipLaunchCooperativeKernel((void*)mega_kernel, dim3(grid_blocks), dim3(256), args, 0, stream);
  if (e != hipSuccess) fprintf(stderr, "cooperative launch failed: %s (grid %d)\n", hipGetErrorString(e), grid_blocks);
#else
  for (int ph = 0; ph < N_PHASES; ++ph) mega_kernel<<<grid_blocks, 256, 0, stream>>>(p, ph, ph + 1);
#endif
}
```

```cpp
#include <hip/hip_runtime.h>
#include <hip/hip_cooperative_groups.h>
#include <stdint.h>
#include <stdio.h>
namespace cg = cooperative_groups;

typedef unsigned short u16;
typedef __attribute__((ext_vector_type(8))) short bf16x8;
typedef __attribute__((ext_vector_type(16))) float f32x16;
typedef __attribute__((ext_vector_type(4))) unsigned u32x4;
typedef __attribute__((ext_vector_type(2))) unsigned u32x2;

#ifndef COOP
#define COOP 1
#endif

#define T_TOK 32768
#define SEQ 8192
#define DM 1024
#define DIN 2272
#define DINP 2304
#define NLAYER 4
#define EPSF 1e-6f
#define C_XA 0
#define C_GA 384
#define C_QL 768
#define C_KVL 960
#define C_KR 1088
#define C_GB 1120
#define C_U 1504
#define C_V 1760
#define C_GC 2016

#define LDT 72
#define TILE_U16 (128 * LDT)
#define LDS_BYTES 73728

struct Params {
  const float* x; const int* pos; const float* pre_g; const float* w_in; const float* conv_w; const float* conv_b;
  const float* lru_wa; const float* lru_ba; const float* lru_wx; const float* lru_bx; const float* lru_lam;
  const float* q_g; const float* w_uq; const float* kv_g; const float* w_ukv; const float* sgu_g; const float* sgu_bn;
  const float* sgu_w; const float* sgu_b; const float* br_g; const float* w_out; const float* post_g;
  float* out;
  u16* wInT; u16* wOutT; u16* wUqT; u16* wUkvT; u16* waT; u16* wxT; u16* sguW;
  float2* tab; int* counters; unsigned* bar;
  u16* hbuf;
  u16* proj;
  u16* y2;
  u16* Q; u16* K; u16* VT;
  u16* hloc; u16* cum; float* Ptile; float* Htile; float* carry;
  u16* obuf; u16* ycpre;
};

__device__ const double c_invfreq_rev[16] = {1.59154943091895345608e-01, 8.94994016088910132600e-02, 5.03292121044870352509e-02, 2.83021958306233986646e-02, 1.59154943091895338669e-02, 8.94994016088910236684e-03, 5.03292121044870369856e-03, 2.83021958306233986646e-03, 1.59154943091895356017e-03, 8.94994016088910236684e-04, 5.03292121044870326488e-04, 2.83021958306233954120e-04, 1.59154943091895350596e-04, 8.94994016088910182474e-05, 5.03292121044870353593e-05, 2.83021958306233960897e-05};
typedef const __attribute__((address_space(4))) Params* PP;
__device__ __forceinline__ PP launder(PP q) { asm volatile("" : "+s"(q)); return q; }
__device__ __forceinline__ float bf2f(u16 b) { return __uint_as_float(((unsigned)b) << 16); }
typedef __attribute__((ext_vector_type(2))) __bf16 bf16x2_t;
__device__ __forceinline__ u16 f2bf(float f) { return __builtin_bit_cast(u16, (__bf16)f); }
__device__ __forceinline__ unsigned pack2(float a, float b) { bf16x2_t v = {(__bf16)a, (__bf16)b}; return __builtin_bit_cast(unsigned, v); }
__device__ __forceinline__ float lo16(unsigned u) { return __uint_as_float(u << 16); }
__device__ __forceinline__ float hi16(unsigned u) { return __uint_as_float(u & 0xffff0000u); }
__device__ __forceinline__ void unpack8(uint4 a, float* v) {
  v[0] = lo16(a.x); v[1] = hi16(a.x); v[2] = lo16(a.y); v[3] = hi16(a.y);
  v[4] = lo16(a.z); v[5] = hi16(a.z); v[6] = lo16(a.w); v[7] = hi16(a.w);
}
__device__ __forceinline__ uint4 pack8(const float* v) {
  uint4 a; a.x = pack2(v[0], v[1]); a.y = pack2(v[2], v[3]); a.z = pack2(v[4], v[5]); a.w = pack2(v[6], v[7]); return a;
}
__device__ __forceinline__ float sigmoidf_(float x) { return __builtin_amdgcn_rcpf(1.f + __expf(-x)); }
__device__ __forceinline__ float siluf_(float x) { return x * __builtin_amdgcn_rcpf(1.f + __expf(-x)); }
__device__ __forceinline__ float geluf_(float x) {
  float u = 1.5957691216057308f * (x + 0.044715f * x * x * x);
  return x * __builtin_amdgcn_rcpf(1.f + __expf(-u));
}
__device__ __forceinline__ float wave_sum(float v) {
#pragma unroll
  for (int o = 32; o >= 1; o >>= 1) v += __shfl_xor(v, o);
  return v;
}
__device__ __forceinline__ int opaque_tid() { int t = threadIdx.x; asm volatile("" : "+v"(t)); return t; }
__device__ __forceinline__ f32x16 mfma32(bf16x8 a, bf16x8 b, f32x16 c) {
  return __builtin_amdgcn_mfma_f32_32x32x16_bf16(a, b, c, 0, 0, 0);
}

struct GStage { u32x4 w0, w1, w2, w3, x0, x1, x2, x3; };
__device__ __forceinline__ void gs_load(GStage& g, const u16* gw, int ldw, const u16* gx, int ldx, int k0) {
  g.w0 = *(const u32x4*)(gw + k0);
  g.w1 = *(const u32x4*)(gw + (size_t)32 * ldw + k0);
  g.w2 = *(const u32x4*)(gw + (size_t)64 * ldw + k0);
  g.w3 = *(const u32x4*)(gw + (size_t)96 * ldw + k0);
  g.x0 = *(const u32x4*)(gx + k0);
  g.x1 = *(const u32x4*)(gx + (size_t)32 * ldx + k0);
  g.x2 = *(const u32x4*)(gx + (size_t)64 * ldx + k0);
  g.x3 = *(const u32x4*)(gx + (size_t)96 * ldx + k0);
}
__device__ __forceinline__ void gs_store(const GStage& g, u16* db, int lo) {
  *(u32x4*)(db + lo) = g.w0;
  *(u32x4*)(db + lo + 32 * LDT) = g.w1;
  *(u32x4*)(db + lo + 64 * LDT) = g.w2;
  *(u32x4*)(db + lo + 96 * LDT) = g.w3;
  *(u32x4*)(db + TILE_U16 + lo) = g.x0;
  *(u32x4*)(db + TILE_U16 + lo + 32 * LDT) = g.x1;
  *(u32x4*)(db + TILE_U16 + lo + 64 * LDT) = g.x2;
  *(u32x4*)(db + TILE_U16 + lo + 96 * LDT) = g.x3;
}
__device__ __forceinline__ void gemm_kstep(const u16* sb, int wn, int wt, int r, int h, f32x16 (&acc)[2][2]) {
  const u16* bw = sb + (wn * 64 + r) * LDT + h * 8;
  const u16* bx = sb + TILE_U16 + (wt * 64 + r) * LDT + h * 8;
  __builtin_amdgcn_s_setprio(1);
#pragma unroll
  for (int ks = 0; ks < 4; ++ks) {
    bf16x8 a0 = *(const bf16x8*)(bw + ks * 16);
    bf16x8 a1 = *(const bf16x8*)(bw + 32 * LDT + ks * 16);
    bf16x8 b0 = *(const bf16x8*)(bx + ks * 16);
    bf16x8 b1 = *(const bf16x8*)(bx + 32 * LDT + ks * 16);
    acc[0][0] = mfma32(a0, b0, acc[0][0]);
    acc[0][1] = mfma32(a0, b1, acc[0][1]);
    acc[1][0] = mfma32(a1, b0, acc[1][0]);
    acc[1][1] = mfma32(a1, b1, acc[1][1]);
  }
  __builtin_amdgcn_s_setprio(0);
}
__device__ __forceinline__ void gemm_tile(const u16* __restrict__ W, int ldw, const u16* __restrict__ X, int ldx,
                                          int K, u16* lds, f32x16 (&acc)[2][2]) {
  const int tid = opaque_tid(), lane = tid & 63, w = tid >> 6, r = lane & 31, h = lane >> 5;
  const int wn = w >> 1, wt = w & 1;
#pragma unroll
  for (int a = 0; a < 2; ++a)
#pragma unroll
    for (int b = 0; b < 2; ++b)
#pragma unroll
      for (int i = 0; i < 16; ++i) acc[a][b][i] = 0.f;
  const int lrow = tid >> 3, lc = tid & 7;
  const u16* gw = W + (size_t)lrow * ldw + lc * 8;
  const u16* gx = X + (size_t)lrow * ldx + lc * 8;
  const int lo = lrow * LDT + lc * 8;
  const int nk = K >> 6;
  GStage A, B;
  gs_load(B, gw, ldw, gx, ldx, 0);
  if (nk > 1) gs_load(A, gw, ldw, gx, ldx, 64);
  gs_store(B, lds, lo);
  __syncthreads();
  for (int kt = 0; kt < nk; kt += 2) {
    if (kt + 2 < nk) gs_load(B, gw, ldw, gx, ldx, (kt + 2) * 64);
    gemm_kstep(lds, wn, wt, r, h, acc);
    if (kt + 1 < nk) gs_store(A, lds + 2 * TILE_U16, lo);
    __syncthreads();
    if (kt + 1 < nk) {
      if (kt + 3 < nk) gs_load(A, gw, ldw, gx, ldx, (kt + 3) * 64);
      gemm_kstep(lds + 2 * TILE_U16, wn, wt, r, h, acc);
      if (kt + 2 < nk) gs_store(B, lds, lo);
      __syncthreads();
    }
  }
}

__device__ __forceinline__ void stage_f32(float* st, f32x16 (&acc)[2][2]) {
  const int tid = opaque_tid(), lane = tid & 63, w = tid >> 6, r = lane & 31, h = lane >> 5;
  const int wn = w >> 1, wt = w & 1;
#pragma unroll
  for (int nb = 0; nb < 2; ++nb)
#pragma unroll
    for (int tb = 0; tb < 2; ++tb) {
      const int token = wt * 64 + tb * 32 + r;
#pragma unroll
      for (int g = 0; g < 4; ++g) {
        const int n0 = wn * 64 + nb * 32 + 8 * g + 4 * h;
        float4 v = make_float4(acc[nb][tb][4 * g], acc[nb][tb][4 * g + 1], acc[nb][tb][4 * g + 2], acc[nb][tb][4 * g + 3]);
        *(float4*)(st + token * 132 + n0) = v;
      }
    }
}
__device__ __forceinline__ void stage_bf16(u16* st, f32x16 (&acc)[2][2]) {
  const int tid = opaque_tid(), lane = tid & 63, w = tid >> 6, r = lane & 31, h = lane >> 5;
  const int wn = w >> 1, wt = w & 1;
#pragma unroll
  for (int nb = 0; nb < 2; ++nb)
#pragma unroll
    for (int tb = 0; tb < 2; ++tb) {
      const int token = wt * 64 + tb * 32 + r;
#pragma unroll
      for (int g = 0; g < 4; ++g) {
        const int n0 = wn * 64 + nb * 32 + 8 * g + 4 * h;
        uint2 v;
        v.x = pack2(acc[nb][tb][4 * g], acc[nb][tb][4 * g + 1]);
        v.y = pack2(acc[nb][tb][4 * g + 2], acc[nb][tb][4 * g + 3]);
        *(uint2*)(st + token * 136 + n0) = v;
      }
    }
}

__device__ void gemm_store_tile(const u16* W, int ldw, const u16* X, int ldx, int K, u16* out, int ldo, u16* lds) {
  f32x16 acc[2][2];
  gemm_tile(W, ldw, X, ldx, K, lds, acc);
  stage_bf16(lds, acc);
  __syncthreads();
  const int tid = opaque_tid();
#pragma unroll
  for (int i = 0; i < 8; ++i) {
    const int id = tid + 256 * i;
    const int row = id >> 4, c = id & 15;
    uint4 v = *(const uint4*)(lds + row * 136 + c * 8);
    *(uint4*)(out + (size_t)row * ldo + c * 8) = v;
  }
  __syncthreads();
}

__device__ void gemm_phase(const u16* __restrict__ Wb, int ldw, const u16* __restrict__ Xb, int ldx, int K,
                           u16* __restrict__ outb, int ldo, int ntn, int ntiles, u16* lds) {
  const int tid = opaque_tid(), lane = tid & 63, w = tid >> 6, r = lane & 31, h = lane >> 5;
  const int wn = w >> 1, wt = w & 1;
  const int lrow = tid >> 3, lc = tid & 7;
  const int lo = lrow * LDT + lc * 8;
  const int nk = K >> 6;
  const int nbl = gridDim.x >> 3;
  const int xl = blockIdx.x & 7, jl = blockIdx.x >> 3;
  const int mt_per = (ntiles / ntn) >> 3;
  const int L = mt_per * ntn;
  int q = jl;
  if (q >= L) return;
#define GP_MT(qq) (xl * mt_per + ((qq) / (8 * ntn)) * 8 + ((qq) % (8 * ntn)) % 8)
#define GP_NT(qq) (((qq) % (8 * ntn)) / 8)
  const u16* gw = Wb + (size_t)(GP_NT(q) * 128 + lrow) * ldw + lc * 8;
  const u16* gx = Xb + (size_t)(GP_MT(q) * 128 + lrow) * ldx + lc * 8;
  GStage A, B;
  gs_load(B, gw, ldw, gx, ldx, 0);
  gs_load(A, gw, ldw, gx, ldx, 64);
  for (; q < L; q += nbl) {
    const int qn = q + nbl;
    const bool has_next = qn < L;
    const int qq = has_next ? qn : q;
    const u16* gwn = Wb + (size_t)(GP_NT(qq) * 128 + lrow) * ldw + lc * 8;
    const u16* gxn = Xb + (size_t)(GP_MT(qq) * 128 + lrow) * ldx + lc * 8;
    f32x16 acc[2][2];
#pragma unroll
    for (int a = 0; a < 2; ++a)
#pragma unroll
      for (int b = 0; b < 2; ++b)
#pragma unroll
        for (int i = 0; i < 16; ++i) acc[a][b][i] = 0.f;
    gs_store(B, lds, lo);
    __syncthreads();
    for (int kt = 0; kt < nk; kt += 2) {
      if (kt + 2 < nk) gs_load(B, gw, ldw, gx, ldx, (kt + 2) * 64);
      else if (has_next) gs_load(B, gwn, ldw, gxn, ldx, 0);
      gemm_kstep(lds, wn, wt, r, h, acc);
      gs_store(A, lds + 2 * TILE_U16, lo);
      __syncthreads();
      if (kt + 3 < nk) gs_load(A, gw, ldw, gx, ldx, (kt + 3) * 64);
      else if (has_next) gs_load(A, gwn, ldw, gxn, ldx, 64);
      gemm_kstep(lds + 2 * TILE_U16, wn, wt, r, h, acc);
      if (kt + 2 < nk) gs_store(B, lds, lo);
      __syncthreads();
    }
    stage_bf16(lds, acc);
    __syncthreads();
    u16* out = outb + (size_t)GP_MT(q) * 128 * ldo + GP_NT(q) * 128;
#pragma unroll
    for (int i = 0; i < 8; ++i) {
      const int id = tid + 256 * i;
      const int row = id >> 4, c = id & 15;
      uint4 v = *(const uint4*)(lds + row * 136 + c * 8);
      *(uint4*)(out + (size_t)row * ldo + c * 8) = v;
    }
    __syncthreads();
    gw = gwn; gx = gxn;
  }
#undef GP_MT
#undef GP_NT
}

__device__ void prep_transpose(const float* __restrict__ src, size_t sstride, int nmat, int R, int C, u16* __restrict__ dst,
                               size_t dstride, int dld, const float* __restrict__ gk, int mode, float* tile, int bid, int nb) {
  const int tid = opaque_tid();
  const int tr = R >> 6, tc = (C + 63) >> 6;
  const int per = tr * tc;
  for (int t = bid; t < per * nmat; t += nb) {
    const int m = t / per, tt = t % per;
    const int r0 = (tt / tc) * 64, c0 = (tt % tc) * 64;
    const float* sm = src + (size_t)m * sstride;
    u16* dm = dst + (size_t)m * dstride;
    __syncthreads();
#pragma unroll
    for (int i = 0; i < 16; ++i) {
      const int rr = i * 4 + (tid >> 6), cc = tid & 63;
      float v = 0.f;
      if (c0 + cc < C) {
        v = sm[(size_t)(r0 + rr) * C + c0 + cc];
        if (gk) v *= gk[m * R + r0 + rr];
      }
      tile[rr * 65 + cc] = v;
    }
    __syncthreads();
#pragma unroll
    for (int i = 0; i < 16; ++i) {
      const int cc = i * 4 + (tid >> 6), rr = tid & 63;
      const int c = c0 + cc;
      if (c < C) {
        const int n = (mode == 1) ? (c / 96) * 128 + (c % 96) : c;
        dm[(size_t)n * dld + r0 + rr] = f2bf(tile[rr * 65 + cc]);
      }
    }
  }
}
__device__ void phase_prep(PP p, float* ldsf) {
  p = launder(p);
  const int bid = blockIdx.x, nb = gridDim.x, tid = opaque_tid();
  const int gtid = bid * 256 + tid, gn = nb * 256;
  if (bid == 0) p->counters[tid] = 0;
  prep_transpose(p->w_in, (size_t)DM * DIN, NLAYER, DM, DIN, p->wInT, (size_t)DINP * DM, DM, nullptr, 0, ldsf, bid, nb);
  prep_transpose(p->w_out, (size_t)DM * DM, NLAYER, DM, DM, p->wOutT, (size_t)DM * DM, DM, nullptr, 0, ldsf, (bid + 256) % nb, nb);
  prep_transpose(p->w_uq, (size_t)192 * 576, NLAYER, 192, 576, p->wUqT, (size_t)768 * 192, 192, p->q_g, 1, ldsf, (bid + 128) % nb, nb);
  prep_transpose(p->w_ukv, (size_t)128 * 768, NLAYER, 128, 768, p->wUkvT, (size_t)768 * 128, 128, p->kv_g, 0, ldsf, (bid + 384) % nb, nb);
  prep_transpose(p->lru_wa, 4096, NLAYER * 6, 64, 64, p->waT, 4096, 64, nullptr, 0, ldsf, (bid + 64) % nb, nb);
  prep_transpose(p->lru_wx, 4096, NLAYER * 6, 64, 64, p->wxT, 4096, 64, nullptr, 0, ldsf, (bid + 192) % nb, nb);
  for (int i = gtid; i < NLAYER * 32 * DM; i += gn) {
    const int l = i / (32 * DM), rem = i % (32 * DM);
    p->wInT[(size_t)l * DINP * DM + (size_t)DIN * DM + rem] = 0;
  }
  for (int i = gtid; i < NLAYER * 6 * 32 * 192; i += gn) {
    const int l = i / (6 * 32 * 192), rem = i % (6 * 32 * 192);
    const int hd = rem / (32 * 192), rem2 = rem % (32 * 192);
    p->wUqT[(size_t)l * 768 * 192 + (size_t)(hd * 128 + 96) * 192 + rem2] = 0;
  }
  for (int i = gtid; i < NLAYER * 4 * 128 * 128; i += gn) {
    const int ii = (i >> 7) & 127, jj = i & 127;
    const float v = (ii >= 64 || jj < 64) ? p->sgu_w[i] : 0.f;
    p->sguW[i] = f2bf(v);
  }
  for (int i = gtid; i < T_TOK * 16; i += gn) {
    const int t = i >> 4, k = i & 15;
    const double rev = (double)p->pos[t] * c_invfreq_rev[k];
    const double fr = rev - __builtin_rint(rev);
    const float f = (float)fr;
    p->tab[i] = make_float2(__builtin_amdgcn_cosf(f), __builtin_amdgcn_sinf(f));
  }
}

typedef __attribute__((ext_vector_type(4))) float f32x4;
__device__ void phase_norm(PP p, int l) {
  p = launder(p);
  const int tid_ = opaque_tid();
  const int lane = tid_ & 63;
  const int gw = blockIdx.x * 4 + (tid_ >> 6), nw = gridDim.x * 4;
  const float* xin = (l <= 1) ? p->x : p->out;
  const float* gpost = p->post_g + (l > 0 ? l - 1 : 0) * DM;
  const float* gpre = p->pre_g + (l < NLAYER ? l : 0) * DM;
  constexpr int NTK = 4;
  for (int tok0 = gw; tok0 < T_TOK; tok0 += NTK * nw) {
    f32x4 xv[NTK][4];
    u32x2 yu[NTK][4];
#pragma unroll
    for (int t = 0; t < NTK; ++t) {
      const int tok = (tok0 + t * nw < T_TOK) ? tok0 + t * nw : tok0;
#pragma unroll
      for (int i = 0; i < 4; ++i) xv[t][i] = __builtin_nontemporal_load((const f32x4*)(xin + (size_t)tok * DM + i * 256 + lane * 4));
    }
    if (l > 0) {
#pragma unroll
      for (int t = 0; t < NTK; ++t) {
        const int tok = (tok0 + t * nw < T_TOK) ? tok0 + t * nw : tok0;
#pragma unroll
        for (int i = 0; i < 4; ++i) yu[t][i] = __builtin_nontemporal_load((const u32x2*)(p->y2 + (size_t)tok * DM + i * 256 + lane * 4));
      }
    }
#pragma unroll
    for (int t = 0; t < NTK; ++t) {
      const int tok = (tok0 + t * nw < T_TOK) ? tok0 + t * nw : tok0;
      if (l > 0) {
        float yv[16];
        float ss = 0.f;
#pragma unroll
        for (int i = 0; i < 4; ++i) {
          yv[4 * i] = lo16(yu[t][i].x); yv[4 * i + 1] = hi16(yu[t][i].x); yv[4 * i + 2] = lo16(yu[t][i].y); yv[4 * i + 3] = hi16(yu[t][i].y);
          ss += yv[4 * i] * yv[4 * i] + yv[4 * i + 1] * yv[4 * i + 1] + yv[4 * i + 2] * yv[4 * i + 2] + yv[4 * i + 3] * yv[4 * i + 3];
        }
        ss = wave_sum(ss);
        const float rs = rsqrtf(ss * (1.f / 1024.f) + EPSF);
#pragma unroll
        for (int i = 0; i < 4; ++i) {
          float4 gv = *(const float4*)(gpost + i * 256 + lane * 4);
          xv[t][i].x += yv[4 * i] * rs * gv.x; xv[t][i].y += yv[4 * i + 1] * rs * gv.y;
          xv[t][i].z += yv[4 * i + 2] * rs * gv.z; xv[t][i].w += yv[4 * i + 3] * rs * gv.w;
        }
      }
      if (l > 0) {
#pragma unroll
        for (int i = 0; i < 4; ++i) __builtin_nontemporal_store(xv[t][i], (f32x4*)(p->out + (size_t)tok * DM + i * 256 + lane * 4));
      }
      if (l < NLAYER) {
        float ss = 0.f;
#pragma unroll
        for (int i = 0; i < 4; ++i) ss += xv[t][i].x * xv[t][i].x + xv[t][i].y * xv[t][i].y + xv[t][i].z * xv[t][i].z + xv[t][i].w * xv[t][i].w;
        ss = wave_sum(ss);
        const float rs = rsqrtf(ss * (1.f / 1024.f) + EPSF);
#pragma unroll
        for (int i = 0; i < 4; ++i) {
          float4 gv = *(const float4*)(gpre + i * 256 + lane * 4);
          uint2 u;
          u.x = pack2(xv[t][i].x * rs * gv.x, xv[t][i].y * rs * gv.y);
          u.y = pack2(xv[t][i].z * rs * gv.z, xv[t][i].w * rs * gv.w);
          *(uint2*)(p->hbuf + (size_t)tok * DM + i * 256 + lane * 4) = u;
        }
      }
    }
  }
}

__device__ void item_q(PP p, int l, int rt, int hd, u16* lds, float* ssm, bool do_rstd) {
  p = launder(p);
  const int tid = opaque_tid();
  const int m0 = rt * 128;
  if (do_rstd) {
    const int row = tid >> 1, half = tid & 1;
    const u16* src = p->proj + (size_t)(m0 + row) * DINP + C_QL + half * 96;
    float ss = 0.f;
#pragma unroll
    for (int i = 0; i < 12; ++i) {
      float v[8]; unpack8(*(const uint4*)(src + i * 8), v);
#pragma unroll
      for (int j = 0; j < 8; ++j) ss += v[j] * v[j];
    }
    ss += __shfl_xor(ss, 1);
    if (half == 0) ssm[row] = rsqrtf(ss * (1.f / 192.f) + EPSF);
  }
  f32x16 acc[2][2];
  gemm_tile(p->wUqT + (size_t)l * 768 * 192 + (size_t)hd * 128 * 192, 192, p->proj + (size_t)m0 * DINP + C_QL, DINP, 192, lds, acc);
  float* st = (float*)lds;
  stage_f32(st, acc);
  __syncthreads();
  const float qscale = 0.10206207261596577f * 1.4426950408889634f;
#pragma unroll
  for (int i = 0; i < 6; ++i) {
    const int u = tid + 256 * i;
    const int row = u / 12, dg = u % 12;
    const float sc = ssm[row] * qscale;
    const float* sr = st + row * 132;
    float o[8];
    if (dg < 8) {
      const float4 a = *(const float4*)(sr + dg * 8), bq = *(const float4*)(sr + dg * 8 + 4);
      o[0] = a.x * sc; o[1] = a.y * sc; o[2] = a.z * sc; o[3] = a.w * sc;
      o[4] = bq.x * sc; o[5] = bq.y * sc; o[6] = bq.z * sc; o[7] = bq.w * sc;
    } else {
      const int i0 = (dg & 1) * 8;
      const float2* tb = p->tab + (size_t)(m0 + row) * 16 + i0;
      const float4 a0 = *(const float4*)(sr + 64 + i0), a1 = *(const float4*)(sr + 68 + i0);
      const float4 b0 = *(const float4*)(sr + 80 + i0), b1 = *(const float4*)(sr + 84 + i0);
      const float x1[8] = {a0.x, a0.y, a0.z, a0.w, a1.x, a1.y, a1.z, a1.w};
      const float x2[8] = {b0.x, b0.y, b0.z, b0.w, b1.x, b1.y, b1.z, b1.w};
      const float4 t0 = *(const float4*)(tb), t1 = *(const float4*)(tb + 2), t2 = *(const float4*)(tb + 4), t3 = *(const float4*)(tb + 6);
      const float cc[8] = {t0.x, t0.z, t1.x, t1.z, t2.x, t2.z, t3.x, t3.z};
      const float sn[8] = {t0.y, t0.w, t1.y, t1.w, t2.y, t2.w, t3.y, t3.w};
      if (dg < 10) {
#pragma unroll
        for (int j = 0; j < 8; ++j) o[j] = (x1[j] * cc[j] - x2[j] * sn[j]) * sc;
      } else {
#pragma unroll
        for (int j = 0; j < 8; ++j) o[j] = (x2[j] * cc[j] + x1[j] * sn[j]) * sc;
      }
    }
    *(uint4*)(p->Q + ((size_t)(m0 + row) * 6 + hd) * 96 + dg * 8) = pack8(o);
  }
  __syncthreads();
}

__device__ void item_kv(PP p, int l, int rt, int hd, u16* lds, float* ssm, bool do_rstd) {
  p = launder(p);
  const int tid = opaque_tid();
  const int m0 = rt * 128;
  if (do_rstd) {
    const int row = tid >> 1, half = tid & 1;
    const u16* src = p->proj + (size_t)(m0 + row) * DINP + C_KVL + half * 64;
    float ss = 0.f;
#pragma unroll
    for (int i = 0; i < 8; ++i) {
      float v[8]; unpack8(*(const uint4*)(src + i * 8), v);
#pragma unroll
      for (int j = 0; j < 8; ++j) ss += v[j] * v[j];
    }
    ss += __shfl_xor(ss, 1);
    if (half == 0) ssm[row] = rsqrtf(ss * (1.f / 128.f) + EPSF);
  }
  f32x16 acc[2][2];
  gemm_tile(p->wUkvT + (size_t)l * 768 * 128 + (size_t)hd * 128 * 128, 128, p->proj + (size_t)m0 * DINP + C_KVL, DINP, 128, lds, acc);
  float* st = (float*)lds;
  stage_f32(st, acc);
  __syncthreads();
  const int kb_ = m0 / SEQ, ks0_ = m0 % SEQ;
#pragma unroll
  for (int i = 0; i < 4; ++i) {
    const int u = tid + 256 * i;
    const int row = u >> 3, dg = u & 7;
    const float sc = ssm[row];
    const float* sr = st + row * 132 + dg * 8;
    float o[8];
    {
      const float4 a = *(const float4*)(sr), bq = *(const float4*)(sr + 4);
      o[0] = a.x * sc; o[1] = a.y * sc; o[2] = a.z * sc; o[3] = a.w * sc;
      o[4] = bq.x * sc; o[5] = bq.y * sc; o[6] = bq.z * sc; o[7] = bq.w * sc;
    }
    *(uint4*)(p->K + ((size_t)(kb_ * 6 + hd) * SEQ + ks0_ + row) * 96 + dg * 8) = pack8(o);
  }
  if (hd == 0) {
#pragma unroll
    for (int i = 0; i < 2; ++i) {
      const int u = tid + 256 * i;
      const int row = u >> 2, dq = u & 3;
      const int i0 = (dq & 1) * 8;
      const u16* kr = p->proj + (size_t)(m0 + row) * DINP + C_KR;
      float x1[8], x2[8], o[8];
      unpack8(*(const uint4*)(kr + i0), x1);
      unpack8(*(const uint4*)(kr + 16 + i0), x2);
      const float2* tb = p->tab + (size_t)(m0 + row) * 16 + i0;
      if (dq < 2) {
#pragma unroll
        for (int j = 0; j < 8; ++j) { float2 cs = tb[j]; o[j] = x1[j] * cs.x - x2[j] * cs.y; }
      } else {
#pragma unroll
        for (int j = 0; j < 8; ++j) { float2 cs = tb[j]; o[j] = x2[j] * cs.x + x1[j] * cs.y; }
      }
      const uint4 ov = pack8(o);
#pragma unroll
      for (int hh2 = 0; hh2 < 6; ++hh2)
        *(uint4*)(p->K + ((size_t)(kb_ * 6 + hh2) * SEQ + ks0_ + row) * 96 + 64 + dq * 8) = ov;
    }
  }
  const int b = m0 / SEQ, s0 = m0 % SEQ;
#pragma unroll
  for (int i = 0; i < 4; ++i) {
    const int u = tid + 256 * i;
    const int dv = u & 63, tg = u >> 6;
    float o[8];
#pragma unroll
    for (int j = 0; j < 8; ++j) o[j] = st[(tg * 8 + j) * 132 + 64 + dv] * ssm[tg * 8 + j];
    u16* vdst = p->VT + (((size_t)(b * 6 + hd) * 128 + (s0 >> 6) + (tg >> 3)) * 64 + dv) * 64 + ((tg & 7) >> 1) * 16 + (tg & 1) * 4;
    uint2 lo2, hi2;
    lo2.x = pack2(o[0], o[1]); lo2.y = pack2(o[2], o[3]);
    hi2.x = pack2(o[4], o[5]); hi2.y = pack2(o[6], o[7]);
    *(uint2*)(vdst) = lo2;
    *(uint2*)(vdst + 8) = hi2;
  }
  __syncthreads();
}

__device__ void item_lru(PP p, int l, int tt, int hd, u16* lds, float* ssm) {
  p = launder(p);
  const int tid = opaque_tid(), lane = tid & 63, w = tid >> 6, r = lane & 31, h = lane >> 5;
  const int t0 = tt * 64;
  const int s0 = t0 % SEQ;
  float* xaf = (float*)lds;
  u16* xcb = lds + 8576;
  float* aarr = (float*)(lds + 8576 + 4608);
  float* barr = aarr + 4096;
  const int c = tid & 63;
  const int cg = hd * 64 + c;
  bf16x8 wfa[4], wfx[4];
  {
    const int cbk_ = w & 1;
    const u16* wa_ = p->waT + (size_t)(l * 6 + hd) * 4096 + (cbk_ * 32 + r) * 64 + h * 8;
    const u16* wx_ = p->wxT + (size_t)(l * 6 + hd) * 4096 + (cbk_ * 32 + r) * 64 + h * 8;
#pragma unroll
    for (int ks = 0; ks < 4; ++ks) { wfa[ks] = *(const bf16x8*)(wa_ + ks * 16); wfx[ks] = *(const bf16x8*)(wx_ + ks * 16); }
  }
  for (int u = tid; u < 67 * 8; u += 256) {
    const int row = u >> 3, c8 = u & 7;
    float v[8];
    if (s0 + row - 3 >= 0) {
      unpack8(*(const uint4*)(p->proj + (size_t)(t0 + row - 3) * DINP + C_XA + hd * 64 + c8 * 8), v);
    } else {
#pragma unroll
      for (int j = 0; j < 8; ++j) v[j] = 0.f;
    }
    *(float4*)(xaf + row * 64 + c8 * 8) = make_float4(v[0], v[1], v[2], v[3]);
    *(float4*)(xaf + row * 64 + c8 * 8 + 4) = make_float4(v[4], v[5], v[6], v[7]);
  }
  __syncthreads();
  const float cw0 = p->conv_w[(l * 4 + 0) * 384 + cg], cw1 = p->conv_w[(l * 4 + 1) * 384 + cg];
  const float cw2 = p->conv_w[(l * 4 + 2) * 384 + cg], cw3 = p->conv_w[(l * 4 + 3) * 384 + cg];
  const float cbias = p->conv_b[l * 384 + cg];
  {
    const int tq = tid >> 6;
    for (int t = tq * 16; t < tq * 16 + 16; ++t) {
      const float xc = cbias + cw0 * xaf[t * 64 + c] + cw1 * xaf[(t + 1) * 64 + c] + cw2 * xaf[(t + 2) * 64 + c] + cw3 * xaf[(t + 3) * 64 + c];
      xcb[t * LDT + c] = f2bf(xc);
    }
  }
  __syncthreads();
  {
    const int tb = w >> 1, cbk = w & 1;
    f32x16 aa, ax;
#pragma unroll
    for (int i = 0; i < 16; ++i) { aa[i] = 0.f; ax[i] = 0.f; }
    const u16* xr = xcb + (tb * 32 + r) * LDT + h * 8;
#pragma unroll
    for (int ks = 0; ks < 4; ++ks) {
      bf16x8 af = *(const bf16x8*)(xr + ks * 16);
      aa = mfma32(af, wfa[ks], aa);
      ax = mfma32(af, wfx[ks], ax);
    }
    const int cc = cbk * 32 + r;
    const int cgl = hd * 64 + cc;
    const float ba = p->lru_ba[l * 384 + cgl], bx = p->lru_bx[l * 384 + cgl];
    const float lam = p->lru_lam[l * 384 + cgl];
    const float nl = -lam;
    const float sp = fmaxf(nl, 0.f) + log1pf(expf(-fabsf(nl)));
#pragma unroll
    for (int reg = 0; reg < 16; ++reg) {
      const int t = tb * 32 + (reg & 3) + 8 * (reg >> 2) + 4 * h;
      const float xc = bf2f(xcb[t * LDT + cc]);
      const float ga = sigmoidf_(aa[reg] + ba);
      const float gx = sigmoidf_(ax[reg] + bx);
      const float la = -8.f * ga * sp;
      const float a = __expf(la);
      const float om = (la > -5e-4f) ? (-2.f * la) * (1.f + la) : (1.f - a * a);
      const float mult = sqrtf(fmaxf(om, 0.f));
      aarr[t * 64 + cc] = a;
      barr[t * 64 + cc] = mult * gx * xc;
    }
  }
  __syncthreads();
  const int seg = tid >> 6;
  u16* h16 = (u16*)aarr;
  u16* c16 = (u16*)barr;
  float pr[16], hr[16];
#pragma unroll
  for (int j = 0; j < 16; ++j) { pr[j] = aarr[(seg * 16 + j) * 64 + c]; hr[j] = barr[(seg * 16 + j) * 64 + c]; }
  {
    float hh = 0.f, P = 1.f;
#pragma unroll
    for (int j = 0; j < 16; ++j) { hh = pr[j] * hh + hr[j]; P *= pr[j]; hr[j] = hh; pr[j] = P; }
    ssm[seg * 64 + c] = P;
    ssm[256 + seg * 64 + c] = hh;
  }
  __syncthreads();
  {
    float Hc = 0.f, Pc = 1.f;
    for (int s2 = 0; s2 < seg; ++s2) {
      const float Ps = ssm[s2 * 64 + c], Hs = ssm[256 + s2 * 64 + c];
      Hc = Ps * Hc + Hs; Pc *= Ps;
    }
    float hl = 0.f, cm = 1.f;
#pragma unroll
    for (int j = 0; j < 16; ++j) {
      hl = hr[j] + pr[j] * Hc;
      cm = pr[j] * Pc;
      h16[(seg * 16 + j) * 64 + c] = f2bf(hl);
      c16[(seg * 16 + j) * 64 + c] = f2bf(cm);
    }
    if (seg == 3) {
      p->Htile[(size_t)tt * 384 + cg] = hl;
      p->Ptile[(size_t)tt * 384 + cg] = cm;
    }
  }
  __syncthreads();
#pragma unroll
  for (int i = 0; i < 2; ++i) {
    const int id = tid + 256 * i;
    const int row = id >> 3, c8 = id & 7;
    const uint4 hv = *(const uint4*)(h16 + row * 64 + c8 * 8);
    const uint4 cv = *(const uint4*)(c16 + row * 64 + c8 * 8);
    *(uint4*)(p->hloc + (size_t)(t0 + row) * 384 + hd * 64 + c8 * 8) = hv;
    *(uint4*)(p->cum + (size_t)(t0 + row) * 384 + hd * 64 + c8 * 8) = cv;
  }
  __syncthreads();
}

__device__ void item_sgu(PP p, int l, int nbk, u16* lds, float* ssm) {
  p = launder(p);
  const int tid = opaque_tid(), lane = tid & 63, w = tid >> 6, r = lane & 31, h = lane >> 5;
  const int m0 = nbk * 128;
  {
    const int row = tid >> 1, half = tid & 1;
    const u16* src = p->proj + (size_t)(m0 + row) * DINP + C_V + half * 128;
    float s1 = 0.f, s2 = 0.f;
#pragma unroll
    for (int i = 0; i < 16; ++i) {
      float v[8]; unpack8(*(const uint4*)(src + i * 8), v);
#pragma unroll
      for (int j = 0; j < 8; ++j) { const float gq = geluf_(v[j]); s1 += gq; s2 += gq * gq; }
    }
    s1 += __shfl_xor(s1, 1); s2 += __shfl_xor(s2, 1);
    if (half == 0) {
      const float mu = s1 * (1.f / 256.f);
      const float var = fmaxf(s2 * (1.f / 256.f) - mu * mu, 0.f);
      ssm[row] = mu; ssm[128 + row] = rsqrtf(var + EPSF);
    }
  }
  u16* vbT = lds;
  for (int g = 0; g < 4; ++g) {
    __syncthreads();
    {
      const int j = tid & 127, chalf = tid >> 7;
      const float mu = ssm[j], rs = ssm[128 + j];
      const u16* src = p->proj + (size_t)(m0 + j) * DINP + C_V + g * 64 + chalf * 32;
      const float* lg = p->sgu_g + l * 256 + g * 64 + chalf * 32;
      const float* lb = p->sgu_bn + l * 256 + g * 64 + chalf * 32;
#pragma unroll
      for (int i = 0; i < 4; ++i) {
        float v[8]; unpack8(*(const uint4*)(src + i * 8), v);
#pragma unroll
        for (int q = 0; q < 8; ++q) {
          const int cc = chalf * 32 + i * 8 + q;
          const float val = (geluf_(v[q]) - mu) * rs * lg[i * 8 + q] + lb[i * 8 + q];
          vbT[cc * 136 + j] = f2bf(val);
        }
      }
    }
    __syncthreads();
    f32x16 a0, a1;
#pragma unroll
    for (int i = 0; i < 16; ++i) { a0[i] = 0.f; a1[i] = 0.f; }
    const u16* wr = p->sguW + ((size_t)(l * 4 + g) * 128 + w * 32 + r) * 128 + h * 8;
    const u16* v0 = vbT + r * 136 + h * 8;
    const u16* v1 = vbT + (32 + r) * 136 + h * 8;
    const int nks = (w < 2) ? 4 : 8;
    for (int ks = 0; ks < nks; ++ks) {
      bf16x8 af = *(const bf16x8*)(wr + ks * 16);
      bf16x8 b0 = *(const bf16x8*)(v0 + ks * 16);
      bf16x8 b1 = *(const bf16x8*)(v1 + ks * 16);
      a0 = mfma32(af, b0, a0);
      a1 = mfma32(af, b1, a1);
    }
    float* stg = (float*)(lds + 8704);
#pragma unroll
    for (int reg = 0; reg < 16; ++reg) {
      const int i = w * 32 + (reg & 3) + 8 * (reg >> 2) + 4 * h;
      const float bsv = p->sgu_b[(l * 4 + g) * 128 + i];
      stg[i * 68 + r] = a0[reg] + bsv;
      stg[i * 68 + 32 + r] = a1[reg] + bsv;
    }
    __syncthreads();
#pragma unroll
    for (int k = 0; k < 4; ++k) {
      const int u = tid + 256 * k;
      const int i = u >> 3, c8 = u & 7;
      const size_t tok = (size_t)(m0 + i);
      const int ch = g * 64 + c8 * 8;
      const float4 m0v = *(const float4*)(stg + i * 68 + c8 * 8), m1v = *(const float4*)(stg + i * 68 + c8 * 8 + 4);
      const float mx[8] = {m0v.x, m0v.y, m0v.z, m0v.w, m1v.x, m1v.y, m1v.z, m1v.w};
      float uu[8], gcv[8], o[8];
      unpack8(*(const uint4*)(p->proj + tok * DINP + C_U + ch), uu);
      unpack8(*(const uint4*)(p->proj + tok * DINP + C_GC + ch), gcv);
#pragma unroll
      for (int q = 0; q < 8; ++q) o[q] = geluf_(uu[q]) * mx[q] * siluf_(gcv[q]);
      *(uint4*)(p->ycpre + tok * 256 + ch) = pack8(o);
    }
  }
  __syncthreads();
}

__device__ void item_carry(PP p, int ci) {
  p = launder(p);
  const int idx = ci * 256 + opaque_tid();
  const int b = idx / 384, c = idx % 384;
  float carry = 0.f;
  for (int tt = 0; tt < 128; ++tt) {
    const size_t o = (size_t)(b * 128 + tt) * 384 + c;
    p->carry[o] = carry;
    carry = p->Ptile[o] * carry + p->Htile[o];
  }
}

#define KLD 104
#define VLD 72
#define ATT_STAGE (64 * KLD + 64 * VLD)
struct AStage { u32x4 k0, k1, k2, v0, v1; };
__device__ __forceinline__ void as_load(AStage& g, const u16* kg, const u16* vg, int kt) {
  const u16* kp = kg + (size_t)kt * 6144;
  g.k0 = *(const u32x4*)(kp); g.k1 = *(const u32x4*)(kp + 2048); g.k2 = *(const u32x4*)(kp + 4096);
  const u16* vp = vg + (size_t)kt * 4096;
  g.v0 = *(const u32x4*)(vp); g.v1 = *(const u32x4*)(vp + 2048);
#ifdef DUP_LOADS
  {
    u32x4 t0 = *(const volatile u32x4*)(kp), t1 = *(const volatile u32x4*)(kp + 2048), t2 = *(const volatile u32x4*)(kp + 4096);
    u32x4 t3 = *(const volatile u32x4*)(vp), t4 = *(const volatile u32x4*)(vp + 2048);
    asm volatile("" :: "v"(t0), "v"(t1), "v"(t2), "v"(t3), "v"(t4));
  }
#endif
}
__device__ __forceinline__ void as_store(const AStage& g, u16* db, int kl0, int kl1, int kl2, int vl) {
  *(u32x4*)(db + kl0) = g.k0; *(u32x4*)(db + kl1) = g.k1; *(u32x4*)(db + kl2) = g.k2;
  *(u32x4*)(db + vl) = g.v0; *(u32x4*)(db + vl + 32 * VLD) = g.v1;
}
__device__ __forceinline__ float max3f(float a, float b, float c) {
  float d; asm("v_max3_f32 %0, %1, %2, %3" : "=v"(d) : "v"(a), "v"(b), "v"(c)); return d;
}
__device__ __forceinline__ bf16x8 pack_p(const f32x16& s, int o) {
  u32x4 pu;
  pu.x = pack2(s[o + 0], s[o + 1]); pu.y = pack2(s[o + 2], s[o + 3]);
  pu.z = pack2(s[o + 4], s[o + 5]); pu.w = pack2(s[o + 6], s[o + 7]);
  return __builtin_bit_cast(bf16x8, pu);
}
__device__ __forceinline__ void attn_qk(const u16* kp, const bf16x8 (&qa)[6], f32x16& s0, f32x16& s1) {
#pragma unroll
  for (int ks = 0; ks < 6; ++ks) {
    bf16x8 k0 = *(const bf16x8*)(kp + ks * 16);
    bf16x8 k1 = *(const bf16x8*)(kp + 32 * KLD + ks * 16);
    s0 = mfma32(k0, qa[ks], s0);
    s1 = mfma32(k1, qa[ks], s1);
  }
}
__device__ __forceinline__ void attn_tile(const u16* sb, const bf16x8 (&qa)[6], f32x16& o0, f32x16& o1, f32x16& lacc,
                                          float& m, bool& mz, int r, int h, bool first) {
  const u16* kp = sb + r * KLD + h * 8;
  f32x16 s0, s1;
  __builtin_amdgcn_s_setprio(1);
  if (mz) {
#pragma unroll
    for (int i = 0; i < 16; ++i) { s0[i] = 0.f; s1[i] = 0.f; }
    attn_qk(kp, qa, s0, s1);
  } else {
#pragma unroll
    for (int i = 0; i < 16; ++i) { s0[i] = -m; s1[i] = -m; }
    attn_qk(kp, qa, s0, s1);
  }
  __builtin_amdgcn_s_setprio(0);
  float mxa = max3f(s0[0], s0[1], s0[2]), mxb = max3f(s0[3], s0[4], s0[5]);
  float mxc = max3f(s0[6], s0[7], s0[8]), mxd = max3f(s0[9], s0[10], s0[11]);
  mxa = max3f(mxa, s0[12], s0[13]); mxb = max3f(mxb, s0[14], s0[15]);
  mxc = max3f(mxc, s1[0], s1[1]); mxd = max3f(mxd, s1[2], s1[3]);
  mxa = max3f(mxa, s1[4], s1[5]); mxb = max3f(mxb, s1[6], s1[7]);
  mxc = max3f(mxc, s1[8], s1[9]); mxd = max3f(mxd, s1[10], s1[11]);
  mxa = max3f(mxa, s1[12], s1[13]); mxb = max3f(mxb, s1[14], s1[15]);
  const float lm = max3f(mxa, mxb, fmaxf(mxc, mxd));
  bool slow;
  if (first) {
    const float mx = fmaxf(lm, __shfl_xor(lm, 32));
    slow = __any(mx > 30.f || mx < -30.f);
  } else {
    slow = __any(lm > 30.f);
  }
  if (slow) {
    const float mx = fmaxf(lm, __shfl_xor(lm, 32));
    const float d = first ? mx : fmaxf(mx, 0.f);
    const float alpha = first ? 1.f : __builtin_amdgcn_exp2f(-d);
    m += d;
    mz = false;
#pragma unroll
    for (int i = 0; i < 16; ++i) { s0[i] -= d; s1[i] -= d; o0[i] *= alpha; o1[i] *= alpha; }
    lacc[0] *= alpha;
  }
  float pa = 0.f, pb = 0.f, pc = 0.f, pd = 0.f;
#pragma unroll
  for (int i = 0; i < 16; ++i) {
    s0[i] = __builtin_amdgcn_exp2f(s0[i]); s1[i] = __builtin_amdgcn_exp2f(s1[i]);
    if ((i & 3) == 0) pa += s0[i] + s1[i];
    else if ((i & 3) == 1) pb += s0[i] + s1[i];
    else if ((i & 3) == 2) pc += s0[i] + s1[i];
    else pd += s0[i] + s1[i];
  }
  lacc[0] += (pa + pb) + (pc + pd);
  const u16* vp = sb + 64 * KLD + r * VLD + 8 * h;
  __builtin_amdgcn_s_setprio(1);
#pragma unroll
  for (int kb = 0; kb < 2; ++kb) {
#pragma unroll
    for (int s = 0; s < 2; ++s) {
      const bf16x8 pf = pack_p(kb == 0 ? s0 : s1, 8 * s);
      const int koff = kb * 32 + 16 * s;
      const bf16x8 v0 = *(const bf16x8*)(vp + koff);
      const bf16x8 v1 = *(const bf16x8*)(vp + 32 * VLD + koff);
      o0 = mfma32(v0, pf, o0);
      o1 = mfma32(v1, pf, o1);
    }
  }
  __builtin_amdgcn_s_setprio(0);
}
__device__ __forceinline__ void attn_write_o(u16* op, const f32x16& o0, const f32x16& o1, float inv) {
#pragma unroll
  for (int g = 0; g < 4; ++g) {
    uint2 v;
    v.x = pack2(o0[4 * g] * inv, o0[4 * g + 1] * inv); v.y = pack2(o0[4 * g + 2] * inv, o0[4 * g + 3] * inv);
    *(uint2*)(op + 8 * g) = v;
    v.x = pack2(o1[4 * g] * inv, o1[4 * g + 1] * inv); v.y = pack2(o1[4 * g + 2] * inv, o1[4 * g + 3] * inv);
    *(uint2*)(op + 32 + 8 * g) = v;
  }
}

__device__ void item_attn(PP p, int qb, int b, int hh, u16* lds) {
  p = launder(p);
  const int tid = opaque_tid(), lane = tid & 63, w = tid >> 6, r = lane & 31, h = lane >> 5;
  const size_t tokbase = (size_t)b * SEQ;
  const int q0 = qb * 128 + w * 32;
  bf16x8 qa[6];
  {
    const u16* qp = p->Q + ((tokbase + q0 + r) * 6 + hh) * 96 + h * 8;
#pragma unroll
    for (int ks = 0; ks < 6; ++ks) qa[ks] = *(const bf16x8*)(qp + ks * 16);
  }
  f32x16 oa0, oa1, lacc;
#pragma unroll
  for (int i = 0; i < 16; ++i) { oa0[i] = 0.f; oa1[i] = 0.f; lacc[i] = 0.f; }
  float ma = 0.f;
  bool mz = true;
  const int ntiles = 2 * qb + 2;
  const int my_ntiles = 2 * qb + 1 + (w >> 1);
  const u16* kg = p->K + (size_t)(b * 6 + hh) * SEQ * 96 + tid * 8;
  const u16* vg = p->VT + (size_t)(b * 6 + hh) * SEQ * 64 + tid * 8;
  const int id1 = tid + 256, id2 = tid + 512;
  const int kl0 = (tid / 12) * KLD + (tid % 12) * 8;
  const int kl1 = (id1 / 12) * KLD + (id1 % 12) * 8;
  const int kl2 = (id2 / 12) * KLD + (id2 % 12) * 8;
  const int vl = 64 * KLD + (tid >> 3) * VLD + (tid & 7) * 8;
  AStage A, B;
  as_load(B, kg, vg, 0);
  as_load(A, kg, vg, 1);
  as_store(B, lds, kl0, kl1, kl2, vl);
  __syncthreads();
  for (int kt = 0; kt < ntiles; kt += 2) {
    if (kt + 2 < ntiles) as_load(B, kg, vg, kt + 2);
    attn_tile(lds, qa, oa0, oa1, lacc, ma, mz, r, h, kt == 0);
    as_store(A, lds + ATT_STAGE, kl0, kl1, kl2, vl);
    __syncthreads();
    if (kt + 3 < ntiles) as_load(A, kg, vg, kt + 3);
    if (kt + 1 < my_ntiles) attn_tile(lds + ATT_STAGE, qa, oa0, oa1, lacc, ma, mz, r, h, false);
    if (kt + 2 < ntiles) as_store(B, lds, kl0, kl1, kl2, vl);
    __syncthreads();
  }
  const float lta = lacc[0] + __shfl_xor(lacc[0], 32);
  u16* op = p->obuf + (tokbase + q0 + r) * 384 + hh * 64 + 4 * h;
  attn_write_o(op, oa0, oa1, 1.f / lta);
}

__device__ void phase_y(PP p, int l) {
  p = launder(p);
  const int tid_ = opaque_tid();
  const int lane = tid_ & 63;
  const int gw = blockIdx.x * 4 + (tid_ >> 6), nw = gridDim.x * 4;
  const float* bg = p->br_g + l * DM + lane * 16;
  const int seg = (lane < 24) ? 0 : (lane < 48) ? 1 : 2;
  const u16* xbase; const u16* gbase; size_t xs, gs;
  if (seg == 0) { xbase = p->hloc + lane * 16; xs = 384; gbase = p->proj + C_GA + lane * 16; gs = DINP; }
  else if (seg == 1) { xbase = p->obuf + (lane - 24) * 16; xs = 384; gbase = p->proj + C_GB + (lane - 24) * 16; gs = DINP; }
  else { xbase = p->ycpre + (lane - 48) * 16; xs = 256; gbase = xbase; gs = 256; }
  for (int tok0 = gw; tok0 < T_TOK; tok0 += 2 * nw) {
    const int tok1 = (tok0 + nw < T_TOK) ? tok0 + nw : tok0;
    uint4 xr[2][2], gr[2][2], cr_[2][2];
    float4 cy[2][4];
#pragma unroll
    for (int t = 0; t < 2; ++t) {
      const size_t tok = (size_t)(t ? tok1 : tok0);
      xr[t][0] = *(const uint4*)(xbase + tok * xs); xr[t][1] = *(const uint4*)(xbase + tok * xs + 8);
      gr[t][0] = *(const uint4*)(gbase + tok * gs); gr[t][1] = *(const uint4*)(gbase + tok * gs + 8);
    }
    if (seg == 0) {
#pragma unroll
      for (int t = 0; t < 2; ++t) {
        const size_t tok = (size_t)(t ? tok1 : tok0);
        cr_[t][0] = *(const uint4*)(p->cum + tok * 384 + lane * 16); cr_[t][1] = *(const uint4*)(p->cum + tok * 384 + lane * 16 + 8);
        const float* cp = p->carry + (tok >> 6) * 384 + lane * 16;
#pragma unroll
        for (int i = 0; i < 4; ++i) cy[t][i] = *(const float4*)(cp + 4 * i);
      }
    }
#pragma unroll
    for (int t = 0; t < 2; ++t) {
      const size_t tok = (size_t)(t ? tok1 : tok0);
      float v[16], g[16];
      unpack8(xr[t][0], v); unpack8(xr[t][1], v + 8);
      unpack8(gr[t][0], g); unpack8(gr[t][1], g + 8);
      if (seg == 0) {
        float cm[16];
        unpack8(cr_[t][0], cm); unpack8(cr_[t][1], cm + 8);
#pragma unroll
        for (int i = 0; i < 4; ++i) {
          v[4 * i] += cm[4 * i] * cy[t][i].x; v[4 * i + 1] += cm[4 * i + 1] * cy[t][i].y;
          v[4 * i + 2] += cm[4 * i + 2] * cy[t][i].z; v[4 * i + 3] += cm[4 * i + 3] * cy[t][i].w;
        }
      }
      if (seg < 2) {
#pragma unroll
        for (int j = 0; j < 16; ++j) v[j] *= siluf_(g[j]);
      }
      float ss = 0.f;
#pragma unroll
      for (int j = 0; j < 16; ++j) ss += v[j] * v[j];
      const float sa = wave_sum(seg == 0 ? ss : 0.f);
      const float sb = wave_sum(seg == 1 ? ss : 0.f);
      const float sc = wave_sum(seg == 2 ? ss : 0.f);
      const float rs = (seg == 0) ? rsqrtf(sa * (1.f / 384.f) + EPSF)
                     : (seg == 1) ? rsqrtf(sb * (1.f / 384.f) + EPSF) : rsqrtf(sc * (1.f / 256.f) + EPSF);
      float o[16];
#pragma unroll
      for (int j = 0; j < 16; ++j) o[j] = v[j] * rs * bg[j];
      *(uint4*)(p->hbuf + tok * DM + lane * 16) = pack8(o);
      *(uint4*)(p->hbuf + tok * DM + lane * 16 + 8) = pack8(o + 8);
    }
  }
}

__device__ __forceinline__ int next_item(int* counter, int* slot) {
  __syncthreads();
  if (threadIdx.x == 0) *slot = atomicAdd(counter, 1);
  __syncthreads();
  return *slot;
}


#define XB_TMO      128
#define XB_XCNT(j)  (256  + 64 * (j))
#define XB_XSUB(j)  (1280 + 64 * (j))
#define XB_XGEN(j)  (2304 + 64 * (j))
#define XB_TOP      3328
#define XB_TOPGEN   3392
#define XCD_BAR_WORDS 3456
#define XB_SPIN_CAP (1u << 18)
#define LAS __attribute__((address_space(3)))
__device__ __forceinline__ unsigned xb_ld(unsigned* p)              { return __hip_atomic_load(p, __ATOMIC_RELAXED, __HIP_MEMORY_SCOPE_AGENT); }
__device__ __forceinline__ unsigned xb_add(unsigned* p, unsigned v) { return __hip_atomic_fetch_add(p, v, __ATOMIC_RELAXED, __HIP_MEMORY_SCOPE_AGENT); }
__device__ __forceinline__ unsigned xb_xcc_id() { return (unsigned)__builtin_amdgcn_s_getreg((3 << 11) | 20) & 0xFu; }
#define XB_SPIN(cond, bar) do { unsigned _sp = 0; while (cond) { __builtin_amdgcn_s_sleep(1); \
    if ((++_sp & 255u) == 0u) { if (xb_ld(&(bar)[XB_TMO])) break; if (_sp > XB_SPIN_CAP) { atomicAdd(&(bar)[XB_TMO], 1u); break; } } } } while (0)
struct XcdBarrier { unsigned* bar; unsigned x; volatile LAS unsigned* st; };
__device__ __forceinline__ XcdBarrier xcd_barrier_post(unsigned* bar, volatile LAS unsigned* st) {
    XcdBarrier b; b.bar = bar; b.x = xb_xcc_id(); b.st = st;
    if (threadIdx.x == 0) (void)xb_add(&bar[XB_XCNT(b.x)], 1u);
    return b;
}
__device__ __forceinline__ void xcd_barrier_complete(unsigned* bar, unsigned x, unsigned& nloc, unsigned& nx) {
    const unsigned G = gridDim.x * gridDim.y * gridDim.z;
    unsigned sum, cnt, mine, sp = 0u;
    for (;;) {
        sum = 0u; cnt = 0u; mine = 0u;
#pragma unroll
        for (unsigned j = 0; j < 16; ++j) { const unsigned c = xb_ld(&bar[XB_XCNT(j)]); sum += c; cnt += (c > 0u) ? 1u : 0u; mine = (j == x) ? c : mine; }
        if (sum == G) break;
        __builtin_amdgcn_s_sleep(1);
        if ((++sp & 255u) == 0u) { if (xb_ld(&bar[XB_TMO])) break; if (sp > XB_SPIN_CAP) { atomicAdd(&bar[XB_TMO], 1u); break; } }
    }
    nloc = mine > 0u ? mine : 1u; nx = cnt > 0u ? cnt : 1u;
}
__device__ __forceinline__ void xcd_barrier(const XcdBarrier& b) {
    asm volatile("s_waitcnt vmcnt(0)" ::: "memory");
    __syncthreads();
    if (threadIdx.x == 0) {
        unsigned* bar = b.bar;
        __builtin_amdgcn_s_waitcnt(0);
        unsigned nloc = b.st[0], nx = b.st[1];
        if (nloc == 0u) { xcd_barrier_complete(bar, b.x, nloc, nx); b.st[0] = nloc; b.st[1] = nx; }
        const unsigned old = xb_add(&bar[XB_XSUB(b.x)], 1u);
        const unsigned gen = old / nloc;
        if (old + 1u == (gen + 1u) * nloc) {
            __builtin_amdgcn_fence(__ATOMIC_RELEASE, "agent");
            asm volatile("s_waitcnt vmcnt(0)" ::: "memory");
            const unsigned og = xb_add(&bar[XB_TOP], 1u);
            const unsigned tg = og / nx;
            if (og + 1u == (tg + 1u) * nx) xb_add(&bar[XB_TOPGEN], 1u);
            else XB_SPIN(xb_ld(&bar[XB_TOPGEN]) == tg, bar);
            __builtin_amdgcn_fence(__ATOMIC_ACQUIRE, "agent");
            xb_add(&bar[XB_XGEN(b.x)], 1u);
            asm volatile("s_waitcnt vmcnt(0)" ::: "memory");
        } else {
            XB_SPIN(xb_ld(&bar[XB_XGEN(b.x)]) == gen, bar);
            __builtin_amdgcn_fence(__ATOMIC_ACQUIRE, "agent");
            asm volatile("s_waitcnt vmcnt(0)" ::: "memory");
        }
    }
    __syncthreads();
}

#define N_PHASES (1 + 6 * NLAYER)

__device__ void run_phase(PP p, int ph, u16* lds, float* ssm, int* slot, int rep) {
  int l = (ph - 1) / 6, sub;
  {
    const int k = (ph - 1) % 6;
    sub = (k == 5) ? 1 : k + 2;
    if (k == 5) l += 1;
  }
  if (ph == 0) { sub = 0; l = 0; }
#ifdef ONLYSUB
  sub = ONLYSUB;
#endif
  const int bid = blockIdx.x, nb = gridDim.x;
  if (sub == 0) { phase_prep(p, (float*)lds); sub = 1; l = 0; }
  if (sub == 1) { phase_norm(p, l); return; }
  if (sub == 2) {
    gemm_phase(p->wInT + (size_t)l * DINP * DM, DM, p->hbuf, DM, DM, p->proj, DINP, 18, 256 * 18, lds);
    return;
  }
  if (sub == 3) {
    int* ctr = p->counters + l * 16 + rep * 64;
    for (;;) {
      int it = next_item(ctr, slot);
      if (it >= 256 + 256 + 256 + 3072) break;
      if (it < 256) item_sgu(p, l, it, lds, ssm);
      else if (it < 512) {
        const int rt = it - 256;
#pragma unroll 1
        for (int h2 = 0; h2 < 6; ++h2) item_q(p, l, rt, h2, lds, ssm, h2 == 0);
      } else if (it < 768) {
        const int rt = it - 512;
#pragma unroll 1
        for (int h2 = 0; h2 < 6; ++h2) item_kv(p, l, rt, h2, lds, ssm, h2 == 0);
      } else { const int k = it - 768; item_lru(p, l, k / 6, k % 6, lds, ssm); }
    }
    return;
  }
  if (sub == 4) {
    if (bid < 6) item_carry(p, bid);
    const int xq = (int)(xb_xcc_id() & 7u);
    int* cbase = p->counters + l * 16 + 8 + rep * 64;
    for (;;) {
      __syncthreads();
      if (threadIdx.x == 0) {
        int got = -1;
        for (int dq = 0; dq < 8 && got < 0; ++dq) {
          const int q = (xq + dq) & 7;
          if (__hip_atomic_load(cbase + q, __ATOMIC_RELAXED, __HIP_MEMORY_SCOPE_AGENT) < 192) {
            const int it = atomicAdd(cbase + q, 1);
            if (it < 192) got = q * 256 + it;
          }
        }
        *slot = got;
      }
      __syncthreads();
      const int got = *slot;
      if (got < 0) break;
      const int q = got >> 8, it = got & 255;
      int qb, bh;
      if (it < 64) { qb = 63 - it; bh = q * 3; }
      else { const int j = it - 64; qb = 63 - (j >> 1); bh = q * 3 + 1 + (j & 1); }
      item_attn(p, qb, bh / 6, bh % 6, lds);
    }
    return;
  }
  if (sub == 5) { phase_y(p, l); return; }
  gemm_phase(p->wOutT + (size_t)l * DM * DM, DM, p->hbuf, DM, DM, p->y2, DM, 8, 256 * 8, lds);
}

__global__ void __launch_bounds__(256, 2) mega_kernel(Params p, int ph_begin, int ph_end) {
  __shared__ __attribute__((aligned(16))) unsigned char lds_raw[LDS_BYTES];
  __shared__ float ssm[512];
  __shared__ int slot;
  u16* lds = (u16*)lds_raw;
  PP pp = (PP)__builtin_amdgcn_kernarg_segment_ptr();
#if COOP
  cg::grid_group grid = cg::this_grid();
  __shared__ uint4 xb_words;
  if (threadIdx.x == 0) xb_words = make_uint4(0u, 0u, 0u, 0u);
  __syncthreads();
  XcdBarrier xb = xcd_barrier_post(pp->bar, (volatile LAS unsigned*)&xb_words);
#endif
  int rep = 0;
  for (int ph = ph_begin; ph < ph_end;) {
    run_phase(launder(pp), ph, lds, ssm, &slot, rep);
    bool again = false;
#if COOP
#ifdef REPEAT_SUB
    if (ph > 0 && ph < N_PHASES - 1) {
      if (REPEAT_SUB == 99) { xcd_barrier(xb); xcd_barrier(xb); xcd_barrier(xb); xcd_barrier(xb); }
      else if (((ph - 1) % 6 + 1) == REPEAT_SUB && rep == 0) again = true;
    }
#endif
    if (again || ph + 1 < ph_end) {
      if (ph_end > 1000) grid.sync();
      xcd_barrier(xb);
    }
#endif
    if (again) rep = 1; else { rep = 0; ++ph; }
  }
}

extern "C" void kernel_launch(void* const* d_in, const int* in_sizes, int n_in, void* d_out, int out_size, void* d_ws,
                              size_t ws_size, hipStream_t stream) {
  Params p{};
  p.x = (const float*)d_in[0]; p.pos = (const int*)d_in[1]; p.pre_g = (const float*)d_in[2]; p.w_in = (const float*)d_in[3];
  p.conv_w = (const float*)d_in[4]; p.conv_b = (const float*)d_in[5]; p.lru_wa = (const float*)d_in[6]; p.lru_ba = (const float*)d_in[7];
  p.lru_wx = (const float*)d_in[8]; p.lru_bx = (const float*)d_in[9]; p.lru_lam = (const float*)d_in[10]; p.q_g = (const float*)d_in[11];
  p.w_uq = (const float*)d_in[12]; p.kv_g = (const float*)d_in[13]; p.w_ukv = (const float*)d_in[14]; p.sgu_g = (const float*)d_in[15];
  p.sgu_bn = (const float*)d_in[16]; p.sgu_w = (const float*)d_in[17]; p.sgu_b = (const float*)d_in[18]; p.br_g = (const float*)d_in[19];
  p.w_out = (const float*)d_in[20]; p.post_g = (const float*)d_in[21];
  p.out = (float*)d_out;
  unsigned char* ws = (unsigned char*)d_ws;
  size_t off = 0;
  auto take = [&](size_t bytes) { unsigned char* q = ws + off; off += (bytes + 255) & ~(size_t)255; return q; };
  p.counters = (int*)take(1024);
  p.bar = (unsigned*)take(XCD_BAR_WORDS * 4);
  p.wInT = (u16*)take((size_t)NLAYER * DINP * DM * 2);
  p.wOutT = (u16*)take((size_t)NLAYER * DM * DM * 2);
  p.wUqT = (u16*)take((size_t)NLAYER * 768 * 192 * 2);
  p.wUkvT = (u16*)take((size_t)NLAYER * 768 * 128 * 2);
  p.waT = (u16*)take((size_t)NLAYER * 6 * 4096 * 2);
  p.wxT = (u16*)take((size_t)NLAYER * 6 * 4096 * 2);
  p.sguW = (u16*)take((size_t)NLAYER * 4 * 128 * 128 * 2);
  p.tab = (float2*)take((size_t)T_TOK * 16 * 8);
  p.hbuf = (u16*)take((size_t)T_TOK * DM * 2);
  p.proj = (u16*)take((size_t)T_TOK * DINP * 2);
  p.y2 = (u16*)take((size_t)T_TOK * DM * 2);
  p.Q = (u16*)take((size_t)T_TOK * 576 * 2);
  p.K = (u16*)take((size_t)T_TOK * 576 * 2);
  p.VT = (u16*)take((size_t)T_TOK * 384 * 2);
  p.hloc = (u16*)take((size_t)T_TOK * 384 * 2);
  p.cum = (u16*)take((size_t)T_TOK * 384 * 2);
  p.Ptile = (float*)take((size_t)512 * 384 * 4);
  p.Htile = (float*)take((size_t)512 * 384 * 4);
  p.carry = (float*)take((size_t)512 * 384 * 4);
  p.obuf = (u16*)take((size_t)T_TOK * 384 * 2);
  p.ycpre = (u16*)take((size_t)T_TOK * 256 * 2);
  if (off > ws_size) { fprintf(stderr, "workspace too small: need %zu have %zu\n", off, ws_size); return; }

  static int grid_blocks = 0;
  if (!grid_blocks) {
    int dev = 0, cus = 0, per_cu = 0;
    hipGetDevice(&dev);
    hipDeviceGetAttribute(&cus, hipDeviceAttributeMultiprocessorCount, dev);
    hipOccupancyMaxActiveBlocksPerMultiprocessor(&per_cu, mega_kernel, 256, 0);
    if (per_cu > 2) per_cu = 2;
    if (per_cu < 1) per_cu = 1;
    grid_blocks = cus * per_cu;
  }
#if COOP
  (void)hipMemsetAsync(d_ws, 0, 1024 + ((XCD_BAR_WORDS * 4 + 255) & ~255), stream);
  int pb = 0, pe = N_PHASES;
  void* args[] = {&p, &pb, &pe};
  hipError_t e = hipLaunchCooperativeKernel((void*)mega_kernel, dim3(grid_blocks), dim3(256), args, 0, stream);
  if (e != hipSuccess) fprintf(stderr, "cooperative launch failed: %s (grid %d)\n", hipGetErrorString(e), grid_blocks);
#else
  for (int ph = 0; ph < N_PHASES; ++ph) mega_kernel<<<grid_blocks, 256, 0, stream>>>(p, ph, ph + 1);
#endif
}
```
